# Optimizing an MI355X kernel written in HIP

```python
import jax, jax.numpy as jnp
from jax import lax
import numpy as np

D_MODEL = 1024
BATCH = 2
SEQ = 16384
DEPTH = 2

CHUNK = 64
GLA_WIDTH = D_MODEL // 2
GLA_HEADS = 4
GLA_DV = GLA_WIDTH // GLA_HEADS
GLA_DK = GLA_DV // 2
GLA_KW = GLA_HEADS * GLA_DK
GLA_LOWRANK = 16
GLA_GATE_NORM = 16.0
HG_WIDTH = D_MODEL // 2
HG_EXPAND = 128
HG_HEADS = HG_WIDTH // HG_EXPAND
HG_DK = HG_EXPAND
HG_DV = HG_WIDTH // HG_HEADS
IN_WIDTHS = [GLA_KW, GLA_KW, GLA_WIDTH, GLA_WIDTH, GLA_LOWRANK,
             HG_WIDTH, HG_WIDTH, HG_WIDTH, HG_WIDTH, 2 * D_MODEL]
IN_TOTAL = int(sum(IN_WIDTHS))
IN_SPLITS = [int(s) for s in np.cumsum(IN_WIDTHS)[:-1]]
EPS = 1e-6
LB_FLOOR = 1e-30

kernel_name = "hybrid_gla_hgrn2_chunk_causal_adaln"


def rms_norm(x, w):
    xf = x.astype(jnp.float32)
    y = xf * lax.rsqrt(jnp.mean(xf * xf, axis=-1, keepdims=True) + EPS)
    return (y * w.astype(jnp.float32)).astype(x.dtype)


def chunk_gated_state(q, k, v, log_decay):
    B, S, H, dk = q.shape
    dv = v.shape[-1]
    N = S // CHUNK
    qc = q.reshape(B, N, CHUNK, H, dk)
    kc = k.reshape(B, N, CHUNK, H, dk).astype(jnp.float32)
    vc = v.reshape(B, N, CHUNK, H, dv).astype(jnp.float32)
    G = jnp.cumsum(log_decay.reshape(B, N, CHUNK, H, dk).astype(jnp.float32), axis=2)
    G_end = G[:, :, -1]
    k_dec = kc * jnp.exp(G_end[:, :, None] - G)
    dS = jnp.einsum('bnlhk,bnlhv->nbhkv', k_dec, vc)
    A = jnp.exp(jnp.transpose(G_end, (1, 0, 2, 3)))

    def step(S_prev, inp):
        a, d = inp
        S_new = a[..., None] * S_prev + d
        return S_new, S_new

    S0 = jnp.zeros((B, H, dk, dv), jnp.float32)
    _, S_all = lax.scan(step, S0, (A, dS))
    o = jnp.einsum('bnlhk,nbhkv->bnlhv', qc.astype(jnp.float32), S_all)
    return o.reshape(B, S, H, dv).astype(v.dtype)


def setup_inputs(seed: int = 0) -> dict:
    key = jax.random.key(seed)
    ks = jax.random.split(key, 16)
    D = D_MODEL
    nrm = jax.random.normal
    f32 = jnp.float32
    return {
        "x": nrm(ks[0], (BATCH, SEQ, D), f32),
        "c": nrm(ks[1], (BATCH, D), f32),
        "norm_w": 1.0 + 0.02 * nrm(ks[2], (DEPTH, D), f32),
        "ada_w": nrm(ks[3], (DEPTH, D, 3 * D), f32) * D ** -0.5,
        "ada_b": 0.02 * nrm(ks[4], (DEPTH, 3 * D), f32),
        "w_in": nrm(ks[5], (DEPTH, D, IN_TOTAL), f32) * D ** -0.5,
        "gla_wa2": nrm(ks[6], (DEPTH, GLA_LOWRANK, GLA_KW), f32) * GLA_LOWRANK ** -0.5,
        "gla_ba": 0.1 * nrm(ks[7], (DEPTH, GLA_KW), f32),
        "gla_norm_w": 1.0 + 0.02 * nrm(ks[8], (DEPTH, GLA_DV), f32),
        "hgrn_gamma": nrm(ks[9], (DEPTH, HG_WIDTH), f32),
        "hgrn_norm_w": 1.0 + 0.02 * nrm(ks[10], (DEPTH, HG_DV), f32),
        "merge_b": 0.02 * nrm(ks[11], (DEPTH, 2 * D), f32),
        "w_up_gla": nrm(ks[12], (DEPTH, GLA_WIDTH, D), f32) * GLA_WIDTH ** -0.5,
        "w_up_hgrn": nrm(ks[13], (DEPTH, HG_WIDTH, D), f32) * HG_WIDTH ** -0.5,
        "w_out": nrm(ks[14], (DEPTH, D, D), f32) * D ** -0.5,
        "final_norm_w": 1.0 + 0.02 * nrm(ks[15], (D,), f32),
    }


def reference(x, c, norm_w, ada_w, ada_b, w_in, gla_wa2, gla_ba, gla_norm_w, hgrn_gamma,
              hgrn_norm_w, merge_b, w_up_gla, w_up_hgrn, w_out, final_norm_w):
    B, S, _ = x.shape
    sm = jax.nn.softmax(hgrn_gamma.astype(jnp.float32), axis=0)
    lower_bounds = jnp.cumsum(sm, axis=0) - sm[0]
    c_act = jax.nn.silu(c)
    for l in range(DEPTH):
        mod = c_act @ ada_w[l] + ada_b[l]
        shift, scale, gate = jnp.split(mod, 3, axis=-1)
        h = rms_norm(x, norm_w[l]) * (1.0 + scale[:, None]) + shift[:, None]
        p = h @ w_in[l]
        gq, gk, gv, gz, glr, hq, hf, hi, hz, mg = jnp.split(p, IN_SPLITS, axis=-1)

        log_a = jax.nn.log_sigmoid((glr @ gla_wa2[l] + gla_ba[l]).astype(jnp.float32)) / GLA_GATE_NORM
        o_g = chunk_gated_state(
            (gq * GLA_DK ** -0.5).reshape(B, S, GLA_HEADS, GLA_DK),
            gk.reshape(B, S, GLA_HEADS, GLA_DK),
            gv.reshape(B, S, GLA_HEADS, GLA_DV),
            log_a.reshape(B, S, GLA_HEADS, GLA_DK))
        o_g = rms_norm(o_g, gla_norm_w[l]) * jax.nn.silu(gz.reshape(B, S, GLA_HEADS, GLA_DV))
        o_g = o_g.reshape(B, S, GLA_WIDTH)

        lb = jnp.clip(lower_bounds[l], 0.0, 1.0 - 1e-6)
        zf = hf.astype(jnp.float32)
        log_f = jnp.logaddexp(jnp.log(jnp.maximum(lb, LB_FLOOR)),
                              jnp.log1p(-lb) + jax.nn.log_sigmoid(zf))
        k_h = ((1.0 - lb) * jax.nn.sigmoid(-zf)).astype(x.dtype)
        o_h = chunk_gated_state(
            (jax.nn.silu(hq) * HG_DK ** -0.5).reshape(B, S, HG_HEADS, HG_DK),
            k_h.reshape(B, S, HG_HEADS, HG_DK),
            hi.reshape(B, S, HG_HEADS, HG_DV),
            log_f.reshape(B, S, HG_HEADS, HG_DK))
        o_h = rms_norm(o_h, hgrn_norm_w[l]) * jax.nn.silu(hz.reshape(B, S, HG_HEADS, HG_DV))
        o_h = o_h.reshape(B, S, HG_WIDTH)

        g_a, g_b = jnp.split(jax.nn.sigmoid(mg + merge_b[l]), 2, axis=-1)
        m = g_a * (o_g @ w_up_gla[l]) + g_b * (o_h @ w_up_hgrn[l])
        x = x + gate[:, None] * (m @ w_out[l])
    return rms_norm(x, final_norm_w)
```

```cpp
#include <hip/hip_runtime.h>
#include <hip/hip_cooperative_groups.h>
#include <cstdio>
#include <cstdint>
namespace cg = cooperative_groups;
namespace pg8 {
#define PG8_LAS __attribute__((address_space(3)))
typedef unsigned short bf16_t;
typedef short bf16x8 __attribute__((ext_vector_type(8)));
typedef float f32x4 __attribute__((ext_vector_type(4)));
typedef unsigned u32x4 __attribute__((ext_vector_type(4)));
constexpr int BM = 256, BK = 64, HALF = 128, HTB = HALF * BK * 2  , STAGE_BYTES = 8 * HTB, NXCD = 8, WGM = 8;

__host__ __device__ __forceinline__ int lds_byte(int r, int c) { const int st = (r >> 4) * 2 + (c >> 5), rr = r & 15, cc = c & 31, ob = rr * 64 + cc * 2; return st * 1024 + (ob ^ (((ob >> 9) & 1) << 5)); }
__host__ __device__ __forceinline__ void stage_rc(int b, int& R, int& C) { const int st = b / 1024, sb = b % 1024, swz = sb ^ (((sb >> 9) & 1) << 5); R = (st >> 1) * 16 + swz / 64; C = (st & 1) * 32 + (swz % 64) / 2; }
__host__ __device__ __forceinline__ int perm32(int rho) { const int n = rho >> 4, i = rho & 15; return 8 * (i >> 2) + 4 * n + (i & 3); }

struct Unit { int pm, pn; };
struct Gemm { const bf16_t* A; const bf16_t* Bt; int M, N, K; };

struct StaticOrder {
    int nM, nN, nwg, G, c;
    __host__ __device__ void init(int M, int N, int G_, int c_) { nM = M / BM; nN = N / BM; nwg = nM * nN; G = G_; c = c_; }
    __host__ __device__ bool next(int i, Unit& u) const {
        const long L = (long)i * G + c; if (L >= nwg) return false;
        int wgid = (int)L; { const int q = nwg / NXCD, r = nwg % NXCD, xcd = wgid % NXCD, off = wgid / NXCD; wgid = (xcd < r ? xcd * (q + 1) : r * (q + 1) + (xcd - r) * q) + off; }
        const int nig = WGM * nN, gid = wgid / nig, fm = gid * WGM, gsz = (nM - fm) < WGM ? (nM - fm) : WGM;
        u.pm = fm + ((wgid % nig) % gsz); u.pn = (wgid % nig) / gsz; return true;
    }
    __device__ __forceinline__ void a_ready(const Unit&) const {}
    __device__ __forceinline__ void done(const Unit&) const {}
};
__device__ __forceinline__ unsigned cvt_pk_bf16(float lo, float hi) { unsigned r; asm volatile("v_cvt_pk_bf16_f32 %0, %1, %2" : "=v"(r) : "v"(lo), "v"(hi)); return r; }
template <class Epi, class Sched, bool ALIGN_EPI = false, bool SP2 = false>
__device__ __forceinline__ void gemm_phase(PG8_LAS unsigned char* lds, const Gemm g, const Sched& S, const Epi& E) {
    int tid_ = threadIdx.x; asm volatile("" : "+v"(tid_));
    const int tid = tid_, wid = __builtin_amdgcn_readfirstlane(tid >> 6), lane = tid & 63, wr = wid >> 2, wc = wid & 3, fr = lane & 15, fq = lane >> 4;
    const int K = g.K, nt = K / BK;
    unsigned voffA[2], voffB[2];
#pragma unroll
    for (int i = 0; i < 2; ++i) { int R, C; stage_rc(tid * 16 + i * 8192, R, C); const int Rb = Epi::PERM ? ((R & ~31) + perm32(R & 31)) : R;
        voffA[i] = (unsigned)(R * K + C) * 2u; voffB[i] = (unsigned)(Rb * K + C) * 2u; }
    const size_t kstep = (size_t)(BK * 2);
    const size_t hstep = (size_t)HALF * K * 2;
    const size_t tstep = 2 * hstep;
    const unsigned ldsw = (unsigned)wid * 1024u;
    const int aoff = lds_byte(wr * 64 + fr, fq * 8), boff = lds_byte(wc * 32 + fr, fq * 8);
#define PG8_SA(b, h) (((b) * 2 + (h)) * HTB)
#define PG8_SB(b, h) ((4 + (b) * 2 + (h)) * HTB)
#define PG8_STAGE(bufoff, gbase, voff) do { _Pragma("unroll") for (int _i = 0; _i < 2; ++_i) \
        __builtin_amdgcn_global_load_lds((const unsigned*)((const char*)(gbase) + (voff)[_i]), (PG8_LAS unsigned*)(lds + (bufoff) + ldsw + _i * 8192), 16, 0, 0); } while (0)
#define PG8_LDA(dst, b, h) do { _Pragma("unroll") for (int m = 0; m < 4; ++m) _Pragma("unroll") for (int k = 0; k < 2; ++k) dst[m][k] = *(const PG8_LAS bf16x8*)(lds + PG8_SA(b, h) + aoff + m * 2048 + k * 1024); } while (0)
#define PG8_LDB(dst, b, h) do { _Pragma("unroll") for (int n = 0; n < 2; ++n) _Pragma("unroll") for (int k = 0; k < 2; ++k) dst[n][k] = *(const PG8_LAS bf16x8*)(lds + PG8_SB(b, h) + boff + n * 2048 + k * 1024); } while (0)
#define PG8_MMA(ai, bj, At, Bt) do { __builtin_amdgcn_s_setprio(1); _Pragma("unroll") for (int m = 0; m < 4; ++m) _Pragma("unroll") for (int n = 0; n < 2; ++n) _Pragma("unroll") for (int k = 0; k < 2; ++k) \
        acc[ai][bj][m][n] = __builtin_amdgcn_mfma_f32_16x16x32_bf16(Bt[n][k], At[m][k], acc[ai][bj][m][n], 0, 0, 0); __builtin_amdgcn_s_setprio(0); } while (0)
#define PG8_WAIT_V(n) asm volatile("s_waitcnt vmcnt(" #n ")" ::: "memory")
#define PG8_WAIT_L(n) asm volatile("s_waitcnt lgkmcnt(" #n ")" ::: "memory")
#define PG8_BAR __builtin_amdgcn_s_barrier()
#define PG8_SCHED __builtin_amdgcn_sched_barrier(0)
    Unit cur, nxt; int ui = 0;
    if (!S.next(0, cur)) return;
    f32x4 acc[2][2][4][2];
#pragma unroll
    for (int a = 0; a < 2; ++a)
#pragma unroll
        for (int b = 0; b < 2; ++b)
#pragma unroll
            for (int m = 0; m < 4; ++m)
#pragma unroll
                for (int n = 0; n < 2; ++n) acc[a][b][m][n] = (f32x4){0.f, 0.f, 0.f, 0.f};
    bf16x8 At[4][2], B0[2][2], B1[2][2];
    const char* cA = (const char*)g.A + (size_t)cur.pm * tstep; const char* cB = (const char*)g.Bt + (size_t)cur.pn * tstep;
    S.a_ready(cur);
    if constexpr (SP2) {
        PG8_STAGE(PG8_SB(0, 0), cB, voffB); PG8_STAGE(PG8_SB(0, 1), cB + hstep, voffB); PG8_STAGE(PG8_SA(0, 0), cA, voffA); PG8_STAGE(PG8_SA(0, 1), cA + hstep, voffA);
        if (wr == 1) PG8_BAR;
        PG8_WAIT_V(2); PG8_BAR;
        PG8_STAGE(PG8_SB(1, 0), cB + kstep, voffB); PG8_STAGE(PG8_SA(1, 0), cA + kstep, voffA); PG8_STAGE(PG8_SB(1, 1), cB + hstep + kstep, voffB);
        PG8_WAIT_V(6); PG8_BAR;
    } else {
        PG8_STAGE(PG8_SB(0, 0), cB, voffB); PG8_STAGE(PG8_SA(0, 0), cA, voffA); PG8_STAGE(PG8_SB(0, 1), cB + hstep, voffB); PG8_STAGE(PG8_SA(0, 1), cA + hstep, voffA);
        if (wr == 1) PG8_BAR;
        PG8_WAIT_V(4); PG8_BAR;
        PG8_STAGE(PG8_SB(1, 0), cB + kstep, voffB); PG8_STAGE(PG8_SA(1, 0), cA + kstep, voffA); PG8_STAGE(PG8_SB(1, 1), cB + hstep + kstep, voffB);
        PG8_WAIT_V(6); PG8_BAR;
    }
    for (;;) {
        const bool has_next = S.next(ui + 1, nxt);
        const char* nA = has_next ? (const char*)g.A + (size_t)nxt.pm * tstep : cA; const char* nB = has_next ? (const char*)g.Bt + (size_t)nxt.pn * tstep : cB;
        for (int t = 0; t < nt; t += 2) {
            const bool last = (t == nt - 2);
            const char* a1 = cA + (size_t)(t + 1) * kstep;
            const char* a2 = last ? nA : cA + (size_t)(t + 2) * kstep; const char* b2 = last ? nB : cB + (size_t)(t + 2) * kstep;
            const char* a3 = a2 + kstep; const char* b3 = b2 + kstep;
            if (last && has_next) S.a_ready(nxt);
            if constexpr (Epi::MID) { if (t == nt / 2) E.mid(acc, cur, wr, wc, fr, fq); }
            if constexpr (SP2) {
            PG8_LDB(B0, 0, 0); PG8_LDB(B1, 0, 1); PG8_SCHED; PG8_LDA(At, 0, 0); PG8_STAGE(PG8_SA(1, 1), a1 + hstep, voffA);
            PG8_WAIT_V(8); PG8_WAIT_L(0); PG8_BAR; PG8_MMA(0, 0, At, B0); PG8_MMA(0, 1, At, B1); PG8_BAR; PG8_SCHED;
            PG8_LDA(At, 0, 1); PG8_STAGE(PG8_SB(0, 0), b2, voffB); PG8_STAGE(PG8_SB(0, 1), b2 + hstep, voffB); PG8_STAGE(PG8_SA(0, 0), a2, voffA);
            PG8_WAIT_V(8); PG8_WAIT_L(0); PG8_BAR; PG8_MMA(1, 0, At, B0); PG8_MMA(1, 1, At, B1); PG8_BAR; PG8_SCHED;
            PG8_LDB(B0, 1, 0); PG8_LDB(B1, 1, 1); PG8_SCHED; PG8_LDA(At, 1, 0); PG8_STAGE(PG8_SA(0, 1), a2 + hstep, voffA);
            PG8_WAIT_V(8); PG8_WAIT_L(0); PG8_BAR; PG8_MMA(0, 0, At, B0); PG8_MMA(0, 1, At, B1); PG8_BAR; PG8_SCHED;
            PG8_LDA(At, 1, 1); PG8_STAGE(PG8_SB(1, 0), b3, voffB); PG8_STAGE(PG8_SB(1, 1), b3 + hstep, voffB); PG8_STAGE(PG8_SA(1, 0), a3, voffA);
            PG8_WAIT_V(8); PG8_WAIT_L(0); PG8_BAR; PG8_MMA(1, 0, At, B0); PG8_MMA(1, 1, At, B1); PG8_BAR; PG8_SCHED;
            } else {
            PG8_LDB(B0, 0, 0); PG8_SCHED; PG8_LDA(At, 0, 0); PG8_STAGE(PG8_SA(1, 1), a1 + hstep, voffA);
            PG8_WAIT_L(8); PG8_BAR; PG8_WAIT_L(0); PG8_MMA(0, 0, At, B0); PG8_BAR; PG8_SCHED;
            PG8_LDB(B1, 0, 1); PG8_STAGE(PG8_SB(0, 0), b2, voffB);
            PG8_BAR; PG8_WAIT_L(0); PG8_MMA(0, 1, At, B1); PG8_BAR;
            PG8_LDA(At, 0, 1); PG8_STAGE(PG8_SA(0, 0), a2, voffA);
            PG8_BAR; PG8_WAIT_L(0); PG8_MMA(1, 0, At, B0); PG8_BAR; PG8_SCHED;
            PG8_STAGE(PG8_SB(0, 1), b2 + hstep, voffB);
            PG8_WAIT_V(6); PG8_BAR; PG8_MMA(1, 1, At, B1); PG8_BAR;
            PG8_LDB(B0, 1, 0); PG8_SCHED; PG8_LDA(At, 1, 0); PG8_STAGE(PG8_SA(0, 1), a2 + hstep, voffA);
            PG8_WAIT_L(8); PG8_BAR; PG8_WAIT_L(0); PG8_MMA(0, 0, At, B0); PG8_BAR; PG8_SCHED;
            PG8_LDB(B1, 1, 1); PG8_STAGE(PG8_SB(1, 0), b3, voffB);
            PG8_BAR; PG8_WAIT_L(0); PG8_MMA(0, 1, At, B1); PG8_BAR;
            PG8_LDA(At, 1, 1); PG8_STAGE(PG8_SA(1, 0), a3, voffA);
            PG8_BAR; PG8_WAIT_L(0); PG8_MMA(1, 0, At, B0); PG8_BAR; PG8_SCHED;
            PG8_STAGE(PG8_SB(1, 1), b3 + hstep, voffB);
            PG8_WAIT_V(6); PG8_BAR; PG8_MMA(1, 1, At, B1); PG8_BAR;
            }
        }
        if constexpr (ALIGN_EPI) { if (wr == 0) PG8_BAR; }
        if constexpr (!Epi::AFTER_DRAIN) { E(acc, cur, wr, wc, fr, fq); S.done(cur); }
        if (!has_next) break;
#pragma unroll
        for (int a = 0; a < 2; ++a)
#pragma unroll
            for (int b = 0; b < 2; ++b)
#pragma unroll
                for (int m = 0; m < 4; ++m)
#pragma unroll
                    for (int n = 0; n < 2; ++n) acc[a][b][m][n] = (f32x4){0.f, 0.f, 0.f, 0.f};
        cur = nxt; cA = nA; cB = nB; ++ui;
        if constexpr (ALIGN_EPI) { if (wr == 1) PG8_BAR; }
    }
    PG8_WAIT_V(0);
    if constexpr (!ALIGN_EPI) { if (wr == 0) PG8_BAR; }
    PG8_BAR;
    if constexpr (Epi::AFTER_DRAIN) { E.fused(acc, cur, wr, wc, fr, fq, lds, wid, lane); S.done(cur); }
#undef PG8_SA
#undef PG8_SB
#undef PG8_STAGE
#undef PG8_LDA
#undef PG8_LDB
#undef PG8_MMA
#undef PG8_WAIT_V
#undef PG8_WAIT_L
#undef PG8_BAR
#undef PG8_SCHED
}
}

#define LAS __attribute__((address_space(3)))
typedef unsigned short bf16;
typedef float f32x4 __attribute__((ext_vector_type(4)));
typedef short bf16x8 __attribute__((ext_vector_type(8)));
typedef unsigned u32x4 __attribute__((ext_vector_type(4)));
typedef unsigned u32x2 __attribute__((ext_vector_type(2)));

constexpr int D = 1024, BATCH = 2, SEQ = 16384, T = BATCH * SEQ, DEPTH = 2;
constexpr int IN_TOTAL = 5648, NP = 5632, NP1 = 3584, NPG = 2048;
constexpr int G_CH = 8;
constexpr int NCHUNK = SEQ / 64;
constexpr int NG = NCHUNK / G_CH;
constexpr int NTHREADS = 512, NWAVES = 8;
constexpr int LDS_BYTES = 147456;
constexpr float EPS = 1e-6f;

constexpr int C_GQ = 0, C_GK = 256, C_GV = 512, C_GZ = 1024, C_HQ = 1536, C_HF = 2048, C_HI = 2560, C_HZ = 3072;

constexpr size_t MiB = 1u << 20;
constexpr size_t WS_MOD = 0;
constexpr size_t WS_WIN = 1 * MiB;
constexpr size_t WS_WUP = 23 * MiB;
constexpr size_t WS_WOUT = 27 * MiB;
constexpr size_t WS_STATE = 32 * MiB;
constexpr size_t WS_STATE_HG = WS_STATE + 8 * MiB;
constexpr size_t WS_PDEC = 56 * MiB;
constexpr size_t WS_LOGA = 64 * MiB;
constexpr size_t WS_H = 96 * MiB;
constexpr size_t WS_P1 = 160 * MiB;
constexpr size_t WS_PG = 384 * MiB;
constexpr size_t WS_END = 512 * MiB;

struct Params { const float* in[16]; float* out; unsigned char* ws; };

__device__ __forceinline__ float bf2f(unsigned short b) { return __builtin_bit_cast(float, (unsigned)b << 16); }
__device__ __forceinline__ float bflo(unsigned w) { return __builtin_bit_cast(float, w << 16); }
__device__ __forceinline__ float bfhi(unsigned w) { return __builtin_bit_cast(float, w & 0xffff0000u); }
__device__ __forceinline__ unsigned f2bf(float f) { unsigned u = __builtin_bit_cast(unsigned, f); return (u + 0x7fffu + ((u >> 16) & 1u)) >> 16; }
__device__ __forceinline__ unsigned pk2(float lo, float hi) { return f2bf(lo) | (f2bf(hi) << 16); }
__device__ __forceinline__ float sigmoidf_(float x) { return 1.0f / (1.0f + __expf(-x)); }
__device__ __forceinline__ float wave_sum(float v) {
#pragma unroll
    for (int o = 1; o < 64; o <<= 1) v += __shfl_xor(v, o);
    return v;
}
#define LDS_WAIT() asm volatile("s_waitcnt lgkmcnt(0)" ::: "memory")

namespace pg8 {
struct EpiIn {
    static constexpr bool PERM = true, AFTER_DRAIN = false, MID = false;
    bf16_t* P1; bf16_t* PG; const float* bias;
    __device__ __forceinline__ void operator()(const f32x4 (&acc)[2][2][4][2], const Unit& u, int wr, int wc, int fr, int fq) const {
        const int pn = u.pn;
        const int row0 = u.pm * BM + wr * 64 + fr;
        if (pn >= 14) {
            const int ch0 = (pn - 14) * 128 + wc * 32 + 8 * fq;
            f32x4 ba[2], bb[2];
#pragma unroll
            for (int n = 0; n < 2; ++n) { ba[n] = *(const f32x4*)(bias + ch0 + 4 * n); bb[n] = *(const f32x4*)(bias + 1024 + ch0 + 4 * n); }
#pragma unroll
            for (int ai = 0; ai < 2; ++ai)
#pragma unroll
                for (int m = 0; m < 4; ++m) { bf16_t* rowp = PG + (size_t)(row0 + ai * HALF + m * 16) * NPG + ch0;
                    f32x4 r[2], g[2];
#pragma unroll
                    for (int n = 0; n < 2; ++n) { const f32x4 a = acc[ai][0][m][n] + ba[n], b = acc[ai][1][m][n] + bb[n];
#pragma unroll
                        for (int j = 0; j < 4; ++j) { const float ea = __expf(-a[j]), eb = __expf(-b[j]); g[n][j] = 1.0f / (1.0f + eb); r[n][j] = (1.0f + eb) / (1.0f + ea); } }
                    u32x4 w; w.x = cvt_pk_bf16(r[0][0], r[0][1]); w.y = cvt_pk_bf16(r[0][2], r[0][3]); w.z = cvt_pk_bf16(r[1][0], r[1][1]); w.w = cvt_pk_bf16(r[1][2], r[1][3]);
                    *(u32x4*)rowp = w;
                    w.x = cvt_pk_bf16(g[0][0], g[0][1]); w.y = cvt_pk_bf16(g[0][2], g[0][3]); w.z = cvt_pk_bf16(g[1][0], g[1][1]); w.w = cvt_pk_bf16(g[1][2], g[1][3]);
                    *(u32x4*)(rowp + 1024) = w; }
            return;
        }
        int mode = 0; float scl = 1.0f;
        if (pn == 0) scl = 0.125f;
        else if (pn == 4 || pn == 5 || pn == 12 || pn == 13) mode = 1;
        else if (pn == 6 || pn == 7) { mode = 1; scl = 0.08838834764831845f; }
        const int col0 = pn * 256 + wc * 32 + 8 * fq;
#pragma unroll
        for (int ai = 0; ai < 2; ++ai)
#pragma unroll
            for (int m = 0; m < 4; ++m) { bf16_t* rowp = P1 + (size_t)(row0 + ai * HALF + m * 16) * NP1 + col0;
#pragma unroll
                for (int bj = 0; bj < 2; ++bj) { f32x4 v0 = acc[ai][bj][m][0], v1 = acc[ai][bj][m][1];
                    if (mode == 0) { v0 = v0 * scl; v1 = v1 * scl; }
                    else {
#pragma unroll
                        for (int j = 0; j < 4; ++j) { v0[j] = v0[j] * scl / (1.0f + __expf(-v0[j])); v1[j] = v1[j] * scl / (1.0f + __expf(-v1[j])); } }
                    u32x4 w; w.x = cvt_pk_bf16(v0[0], v0[1]); w.y = cvt_pk_bf16(v0[2], v0[3]); w.z = cvt_pk_bf16(v1[0], v1[1]); w.w = cvt_pk_bf16(v1[2], v1[3]);
                    *(u32x4*)(rowp + bj * HALF) = w; } }
    }
};
struct EpiUp {
    static constexpr bool PERM = true, AFTER_DRAIN = false, MID = true;
    const bf16_t* PG; bf16_t* Mo;
    __device__ __forceinline__ void mid(f32x4 (&acc)[2][2][4][2], const Unit& u, int wr, int wc, int fr_, int fq) const {
        int fr = fr_; asm volatile("" : "+v"(fr));
        const int row0 = u.pm * BM + wr * 64 + fr, col0 = u.pn * BM + wc * 32 + 8 * fq;
#pragma unroll
        for (int ai = 0; ai < 2; ++ai) {
            u32x4 rv[4][2];
#pragma unroll
            for (int m = 0; m < 4; ++m) { const bf16_t* gp = PG + (size_t)(row0 + ai * HALF + m * 16) * NPG + col0;
#pragma unroll
                for (int bj = 0; bj < 2; ++bj) rv[m][bj] = *(const u32x4*)(gp + bj * HALF); }
#pragma unroll
            for (int m = 0; m < 4; ++m)
#pragma unroll
                for (int bj = 0; bj < 2; ++bj) { const u32x4 ga = rv[m][bj];
                    acc[ai][bj][m][0] = acc[ai][bj][m][0] * (f32x4){bflo(ga.x), bfhi(ga.x), bflo(ga.y), bfhi(ga.y)};
                    acc[ai][bj][m][1] = acc[ai][bj][m][1] * (f32x4){bflo(ga.z), bfhi(ga.z), bflo(ga.w), bfhi(ga.w)}; }
            __builtin_amdgcn_sched_barrier(0);
        }
    }
    __device__ __forceinline__ void operator()(const f32x4 (&acc)[2][2][4][2], const Unit& u, int wr, int wc, int fr, int fq) const {
        const int row0 = u.pm * BM + wr * 64 + fr, col0 = u.pn * BM + wc * 32 + 8 * fq;
#pragma unroll
        for (int ai = 0; ai < 2; ++ai)
#pragma unroll
            for (int m = 0; m < 4; ++m) { const size_t row = (size_t)(row0 + ai * HALF + m * 16); const bf16_t* gp = PG + row * NPG + 1024 + col0; bf16_t* op = Mo + row * D + col0;
#pragma unroll
                for (int bj = 0; bj < 2; ++bj) { const u32x4 gb = *(const u32x4*)(gp + bj * HALF);
                    const f32x4 a0 = acc[ai][bj][m][0], a1 = acc[ai][bj][m][1];
                    u32x4 w; w.x = cvt_pk_bf16(a0[0] * bflo(gb.x), a0[1] * bfhi(gb.x)); w.y = cvt_pk_bf16(a0[2] * bflo(gb.y), a0[3] * bfhi(gb.y));
                    w.z = cvt_pk_bf16(a1[0] * bflo(gb.z), a1[1] * bfhi(gb.z)); w.w = cvt_pk_bf16(a1[2] * bflo(gb.w), a1[3] * bfhi(gb.w));
                    *(u32x4*)(op + bj * HALF) = w; } }
    }
};
struct EpiOut {
    static constexpr bool PERM = false, AFTER_DRAIN = false, MID = false;
    const float* xin; float* out; const float* gate2;
    __device__ __forceinline__ void operator()(const f32x4 (&acc)[2][2][4][2], const Unit& u, int wr, int wc, int fr, int fq) const {
        const int row0 = u.pm * BM + wr * 64 + fr, col0 = u.pn * BM + wc * 32 + 4 * fq;
        const float* gate = gate2 + ((u.pm * BM) / SEQ) * 3072;
        f32x4 gv[2][2];
#pragma unroll
        for (int bj = 0; bj < 2; ++bj)
#pragma unroll
            for (int n = 0; n < 2; ++n) gv[bj][n] = *(const f32x4*)(gate + col0 + bj * HALF + n * 16);
#pragma unroll
        for (int ai = 0; ai < 2; ++ai)
#pragma unroll
            for (int m = 0; m < 4; ++m) { const size_t off = (size_t)(row0 + ai * HALF + m * 16) * D + col0;
#pragma unroll
                for (int bj = 0; bj < 2; ++bj)
#pragma unroll
                    for (int n = 0; n < 2; ++n) { const f32x4 xv = *(const f32x4*)(xin + off + bj * HALF + n * 16);
                        *(f32x4*)(out + off + bj * HALF + n * 16) = xv + gv[bj][n] * acc[ai][bj][m][n]; } }
    }
};
}

__device__ __forceinline__ void transpose_item(const float* W, int ldw, int src_col0, int k0, bf16* WT, int dst_row0, int dst_k0, LAS float* scr, int lane) {
#pragma unroll 8
    for (int i = 0; i < 32; ++i) { const int kk = 2 * i + (lane >> 5); scr[kk * 33 + (lane & 31)] = W[(size_t)(k0 + kk) * ldw + src_col0 + (lane & 31)]; }
    LDS_WAIT();
    const int c = lane & 7;
#pragma unroll
    for (int j = 0; j < 4; ++j) { const int n = (lane >> 3) + 8 * j; const LAS float* s = scr + (8 * c) * 33 + n;
        u32x4 o; o.x = pk2(s[0 * 33], s[1 * 33]); o.y = pk2(s[2 * 33], s[3 * 33]); o.z = pk2(s[4 * 33], s[5 * 33]); o.w = pk2(s[6 * 33], s[7 * 33]);
        *(u32x4*)(WT + (size_t)(dst_row0 + n) * D + dst_k0 + 8 * c) = o; }
    LDS_WAIT();
}

__device__ __forceinline__ void phase_prologue(const Params& p, LAS unsigned char* lds) {
    int tid_ = threadIdx.x; asm volatile("" : "+v"(tid_));
    const int tid = tid_, lane = tid & 63, wave = tid >> 6;
    unsigned char* ws = p.ws;
    for (int task = blockIdx.x; task < DEPTH * 96; task += gridDim.x) {
        const int l = task / 96, cgp = task % 96, col = tid & 31, ks = tid >> 5;
        const float* W = p.in[3] + (size_t)l * D * 3072 + cgp * 32 + col;
        const float* c0 = p.in[1], *c1 = p.in[1] + D;
        float s0 = 0.f, s1 = 0.f;
#pragma unroll 8
        for (int k = ks * 64; k < ks * 64 + 64; ++k) { const float w = W[(size_t)k * 3072]; const float a = c0[k], b = c1[k];
            s0 += a * sigmoidf_(a) * w; s1 += b * sigmoidf_(b) * w; }
        LAS float* red = (LAS float*)(lds + 98304);
        red[(ks * 32 + col) * 2 + 0] = s0; red[(ks * 32 + col) * 2 + 1] = s1;
        __syncthreads();
        if (tid < 64) { const int cc = tid & 31, bb = tid >> 5; float s = 0.f;
#pragma unroll
            for (int k = 0; k < 16; ++k) s += red[(k * 32 + cc) * 2 + bb];
            const int cglob = cgp * 32 + cc;
            ((float*)(ws + WS_MOD))[(l * BATCH + bb) * 3072 + cglob] = s + p.in[4][l * 3072 + cglob]; }
        __syncthreads();
    }
    LAS float* scr = (LAS float*)(lds + wave * 8704);
    const int gw = blockIdx.x * NWAVES + wave, NGW = gridDim.x * NWAVES;
    constexpr int I_IN = 16 * 176, I_UP = 8 * 32, I_OUT = 16 * 32, I_L = I_IN + 2 * I_UP + I_OUT;
    for (int it = gw; it < DEPTH * I_L; it += NGW) {
        const int l = it / I_L; int r = it % I_L;
        if (r < I_IN) { const int kb = r / 176, nb = r % 176, n0 = 32 * nb;
            transpose_item(p.in[5] + (size_t)l * D * IN_TOTAL, IN_TOTAL, n0 < 1536 ? n0 : (n0 < 3584 ? n0 + 16 : 3600 + (((n0 - 3584) >> 7) & 1) * 1024 + ((n0 - 3584) >> 8) * 128 + (n0 & 127)), 64 * kb, (bf16*)(ws + WS_WIN) + (size_t)l * NP * D, n0, 64 * kb, scr, lane); continue; }
        r -= I_IN;
        if (r < I_UP) { const int kb = r / 32, nb = r % 32;
            transpose_item(p.in[12] + (size_t)l * 512 * D, D, 32 * nb, 64 * kb, (bf16*)(ws + WS_WUP) + (size_t)l * D * D, 32 * nb, 64 * kb, scr, lane); continue; }
        r -= I_UP;
        if (r < I_UP) { const int kb = r / 32, nb = r % 32;
            transpose_item(p.in[13] + (size_t)l * 512 * D, D, 32 * nb, 64 * kb, (bf16*)(ws + WS_WUP) + (size_t)l * D * D, 32 * nb, 512 + 64 * kb, scr, lane); continue; }
        r -= I_UP;
        { const int kb = r / 32, nb = r % 32;
            transpose_item(p.in[14] + (size_t)l * D * D, D, 32 * nb, 64 * kb, (bf16*)(ws + WS_WOUT) + (size_t)l * D * D, 32 * nb, 64 * kb, scr, lane); }
    }
}

__device__ __forceinline__ void phase_norm(const Params& p, LAS unsigned char* lds, int l, const float* xin) {
    int tid_ = threadIdx.x; asm volatile("" : "+v"(tid_));
    const int tid = tid_, lane = tid & 63, wave = tid >> 6;
    unsigned char* ws = p.ws;
    LAS float* wl = (LAS float*)lds;
    LAS float* wa2s = (LAS float*)(lds + 65536);
    LAS float* wscr = (LAS float*)(lds + 81920) + wave * 32;
    for (int k = tid; k < D; k += NTHREADS) { const float* src = p.in[5] + (size_t)l * D * IN_TOTAL + (size_t)k * IN_TOTAL + 1536;
#pragma unroll
        for (int q4 = 0; q4 < 4; ++q4) { const f32x4 v = *(const f32x4*)(src + 4 * q4);
#pragma unroll
            for (int i = 0; i < 4; ++i) wl[(q4 * 4 + i) * D + k] = v[i]; } }
    for (int i = tid; i < 16 * 256; i += NTHREADS) wa2s[i] = p.in[6][l * 4096 + i];
    __syncthreads();
    f32x4 nw[4];
#pragma unroll
    for (int j = 0; j < 4; ++j) nw[j] = *(const f32x4*)(p.in[2] + l * D + lane * 4 + 256 * j);
    const f32x4 ba4 = *(const f32x4*)(p.in[7] + l * 256 + lane * 4);
    const float* mod = (const float*)(ws + WS_MOD) + (size_t)l * BATCH * 3072;
    bf16* H = (bf16*)(ws + WS_H); float* LA = (float*)(ws + WS_LOGA);
    const int gw = blockIdx.x * NWAVES + wave, NGW = gridDim.x * NWAVES;
    for (int r = gw * 2; r < T; r += NGW * 2) {
        const int b = r / SEQ;
        f32x4 hm[4], ha[4];
#pragma unroll
        for (int j = 0; j < 4; ++j) { ha[j] = *(const f32x4*)(mod + b * 3072 + lane * 4 + 256 * j); const f32x4 sc = *(const f32x4*)(mod + b * 3072 + 1024 + lane * 4 + 256 * j); hm[j] = nw[j] * (1.0f + sc); }
        f32x4 hv[2][4];
#pragma unroll
        for (int rr = 0; rr < 2; ++rr) {
            const f32x4* xr = (const f32x4*)(xin + (size_t)(r + rr) * D) + lane;
            float s = 0.f;
#pragma unroll
            for (int j = 0; j < 4; ++j) { hv[rr][j] = xr[64 * j]; s += (hv[rr][j].x * hv[rr][j].x + hv[rr][j].y * hv[rr][j].y) + (hv[rr][j].z * hv[rr][j].z + hv[rr][j].w * hv[rr][j].w); }
            const float rstd = 1.0f / sqrtf(wave_sum(s) * (1.0f / D) + EPS);
            unsigned long long* o8 = (unsigned long long*)(H + (size_t)(r + rr) * D) + lane;
#pragma unroll
            for (int j = 0; j < 4; ++j) { hv[rr][j] = hv[rr][j] * rstd * hm[j] + ha[j];
                o8[64 * j] = (unsigned long long)pk2(hv[rr][j].x, hv[rr][j].y) | ((unsigned long long)pk2(hv[rr][j].z, hv[rr][j].w) << 32); }
        }
        float a0[16], a1[16];
#pragma unroll
        for (int n = 0; n < 16; ++n) { float s0 = 0.f, s1 = 0.f;
#pragma unroll
            for (int j = 0; j < 4; ++j) { const f32x4 w = *(const LAS f32x4*)(wl + n * D + 256 * j + lane * 4);
                s0 += (hv[0][j].x * w.x + hv[0][j].y * w.y) + (hv[0][j].z * w.z + hv[0][j].w * w.w);
                s1 += (hv[1][j].x * w.x + hv[1][j].y * w.y) + (hv[1][j].z * w.z + hv[1][j].w * w.w); }
            a0[n] = s0; a1[n] = s1; }
        float r0, r1;
        {
            float u0[8], u1[8];
            const bool b5 = lane & 32, b4 = lane & 16, b3 = lane & 8, b2 = lane & 4;
#pragma unroll
            for (int i = 0; i < 8; ++i) { const float k0 = b5 ? a0[i + 8] : a0[i], s0 = b5 ? a0[i] : a0[i + 8]; u0[i] = k0 + __shfl_xor(s0, 32);
                const float k1 = b5 ? a1[i + 8] : a1[i], s1 = b5 ? a1[i] : a1[i + 8]; u1[i] = k1 + __shfl_xor(s1, 32); }
            float t0[4], t1[4];
#pragma unroll
            for (int i = 0; i < 4; ++i) { const float k0 = b4 ? u0[i + 4] : u0[i], s0 = b4 ? u0[i] : u0[i + 4]; t0[i] = k0 + __shfl_xor(s0, 16);
                const float k1 = b4 ? u1[i + 4] : u1[i], s1 = b4 ? u1[i] : u1[i + 4]; t1[i] = k1 + __shfl_xor(s1, 16); }
            float v0[2], v1[2];
#pragma unroll
            for (int i = 0; i < 2; ++i) { const float k0 = b3 ? t0[i + 2] : t0[i], s0 = b3 ? t0[i] : t0[i + 2]; v0[i] = k0 + __shfl_xor(s0, 8);
                const float k1 = b3 ? t1[i + 2] : t1[i], s1 = b3 ? t1[i] : t1[i + 2]; v1[i] = k1 + __shfl_xor(s1, 8); }
            { const float k0 = b2 ? v0[1] : v0[0], s0 = b2 ? v0[0] : v0[1]; r0 = k0 + __shfl_xor(s0, 4);
              const float k1 = b2 ? v1[1] : v1[0], s1 = b2 ? v1[0] : v1[1]; r1 = k1 + __shfl_xor(s1, 4); }
            r0 += __shfl_xor(r0, 2); r0 += __shfl_xor(r0, 1);
            r1 += __shfl_xor(r1, 2); r1 += __shfl_xor(r1, 1);
        }
        if ((lane & 3) == 0) { wscr[lane >> 2] = r0; wscr[16 + (lane >> 2)] = r1; }
        LDS_WAIT();
        f32x4 z0 = ba4, z1 = ba4;
#pragma unroll
        for (int n = 0; n < 16; ++n) { const f32x4 w = *(const LAS f32x4*)(wa2s + n * 256 + lane * 4); const float g0 = wscr[n], g1 = wscr[16 + n]; z0 += w * g0; z1 += w * g1; }
        LDS_WAIT();
        f32x4 l0, l1;
#pragma unroll
        for (int i = 0; i < 4; ++i) {
            l0[i] = -(fmaxf(-z0[i], 0.f) + __logf(1.0f + __expf(-fabsf(z0[i])))) * 0.0625f;
            l1[i] = -(fmaxf(-z1[i], 0.f) + __logf(1.0f + __expf(-fabsf(z1[i])))) * 0.0625f; }
        *(f32x4*)(LA + (size_t)r * 256 + lane * 4) = l0;
        *(f32x4*)(LA + (size_t)(r + 1) * 256 + lane * 4) = l1;
    }
}

constexpr int MX_KD = 0, MX_QS = 16384, MX_OCT = 33792, MX_ADEC = 37888, MX_OT = 38400;

template <bool HG, bool FIN>
__device__ __forceinline__ void mixer_unit(const Params& p, LAS unsigned char* lds, int l, int b, int h, int jg) {
    constexpr int DK = HG ? 128 : 64, KT = DK / 16, QSTR = DK + 8;
    constexpr int KCOL = HG ? C_HF : C_GK, VCOL = HG ? C_HI : C_GV, QCOL = HG ? C_HQ : C_GQ, ZCOL = HG ? C_HZ : C_GZ;
    int tid_ = threadIdx.x; asm volatile("" : "+v"(tid_));
    const int tid = tid_, lane = tid & 63, w = tid >> 6, n = lane & 15, q = lane >> 4;
    unsigned char* ws = p.ws;
    const bf16* P1 = (const bf16*)(ws + WS_P1);
    const float* LA = (const float*)(ws + WS_LOGA);
    bf16* OB = (bf16*)(ws + WS_H);
    float* SB = (float*)(ws + (HG ? WS_STATE_HG : WS_STATE)) + (size_t)((b * 4 + h) * NG + jg) * (DK * 128);
    float* PD = (float*)(ws + WS_PDEC) + (size_t)(((HG ? 0 : 8) + b * 4 + h) * NG + jg) * 128;
    LAS unsigned char* KD = lds + MX_KD;
    LAS bf16* QS = (LAS bf16*)(lds + MX_QS);
    LAS float* OCT = (LAS float*)(lds + MX_OCT);
    LAS float* ADEC = (LAS float*)(lds + MX_ADEC);
    LAS float* OT = (LAS float*)(lds + MX_OT);

    const int c = HG ? (tid & 127) : (tid & 63);
    const int o_first = HG ? (tid >> 7) : (tid >> 6);
    constexpr int NOCT = HG ? 2 : 1;
    float lb = 0.f, lbf = 1e-30f, oml = 1.0f;
    if (HG) { if (l > 0) { const float g0 = p.in[9][h * 128 + c], g1 = p.in[9][512 + h * 128 + c]; lb = 1.0f / (1.0f + __expf(g0 - g1)); lb = fminf(fmaxf(lb, 0.f), 1.0f - 1e-6f); }
        lbf = fmaxf(lb, 1e-30f); oml = 1.0f - lb; }
    float nwv[16];
    if (FIN) { const float* nwp = (HG ? p.in[10] : p.in[8]) + l * 128 + (tid & 7) * 16;
#pragma unroll
        for (int i = 0; i < 16; ++i) nwv[i] = nwp[i]; }

    f32x4 S[KT];
    if (FIN) {
#pragma unroll
        for (int kt = 0; kt < KT; ++kt) S[kt] = *(const f32x4*)(SB + (size_t)((w * KT + kt) * 64 + lane) * 4);
    } else {
#pragma unroll
        for (int kt = 0; kt < KT; ++kt) S[kt] = (f32x4){0.f, 0.f, 0.f, 0.f};
    }
    float plog = 0.f;

    for (int cc = 0; cc < G_CH; ++cc) {
        const int row0 = b * SEQ + (jg * G_CH + cc) * 64;
        bf16x8 vf[2];
#pragma unroll
        for (int ks = 0; ks < 2; ++ks)
#pragma unroll
            for (int i = 0; i < 8; ++i) vf[ks][i] = (short)P1[(size_t)(row0 + ks * 32 + q * 8 + i) * NP1 + VCOL + h * 128 + w * 16 + n];
        float la[NOCT][8], kv[NOCT][8], osum[NOCT];
#pragma unroll
        for (int oi = 0; oi < NOCT; ++oi) { const int o = o_first + 4 * oi;
#pragma unroll
            for (int i = 0; i < 8; ++i) { const size_t row = (size_t)(row0 + o * 8 + i);
                if (HG) { float zf = bf2f(P1[row * NP1 + KCOL + h * 128 + c]); zf = fminf(fmaxf(zf, -80.f), 80.f);
                    const float e = __expf(-zf), s = 1.0f / (1.0f + e);
                    la[oi][i] = __logf(lbf + oml * s); kv[oi][i] = oml * e * s; }
                else { la[oi][i] = LA[row * 256 + h * 64 + c]; kv[oi][i] = bf2f(P1[row * NP1 + KCOL + h * 64 + c]); } }
            float s = 0.f;
#pragma unroll
            for (int i = 0; i < 8; ++i) s += la[oi][i];
            osum[oi] = s; OCT[o * 128 + c] = s; }
        if (FIN) {
            constexpr int PPR = DK / 8;
#pragma unroll
            for (int pp = 0; pp < (64 * PPR) / NTHREADS; ++pp) { const int pc = tid + pp * NTHREADS, row = pc / PPR, pk = pc % PPR;
                const u32x4 v = *(const u32x4*)(P1 + (size_t)(row0 + row) * NP1 + QCOL + h * DK + pk * 8);
                *(LAS u32x4*)(QS + row * QSTR + pk * 8) = v; } }
        LDS_WAIT(); __syncthreads();
#pragma unroll
        for (int oi = 0; oi < NOCT; ++oi) { const int o = o_first + 4 * oi;
            float later = 0.f;
            for (int o2 = o + 1; o2 < 8; ++o2) later += OCT[o2 * 128 + c];
            float suf = later; unsigned pk[4]; float kd[8];
#pragma unroll
            for (int i = 7; i >= 0; --i) { kd[i] = kv[oi][i] * __expf(suf); suf += la[oi][i]; }
#pragma unroll
            for (int i = 0; i < 4; ++i) pk[i] = pk2(kd[2 * i], kd[2 * i + 1]);
            *(LAS u32x4*)(KD + (size_t)((((c >> 4) * 2 + (o >> 2)) * 64 + (o & 3) * 16 + (c & 15)) * 16)) = (u32x4){pk[0], pk[1], pk[2], pk[3]};
            if (o == 0) { ADEC[c] = __expf(suf); plog += suf; } }
        LDS_WAIT(); __syncthreads();
#pragma unroll
        for (int kt = 0; kt < KT; ++kt) { const f32x4 a4 = *(const LAS f32x4*)(ADEC + kt * 16 + q * 4); S[kt] = S[kt] * a4;
#pragma unroll
            for (int ks = 0; ks < 2; ++ks) { const bf16x8 af = *(const LAS bf16x8*)(KD + (size_t)(((kt * 2 + ks) * 64 + lane) * 16));
                S[kt] = __builtin_amdgcn_mfma_f32_16x16x32_bf16(af, vf[ks], S[kt], 0, 0, 0); } }
        if (FIN) {
            f32x4 oacc[4];
#pragma unroll
            for (int lt = 0; lt < 4; ++lt) oacc[lt] = (f32x4){0.f, 0.f, 0.f, 0.f};
#pragma unroll
            for (int kk = 0; kk < KT / 2; ++kk) {
                union { u32x4 u; bf16x8 v; } bs;
                bs.u.x = pk2(S[2 * kk][0], S[2 * kk][1]); bs.u.y = pk2(S[2 * kk][2], S[2 * kk][3]); bs.u.z = pk2(S[2 * kk + 1][0], S[2 * kk + 1][1]); bs.u.w = pk2(S[2 * kk + 1][2], S[2 * kk + 1][3]);
#pragma unroll
                for (int lt = 0; lt < 4; ++lt) {
                    union { u32x4 u; bf16x8 v; } aq;
                    const u32x2 q0 = *(const LAS u32x2*)(QS + (lt * 16 + n) * QSTR + (2 * kk) * 16 + q * 4), q1 = *(const LAS u32x2*)(QS + (lt * 16 + n) * QSTR + (2 * kk + 1) * 16 + q * 4);
                    aq.u = (u32x4){q0.x, q0.y, q1.x, q1.y};
                    oacc[lt] = __builtin_amdgcn_mfma_f32_16x16x32_bf16(aq.v, bs.v, oacc[lt], 0, 0, 0); } }
#pragma unroll
            for (int lt = 0; lt < 4; ++lt)
#pragma unroll
                for (int j = 0; j < 4; ++j) OT[(lt * 16 + q * 4 + j) * 132 + w * 16 + n] = oacc[lt][j];
            LDS_WAIT(); __syncthreads();
            { const int fl = tid >> 3, seg = tid & 7;
                f32x4 ov[4]; float ssq = 0.f;
#pragma unroll
                for (int i = 0; i < 4; ++i) { ov[i] = *(const LAS f32x4*)(OT + fl * 132 + seg * 16 + i * 4); ssq += (ov[i].x * ov[i].x + ov[i].y * ov[i].y) + (ov[i].z * ov[i].z + ov[i].w * ov[i].w); }
                ssq += __shfl_xor(ssq, 1); ssq += __shfl_xor(ssq, 2); ssq += __shfl_xor(ssq, 4);
                const float rstd = 1.0f / sqrtf(ssq * (1.0f / 128.0f) + EPS);
                const size_t row = (size_t)(row0 + fl);
                const u32x4 zg0 = *(const u32x4*)(P1 + row * NP1 + ZCOL + h * 128 + seg * 16), zg1 = *(const u32x4*)(P1 + row * NP1 + ZCOL + h * 128 + seg * 16 + 8);
                u32x4 w0, w1;
                w0.x = pk2(ov[0].x * rstd * nwv[0] * bflo(zg0.x), ov[0].y * rstd * nwv[1] * bfhi(zg0.x)); w0.y = pk2(ov[0].z * rstd * nwv[2] * bflo(zg0.y), ov[0].w * rstd * nwv[3] * bfhi(zg0.y));
                w0.z = pk2(ov[1].x * rstd * nwv[4] * bflo(zg0.z), ov[1].y * rstd * nwv[5] * bfhi(zg0.z)); w0.w = pk2(ov[1].z * rstd * nwv[6] * bflo(zg0.w), ov[1].w * rstd * nwv[7] * bfhi(zg0.w));
                w1.x = pk2(ov[2].x * rstd * nwv[8] * bflo(zg1.x), ov[2].y * rstd * nwv[9] * bfhi(zg1.x)); w1.y = pk2(ov[2].z * rstd * nwv[10] * bflo(zg1.y), ov[2].w * rstd * nwv[11] * bfhi(zg1.y));
                w1.z = pk2(ov[3].x * rstd * nwv[12] * bflo(zg1.z), ov[3].y * rstd * nwv[13] * bfhi(zg1.z)); w1.w = pk2(ov[3].z * rstd * nwv[14] * bflo(zg1.w), ov[3].w * rstd * nwv[15] * bfhi(zg1.w));
                bf16* op = OB + row * D + (HG ? 512 : 0) + h * 128 + seg * 16;
                *(u32x4*)op = w0; *(u32x4*)(op + 8) = w1; }
        }
    }
    if (!FIN) {
#pragma unroll
        for (int kt = 0; kt < KT; ++kt) *(f32x4*)(SB + (size_t)((w * KT + kt) * 64 + lane) * 4) = S[kt];
        if (o_first == 0) PD[c] = __expf(plog);
    }
    __syncthreads();
}

template <bool FIN>
__device__ __forceinline__ void phase_mixer(const Params& p, LAS unsigned char* lds, int l) {
    for (int u = blockIdx.x; u < 512; u += gridDim.x) {
        const int rem = u & 255, b = rem >> 7, h = (rem >> 5) & 3, jg = rem & 31;
        if (!FIN && jg == NG - 1) continue;
        if (u < 256) mixer_unit<true, FIN>(p, lds, l, b, h, jg); else mixer_unit<false, FIN>(p, lds, l, b, h, jg);
    }
}

__device__ __forceinline__ void phase_scan(const Params& p) {
    unsigned char* ws = p.ws;
    int tid_ = threadIdx.x; asm volatile("" : "+v"(tid_));
    const int gt = blockIdx.x * NTHREADS + tid_, NT = gridDim.x * NTHREADS;
    for (int tt = gt; tt < 8 * 4096 + 8 * 2048; tt += NT) {
        const bool hg = tt < 32768; const int t2 = hg ? tt : tt - 32768, per = hg ? 4096 : 2048, bh = t2 / per, e = t2 % per, KT = hg ? 8 : 4;
        const int kt = (e >> 6) % KT, lane = e & 63, c4 = kt * 16 + (lane >> 4) * 4;
        float* base = (float*)(ws + (hg ? WS_STATE_HG : WS_STATE)) + (size_t)bh * NG * (per * 4) + (size_t)e * 4;
        const float* pd = (const float*)(ws + WS_PDEC) + (size_t)(((hg ? 0 : 8) + bh) * NG) * 128 + c4;
        f32x4 S = (f32x4){0.f, 0.f, 0.f, 0.f};
        for (int j0 = 0; j0 < NG; j0 += 8) {
            f32x4 Lv[8], Pv[8];
#pragma unroll
            for (int j = 0; j < 8; ++j) { if (j0 + j < NG - 1) { Lv[j] = *(const f32x4*)(base + (size_t)(j0 + j) * (per * 4)); Pv[j] = *(const f32x4*)(pd + (size_t)(j0 + j) * 128); } else { Lv[j] = (f32x4){0.f, 0.f, 0.f, 0.f}; Pv[j] = Lv[j]; } }
#pragma unroll
            for (int j = 0; j < 8; ++j) { *(f32x4*)(base + (size_t)(j0 + j) * (per * 4)) = S; S = Pv[j] * S + Lv[j]; }
        }
    }
}

__device__ __forceinline__ void phase_final_norm(const Params& p) {
    int tid_ = threadIdx.x; asm volatile("" : "+v"(tid_));
    const int tid = tid_, lane = tid & 63, wave = tid >> 6;
    f32x4 nw[4];
#pragma unroll
    for (int j = 0; j < 4; ++j) nw[j] = *(const f32x4*)(p.in[15] + lane * 4 + 256 * j);
    const int gw = blockIdx.x * NWAVES + wave, NGW = gridDim.x * NWAVES;
    for (int r = gw; r < T; r += NGW) {
        f32x4* xr = (f32x4*)(p.out + (size_t)r * D) + lane;
        f32x4 v[4]; float s = 0.f;
#pragma unroll
        for (int j = 0; j < 4; ++j) { v[j] = xr[64 * j]; s += (v[j].x * v[j].x + v[j].y * v[j].y) + (v[j].z * v[j].z + v[j].w * v[j].w); }
        const float rstd = 1.0f / sqrtf(wave_sum(s) * (1.0f / D) + EPS);
#pragma unroll
        for (int j = 0; j < 4; ++j) xr[64 * j] = v[j] * rstd * nw[j];
    }
}

__global__ void __launch_bounds__(NTHREADS, 2) mega_fwd(Params p) {
    extern __shared__ __attribute__((aligned(16))) unsigned char lds_raw[];
    LAS unsigned char* lds = (LAS unsigned char*)lds_raw;
    cg::grid_group grid = cg::this_grid();
    unsigned char* ws = p.ws;
    phase_prologue(p, lds);
    grid.sync();
#pragma unroll 1
    for (int l_ = 0; l_ < DEPTH; ++l_) {
        int l = l_; asm volatile("" : "+s"(l));
        const float* xin = (l == 0) ? p.in[0] : p.out;
        phase_norm(p, lds, l, xin);
        grid.sync();
        {
            pg8::Gemm g{(const pg8::bf16_t*)(ws + WS_H), (const pg8::bf16_t*)(ws + WS_WIN) + (size_t)l * NP * D, T, NP, D};
            pg8::StaticOrder S; S.init(T, NP, (int)gridDim.x, (int)blockIdx.x);
            pg8::EpiIn E{(pg8::bf16_t*)(ws + WS_P1), (pg8::bf16_t*)(ws + WS_PG), p.in[11] + l * 2048};
            pg8::gemm_phase<pg8::EpiIn, pg8::StaticOrder, true, true>(lds, g, S, E);
        }
        grid.sync();
        phase_mixer<false>(p, lds, l);
        grid.sync();
        phase_scan(p);
        grid.sync();
        phase_mixer<true>(p, lds, l);
        grid.sync();
        {
            pg8::Gemm g{(const pg8::bf16_t*)(ws + WS_H), (const pg8::bf16_t*)(ws + WS_WUP) + (size_t)l * D * D, T, D, D};
            pg8::StaticOrder S; S.init(T, D, (int)gridDim.x, (int)blockIdx.x);
            pg8::EpiUp E{(const pg8::bf16_t*)(ws + WS_PG), (pg8::bf16_t*)(ws + WS_P1)};
            pg8::gemm_phase<pg8::EpiUp, pg8::StaticOrder, true, true>(lds, g, S, E);
        }
        grid.sync();
        {
            pg8::Gemm g{(const pg8::bf16_t*)(ws + WS_P1), (const pg8::bf16_t*)(ws + WS_WOUT) + (size_t)l * D * D, T, D, D};
            pg8::StaticOrder S; S.init(T, D, (int)gridDim.x, (int)blockIdx.x);
            pg8::EpiOut E{xin, p.out, (const float*)(ws + WS_MOD) + (size_t)l * BATCH * 3072 + 2048};
            pg8::gemm_phase<pg8::EpiOut, pg8::StaticOrder, true, true>(lds, g, S, E);
        }
        grid.sync();
    }
    phase_final_norm(p);
}

extern "C" void kernel_launch(void* const* d_in, const int* in_sizes, int n_in, void* d_out, int out_size, void* d_ws, size_t ws_size, hipStream_t stream) {
    static int grid = 0;
    if (grid == 0) {
        if (n_in != 16 || in_sizes[0] != T * D || out_size != T * D || ws_size < WS_END) { fprintf(stderr, "kernel_launch: unexpected shapes (n_in %d, in0 %d, out %d, ws %zu)\n", n_in, n_in > 0 ? in_sizes[0] : -1, out_size, ws_size); grid = -1; return; }
        int dev = 0, cus = 0, per_cu = 0;
        if (hipGetDevice(&dev) != hipSuccess || hipDeviceGetAttribute(&cus, hipDeviceAttributeMultiprocessorCount, dev) != hipSuccess) { fprintf(stderr, "kernel_launch: device query failed\n"); grid = -1; return; }
        if (hipFuncSetAttribute((const void*)mega_fwd, hipFuncAttributeMaxDynamicSharedMemorySize, LDS_BYTES) != hipSuccess) { fprintf(stderr, "kernel_launch: hipFuncSetAttribute failed\n"); grid = -1; return; }
        if (hipOccupancyMaxActiveBlocksPerMultiprocessor(&per_cu, (const void*)mega_fwd, NTHREADS, LDS_BYTES) != hipSuccess || per_cu < 1) { fprintf(stderr, "kernel_launch: occupancy query failed (%d)\n", per_cu); (void)hipGetLastError(); per_cu = 1; }
        grid = cus * per_cu;
    }
    if (grid < 0) return;
    Params p{};
    for (int i = 0; i < 16; ++i) p.in[i] = (const float*)d_in[i];
    p.out = (float*)d_out; p.ws = (unsigned char*)d_ws;
    void* args[] = {&p};
    const hipError_t e = hipLaunchCooperativeKernel((const void*)mega_fwd, dim3(grid), dim3(NTHREADS), args, LDS_BYTES, stream);
    if (e != hipSuccess) fprintf(stderr, "kernel_launch: cooperative launch failed: %s (grid %d)\n", hipGetErrorString(e), grid);
}
```

```cpp
#include <hip/hip_runtime.h>
#include <hip/hip_cooperative_groups.h>
#include <cstdio>
#include <cstdint>
namespace cg = cooperative_groups;
namespace pg8 {
#define PG8_LAS __attribute__((address_space(3)))
typedef unsigned short bf16_t;
typedef short bf16x8 __attribute__((ext_vector_type(8)));
typedef float f32x4 __attribute__((ext_vector_type(4)));
typedef unsigned u32x4 __attribute__((ext_vector_type(4)));
constexpr int BM = 256, BK = 64, HALF = 128, HTB = HALF * BK * 2  , STAGE_BYTES = 8 * HTB, NXCD = 8, WGM = 8;

__host__ __device__ __forceinline__ int lds_byte(int r, int c) { const int st = (r >> 4) * 2 + (c >> 5), rr = r & 15, cc = c & 31, ob = rr * 64 + cc * 2; return st * 1024 + (ob ^ (((ob >> 9) & 1) << 5)); }
__host__ __device__ __forceinline__ void stage_rc(int b, int& R, int& C) { const int st = b / 1024, sb = b % 1024, swz = sb ^ (((sb >> 9) & 1) << 5); R = (st >> 1) * 16 + swz / 64; C = (st & 1) * 32 + (swz % 64) / 2; }
__host__ __device__ __forceinline__ int perm32(int rho) { const int n = rho >> 4, i = rho & 15; return 8 * (i >> 2) + 4 * n + (i & 3); }

struct Unit { int pm, pn; };
struct Gemm { const bf16_t* A; const bf16_t* Bt; int M, N, K; };

struct StaticOrder {
    int nM, nN, nwg, G, c;
    __host__ __device__ void init(int M, int N, int G_, int c_) { nM = M / BM; nN = N / BM; nwg = nM * nN; G = G_; c = c_; }
    __host__ __device__ bool next(int i, Unit& u) const {
        const long L = (long)i * G + c; if (L >= nwg) return false;
        int wgid = (int)L; { const int q = nwg / NXCD, r = nwg % NXCD, xcd = wgid % NXCD, off = wgid / NXCD; wgid = (xcd < r ? xcd * (q + 1) : r * (q + 1) + (xcd - r) * q) + off; }
        const int nig = WGM * nN, gid = wgid / nig, fm = gid * WGM, gsz = (nM - fm) < WGM ? (nM - fm) : WGM;
        u.pm = fm + ((wgid % nig) % gsz); u.pn = (wgid % nig) / gsz; return true;
    }
    __device__ __forceinline__ void a_ready(const Unit&) const {}
    __device__ __forceinline__ void done(const Unit&) const {}
};
__device__ __forceinline__ unsigned cvt_pk_bf16(float lo, float hi) { unsigned r; asm volatile("v_cvt_pk_bf16_f32 %0, %1, %2" : "=v"(r) : "v"(lo), "v"(hi)); return r; }
template <class Epi, class Sched, bool ALIGN_EPI = false, bool SP2 = false>
__device__ __forceinline__ void gemm_phase(PG8_LAS unsigned char* lds, const Gemm g, const Sched& S, const Epi& E) {
    int tid_ = threadIdx.x; asm volatile("" : "+v"(tid_));
    const int tid = tid_, wid = __builtin_amdgcn_readfirstlane(tid >> 6), lane = tid & 63, wr = wid >> 2, wc = wid & 3, fr = lane & 15, fq = lane >> 4;
    const int K = g.K, nt = K / BK;
    unsigned voffA[2], voffB[2];
#pragma unroll
    for (int i = 0; i < 2; ++i) { int R, C; stage_rc(tid * 16 + i * 8192, R, C); const int Rb = Epi::PERM ? ((R & ~31) + perm32(R & 31)) : R;
        voffA[i] = (unsigned)(R * K + C) * 2u; voffB[i] = (unsigned)(Rb * K + C) * 2u; }
    const size_t kstep = (size_t)(BK * 2);
    const size_t hstep = (size_t)HALF * K * 2;
    const size_t tstep = 2 * hstep;
    const unsigned ldsw = (unsigned)wid * 1024u;
    const int aoff = lds_byte(wr * 64 + fr, fq * 8), boff = lds_byte(wc * 32 + fr, fq * 8);
#define PG8_SA(b, h) (((b) * 2 + (h)) * HTB)
#define PG8_SB(b, h) ((4 + (b) * 2 + (h)) * HTB)
#define PG8_STAGE(bufoff, gbase, voff) do { _Pragma("unroll") for (int _i = 0; _i < 2; ++_i) \
        __builtin_amdgcn_global_load_lds((const unsigned*)((const char*)(gbase) + (voff)[_i]), (PG8_LAS unsigned*)(lds + (bufoff) + ldsw + _i * 8192), 16, 0, 0); } while (0)
#define PG8_LDA(dst, b, h) do { _Pragma("unroll") for (int m = 0; m < 4; ++m) _Pragma("unroll") for (int k = 0; k < 2; ++k) dst[m][k] = *(const PG8_LAS bf16x8*)(lds + PG8_SA(b, h) + aoff + m * 2048 + k * 1024); } while (0)
#define PG8_LDB(dst, b, h) do { _Pragma("unroll") for (int n = 0; n < 2; ++n) _Pragma("unroll") for (int k = 0; k < 2; ++k) dst[n][k] = *(const PG8_LAS bf16x8*)(lds + PG8_SB(b, h) + boff + n * 2048 + k * 1024); } while (0)
#define PG8_MMA(ai, bj, At, Bt) do { __builtin_amdgcn_s_setprio(1); _Pragma("unroll") for (int m = 0; m < 4; ++m) _Pragma("unroll") for (int n = 0; n < 2; ++n) _Pragma("unroll") for (int k = 0; k < 2; ++k) \
        acc[ai][bj][m][n] = __builtin_amdgcn_mfma_f32_16x16x32_bf16(Bt[n][k], At[m][k], acc[ai][bj][m][n], 0, 0, 0); __builtin_amdgcn_s_setprio(0); } while (0)
#define PG8_WAIT_V(n) asm volatile("s_waitcnt vmcnt(" #n ")" ::: "memory")
#define PG8_WAIT_L(n) asm volatile("s_waitcnt lgkmcnt(" #n ")" ::: "memory")
#define PG8_BAR __builtin_amdgcn_s_barrier()
#define PG8_SCHED __builtin_amdgcn_sched_barrier(0)
    Unit cur, nxt; int ui = 0;
    if (!S.next(0, cur)) return;
    f32x4 acc[2][2][4][2];
#pragma unroll
    for (int a = 0; a < 2; ++a)
#pragma unroll
        for (int b = 0; b < 2; ++b)
#pragma unroll
            for (int m = 0; m < 4; ++m)
#pragma unroll
                for (int n = 0; n < 2; ++n) acc[a][b][m][n] = (f32x4){0.f, 0.f, 0.f, 0.f};
    bf16x8 At[4][2], B0[2][2], B1[2][2];
    const char* cA = (const char*)g.A + (size_t)cur.pm * tstep; const char* cB = (const char*)g.Bt + (size_t)cur.pn * tstep;
    S.a_ready(cur);
    if constexpr (SP2) {
        PG8_STAGE(PG8_SB(0, 0), cB, voffB); PG8_STAGE(PG8_SB(0, 1), cB + hstep, voffB); PG8_STAGE(PG8_SA(0, 0), cA, voffA); PG8_STAGE(PG8_SA(0, 1), cA + hstep, voffA);
        if (wr == 1) PG8_BAR;
        PG8_WAIT_V(2); PG8_BAR;
        PG8_STAGE(PG8_SB(1, 0), cB + kstep, voffB); PG8_STAGE(PG8_SA(1, 0), cA + kstep, voffA); PG8_STAGE(PG8_SB(1, 1), cB + hstep + kstep, voffB);
        PG8_WAIT_V(6); PG8_BAR;
    } else {
        PG8_STAGE(PG8_SB(0, 0), cB, voffB); PG8_STAGE(PG8_SA(0, 0), cA, voffA); PG8_STAGE(PG8_SB(0, 1), cB + hstep, voffB); PG8_STAGE(PG8_SA(0, 1), cA + hstep, voffA);
        if (wr == 1) PG8_BAR;
        PG8_WAIT_V(4); PG8_BAR;
        PG8_STAGE(PG8_SB(1, 0), cB + kstep, voffB); PG8_STAGE(PG8_SA(1, 0), cA + kstep, voffA); PG8_STAGE(PG8_SB(1, 1), cB + hstep + kstep, voffB);
        PG8_WAIT_V(6); PG8_BAR;
    }
    for (;;) {
        const bool has_next = S.next(ui + 1, nxt);
        const char* nA = has_next ? (const char*)g.A + (size_t)nxt.pm * tstep : cA; const char* nB = has_next ? (const char*)g.Bt + (size_t)nxt.pn * tstep : cB;
        for (int t = 0; t < nt; t += 2) {
            const bool last = (t == nt - 2);
            const char* a1 = cA + (size_t)(t + 1) * kstep;
            const char* a2 = last ? nA : cA + (size_t)(t + 2) * kstep; const char* b2 = last ? nB : cB + (size_t)(t + 2) * kstep;
            const char* a3 = a2 + kstep; const char* b3 = b2 + kstep;
            if (last && has_next) S.a_ready(nxt);
            if constexpr (Epi::MID) { if (t == nt / 2) E.mid(acc, cur, wr, wc, fr, fq); }
            if constexpr (SP2) {
            PG8_LDB(B0, 0, 0); PG8_LDB(B1, 0, 1); PG8_SCHED; PG8_LDA(At, 0, 0); PG8_STAGE(PG8_SA(1, 1), a1 + hstep, voffA);
            PG8_WAIT_V(8); PG8_WAIT_L(0); PG8_BAR; PG8_MMA(0, 0, At, B0); PG8_MMA(0, 1, At, B1); PG8_BAR; PG8_SCHED;
            PG8_LDA(At, 0, 1); PG8_STAGE(PG8_SB(0, 0), b2, voffB); PG8_STAGE(PG8_SB(0, 1), b2 + hstep, voffB); PG8_STAGE(PG8_SA(0, 0), a2, voffA);
            PG8_WAIT_V(8); PG8_WAIT_L(0); PG8_BAR; PG8_MMA(1, 0, At, B0); PG8_MMA(1, 1, At, B1); PG8_BAR; PG8_SCHED;
            PG8_LDB(B0, 1, 0); PG8_LDB(B1, 1, 1); PG8_SCHED; PG8_LDA(At, 1, 0); PG8_STAGE(PG8_SA(0, 1), a2 + hstep, voffA);
            PG8_WAIT_V(8); PG8_WAIT_L(0); PG8_BAR; PG8_MMA(0, 0, At, B0); PG8_MMA(0, 1, At, B1); PG8_BAR; PG8_SCHED;
            PG8_LDA(At, 1, 1); PG8_STAGE(PG8_SB(1, 0), b3, voffB); PG8_STAGE(PG8_SB(1, 1), b3 + hstep, voffB); PG8_STAGE(PG8_SA(1, 0), a3, voffA);
            PG8_WAIT_V(8); PG8_WAIT_L(0); PG8_BAR; PG8_MMA(1, 0, At, B0); PG8_MMA(1, 1, At, B1); PG8_BAR; PG8_SCHED;
            } else {
            PG8_LDB(B0, 0, 0); PG8_SCHED; PG8_LDA(At, 0, 0); PG8_STAGE(PG8_SA(1, 1), a1 + hstep, voffA);
            PG8_WAIT_L(8); PG8_BAR; PG8_WAIT_L(0); PG8_MMA(0, 0, At, B0); PG8_BAR; PG8_SCHED;
            PG8_LDB(B1, 0, 1); PG8_STAGE(PG8_SB(0, 0), b2, voffB);
            PG8_BAR; PG8_WAIT_L(0); PG8_MMA(0, 1, At, B1); PG8_BAR;
            PG8_LDA(At, 0, 1); PG8_STAGE(PG8_SA(0, 0), a2, voffA);
            PG8_BAR; PG8_WAIT_L(0); PG8_MMA(1, 0, At, B0); PG8_BAR; PG8_SCHED;
            PG8_STAGE(PG8_SB(0, 1), b2 + hstep, voffB);
            PG8_WAIT_V(6); PG8_BAR; PG8_MMA(1, 1, At, B1); PG8_BAR;
            PG8_LDB(B0, 1, 0); PG8_SCHED; PG8_LDA(At, 1, 0); PG8_STAGE(PG8_SA(0, 1), a2 + hstep, voffA);
            PG8_WAIT_L(8); PG8_BAR; PG8_WAIT_L(0); PG8_MMA(0, 0, At, B0); PG8_BAR; PG8_SCHED;
            PG8_LDB(B1, 1, 1); PG8_STAGE(PG8_SB(1, 0), b3, voffB);
            PG8_BAR; PG8_WAIT_L(0); PG8_MMA(0, 1, At, B1); PG8_BAR;
            PG8_LDA(At, 1, 1); PG8_STAGE(PG8_SA(1, 0), a3, voffA);
            PG8_BAR; PG8_WAIT_L(0); PG8_MMA(1, 0, At, B0); PG8_BAR; PG8_SCHED;
            PG8_STAGE(PG8_SB(1, 1), b3 + hstep, voffB);
            PG8_WAIT_V(6); PG8_BAR; PG8_MMA(1, 1, At, B1); PG8_BAR;
            }
        }
        if constexpr (ALIGN_EPI) { if (wr == 0) PG8_BAR; }
        if constexpr (!Epi::AFTER_DRAIN) { E(acc, cur, wr, wc, fr, fq); S.done(cur); }
        if (!has_next) break;
#pragma unroll
        for (int a = 0; a < 2; ++a)
#pragma unroll
            for (int b = 0; b < 2; ++b)
#pragma unroll
                for (int m = 0; m < 4; ++m)
#pragma unroll
                    for (int n = 0; n < 2; ++n) acc[a][b][m][n] = (f32x4){0.f, 0.f, 0.f, 0.f};
        cur = nxt; cA = nA; cB = nB; ++ui;
        if constexpr (ALIGN_EPI) { if (wr == 1) PG8_BAR; }
    }
    PG8_WAIT_V(0);
    if constexpr (!ALIGN_EPI) { if (wr == 0) PG8_BAR; }
    PG8_BAR;
    if constexpr (Epi::AFTER_DRAIN) { E.fused(acc, cur, wr, wc, fr, fq, lds, wid, lane); S.done(cur); }
#undef PG8_SA
#undef PG8_SB
#undef PG8_STAGE
#undef PG8_LDA
#undef PG8_LDB
#undef PG8_MMA
#undef PG8_WAIT_V
#undef PG8_WAIT_L
#undef PG8_BAR
#undef PG8_SCHED
}
}

#define LAS __attribute__((address_space(3)))
typedef unsigned short bf16;
typedef float f32x4 __attribute__((ext_vector_type(4)));
typedef short bf16x8 __attribute__((ext_vector_type(8)));
typedef unsigned u32x4 __attribute__((ext_vector_type(4)));
typedef unsigned u32x2 __attribute__((ext_vector_type(2)));

constexpr int D = 1024, BATCH = 2, SEQ = 16384, T = BATCH * SEQ, DEPTH = 2;
constexpr int IN_TOTAL = 5648, NP = 5632, NP1 = 3584, NPG = 2048;
constexpr int G_CH = 8;
constexpr int NCHUNK = SEQ / 64;
constexpr int NG = NCHUNK / G_CH;
constexpr int NTHREADS = 512, NWAVES = 8;
constexpr int LDS_BYTES = 147456;
constexpr float EPS = 1e-6f;

constexpr int C_GQ = 0, C_GK = 256, C_GV = 512, C_GZ = 1024, C_HQ = 1536, C_HF = 2048, C_HI = 2560, C_HZ = 3072;

constexpr size_t MiB = 1u << 20;
constexpr size_t WS_MOD = 0;
constexpr size_t WS_BAR = 512 * 1024;
constexpr size_t WS_WIN = 1 * MiB;
constexpr size_t WS_WUP = 23 * MiB;
constexpr size_t WS_WOUT = 27 * MiB;
constexpr size_t WS_STATE = 32 * MiB;
constexpr size_t WS_STATE_HG = WS_STATE + 8 * MiB;
constexpr size_t WS_PDEC = 56 * MiB;
constexpr size_t WS_LOGA = 64 * MiB;
constexpr size_t WS_H = 96 * MiB;
constexpr size_t WS_P1 = 160 * MiB;
constexpr size_t WS_PG = 384 * MiB;
constexpr size_t WS_END = 512 * MiB;

struct Params { const float* in[16]; float* out; unsigned char* ws; };

__device__ __forceinline__ float bf2f(unsigned short b) { return __builtin_bit_cast(float, (unsigned)b << 16); }
__device__ __forceinline__ float bflo(unsigned w) { return __builtin_bit_cast(float, w << 16); }
__device__ __forceinline__ float bfhi(unsigned w) { return __builtin_bit_cast(float, w & 0xffff0000u); }
__device__ __forceinline__ unsigned f2bf(float f) { unsigned u = __builtin_bit_cast(unsigned, f); return (u + 0x7fffu + ((u >> 16) & 1u)) >> 16; }
__device__ __forceinline__ unsigned pk2(float lo, float hi) { return f2bf(lo) | (f2bf(hi) << 16); }
__device__ __forceinline__ float sigmoidf_(float x) { return 1.0f / (1.0f + __expf(-x)); }
__device__ __forceinline__ float wave_sum(float v) {
#pragma unroll
    for (int o = 1; o < 64; o <<= 1) v += __shfl_xor(v, o);
    return v;
}
#define LDS_WAIT() asm volatile("s_waitcnt lgkmcnt(0)" ::: "memory")

namespace pg8 {
struct EpiIn {
    static constexpr bool PERM = true, AFTER_DRAIN = false, MID = false;
    bf16_t* P1; bf16_t* PG; const float* bias;
    __device__ __forceinline__ void operator()(const f32x4 (&acc)[2][2][4][2], const Unit& u, int wr, int wc, int fr, int fq) const {
        const int pn = u.pn;
        const int row0 = u.pm * BM + wr * 64 + fr;
        if (pn >= 14) {
            const int ch0 = (pn - 14) * 128 + wc * 32 + 8 * fq;
            f32x4 ba[2], bb[2];
#pragma unroll
            for (int n = 0; n < 2; ++n) { ba[n] = *(const f32x4*)(bias + ch0 + 4 * n); bb[n] = *(const f32x4*)(bias + 1024 + ch0 + 4 * n); }
#pragma unroll
            for (int ai = 0; ai < 2; ++ai)
#pragma unroll
                for (int m = 0; m < 4; ++m) { bf16_t* rowp = PG + (size_t)(row0 + ai * HALF + m * 16) * NPG + ch0;
                    f32x4 r[2], g[2];
#pragma unroll
                    for (int n = 0; n < 2; ++n) { const f32x4 a = acc[ai][0][m][n] + ba[n], b = acc[ai][1][m][n] + bb[n];
#pragma unroll
                        for (int j = 0; j < 4; ++j) { const float ea = __expf(-a[j]), eb = __expf(-b[j]); g[n][j] = __builtin_amdgcn_rcpf(1.0f + eb); r[n][j] = (1.0f + eb) * __builtin_amdgcn_rcpf(1.0f + ea); } }
                    u32x4 w; w.x = cvt_pk_bf16(r[0][0], r[0][1]); w.y = cvt_pk_bf16(r[0][2], r[0][3]); w.z = cvt_pk_bf16(r[1][0], r[1][1]); w.w = cvt_pk_bf16(r[1][2], r[1][3]);
                    *(u32x4*)rowp = w;
                    w.x = cvt_pk_bf16(g[0][0], g[0][1]); w.y = cvt_pk_bf16(g[0][2], g[0][3]); w.z = cvt_pk_bf16(g[1][0], g[1][1]); w.w = cvt_pk_bf16(g[1][2], g[1][3]);
                    *(u32x4*)(rowp + 1024) = w; }
            return;
        }
        int mode = 0; float scl = 1.0f;
        if (pn == 0) scl = 0.125f;
        else if (pn == 4 || pn == 5 || pn == 12 || pn == 13) mode = 1;
        else if (pn == 6 || pn == 7) { mode = 1; scl = 0.08838834764831845f; }
        const int col0 = pn * 256 + wc * 32 + 8 * fq;
#pragma unroll
        for (int ai = 0; ai < 2; ++ai)
#pragma unroll
            for (int m = 0; m < 4; ++m) { bf16_t* rowp = P1 + (size_t)(row0 + ai * HALF + m * 16) * NP1 + col0;
#pragma unroll
                for (int bj = 0; bj < 2; ++bj) { f32x4 v0 = acc[ai][bj][m][0], v1 = acc[ai][bj][m][1];
                    if (mode == 0) { v0 = v0 * scl; v1 = v1 * scl; }
                    else {
#pragma unroll
                        for (int j = 0; j < 4; ++j) { v0[j] = v0[j] * scl * __builtin_amdgcn_rcpf(1.0f + __expf(-v0[j])); v1[j] = v1[j] * scl * __builtin_amdgcn_rcpf(1.0f + __expf(-v1[j])); } }
                    u32x4 w; w.x = cvt_pk_bf16(v0[0], v0[1]); w.y = cvt_pk_bf16(v0[2], v0[3]); w.z = cvt_pk_bf16(v1[0], v1[1]); w.w = cvt_pk_bf16(v1[2], v1[3]);
                    *(u32x4*)(rowp + bj * HALF) = w; } }
    }
};
struct EpiUp {
    static constexpr bool PERM = true, AFTER_DRAIN = false, MID = true;
    const bf16_t* PG; bf16_t* Mo;
    __device__ __forceinline__ void mid(f32x4 (&acc)[2][2][4][2], const Unit& u, int wr, int wc, int fr_, int fq) const {
        int fr = fr_; asm volatile("" : "+v"(fr));
        const int row0 = u.pm * BM + wr * 64 + fr, col0 = u.pn * BM + wc * 32 + 8 * fq;
#pragma unroll
        for (int ai = 0; ai < 2; ++ai) {
            u32x4 rv[4][2];
#pragma unroll
            for (int m = 0; m < 4; ++m) { const bf16_t* gp = PG + (size_t)(row0 + ai * HALF + m * 16) * NPG + col0;
#pragma unroll
                for (int bj = 0; bj < 2; ++bj) rv[m][bj] = *(const u32x4*)(gp + bj * HALF); }
#pragma unroll
            for (int m = 0; m < 4; ++m)
#pragma unroll
                for (int bj = 0; bj < 2; ++bj) { const u32x4 ga = rv[m][bj];
                    acc[ai][bj][m][0] = acc[ai][bj][m][0] * (f32x4){bflo(ga.x), bfhi(ga.x), bflo(ga.y), bfhi(ga.y)};
                    acc[ai][bj][m][1] = acc[ai][bj][m][1] * (f32x4){bflo(ga.z), bfhi(ga.z), bflo(ga.w), bfhi(ga.w)}; }
            __builtin_amdgcn_sched_barrier(0);
        }
    }
    __device__ __forceinline__ void operator()(const f32x4 (&acc)[2][2][4][2], const Unit& u, int wr, int wc, int fr, int fq) const {
        const int row0 = u.pm * BM + wr * 64 + fr, col0 = u.pn * BM + wc * 32 + 8 * fq;
#pragma unroll
        for (int ai = 0; ai < 2; ++ai)
#pragma unroll
            for (int m = 0; m < 4; ++m) { const size_t row = (size_t)(row0 + ai * HALF + m * 16); const bf16_t* gp = PG + row * NPG + 1024 + col0; bf16_t* op = Mo + row * D + col0;
#pragma unroll
                for (int bj = 0; bj < 2; ++bj) { const u32x4 gb = *(const u32x4*)(gp + bj * HALF);
                    const f32x4 a0 = acc[ai][bj][m][0], a1 = acc[ai][bj][m][1];
                    u32x4 w; w.x = cvt_pk_bf16(a0[0] * bflo(gb.x), a0[1] * bfhi(gb.x)); w.y = cvt_pk_bf16(a0[2] * bflo(gb.y), a0[3] * bfhi(gb.y));
                    w.z = cvt_pk_bf16(a1[0] * bflo(gb.z), a1[1] * bfhi(gb.z)); w.w = cvt_pk_bf16(a1[2] * bflo(gb.w), a1[3] * bfhi(gb.w));
                    *(u32x4*)(op + bj * HALF) = w; } }
    }
};
struct EpiOut {
    static constexpr bool PERM = false, AFTER_DRAIN = false, MID = false;
    const float* xin; float* out; const float* gate2;
    __device__ __forceinline__ void operator()(const f32x4 (&acc)[2][2][4][2], const Unit& u, int wr, int wc, int fr, int fq) const {
        const int row0 = u.pm * BM + wr * 64 + fr, col0 = u.pn * BM + wc * 32 + 4 * fq;
        const float* gate = gate2 + ((u.pm * BM) / SEQ) * 3072;
        f32x4 gv[2][2];
#pragma unroll
        for (int bj = 0; bj < 2; ++bj)
#pragma unroll
            for (int n = 0; n < 2; ++n) gv[bj][n] = *(const f32x4*)(gate + col0 + bj * HALF + n * 16);
#pragma unroll
        for (int ai = 0; ai < 2; ++ai)
#pragma unroll
            for (int m = 0; m < 4; ++m) { const size_t off = (size_t)(row0 + ai * HALF + m * 16) * D + col0;
#pragma unroll
                for (int bj = 0; bj < 2; ++bj)
#pragma unroll
                    for (int n = 0; n < 2; ++n) { const f32x4 xv = *(const f32x4*)(xin + off + bj * HALF + n * 16);
                        *(f32x4*)(out + off + bj * HALF + n * 16) = xv + gv[bj][n] * acc[ai][bj][m][n]; } }
    }
};
}

__device__ __forceinline__ void transpose_item(const float* W, int ldw, int src_col0, int k0, bf16* WT, int dst_row0, int dst_k0, LAS float* scr, int lane) {
#pragma unroll
    for (int i = 0; i < 32; ++i) { const int kk = 2 * i + (lane >> 5); scr[kk * 33 + (lane & 31)] = W[(size_t)(k0 + kk) * ldw + src_col0 + (lane & 31)]; }
    LDS_WAIT();
    const int c = lane & 7;
#pragma unroll
    for (int j = 0; j < 4; ++j) { const int n = (lane >> 3) + 8 * j; const LAS float* s = scr + (8 * c) * 33 + n;
        u32x4 o; o.x = pk2(s[0 * 33], s[1 * 33]); o.y = pk2(s[2 * 33], s[3 * 33]); o.z = pk2(s[4 * 33], s[5 * 33]); o.w = pk2(s[6 * 33], s[7 * 33]);
        *(u32x4*)(WT + (size_t)(dst_row0 + n) * D + dst_k0 + 8 * c) = o; }
    LDS_WAIT();
}

__device__ __forceinline__ void phase_prologue(const Params& p, LAS unsigned char* lds) {
    int tid_ = threadIdx.x; asm volatile("" : "+v"(tid_));
    const int tid = tid_, lane = tid & 63, wave = tid >> 6;
    unsigned char* ws = p.ws;
    for (int task = blockIdx.x; task < DEPTH * 96; task += gridDim.x) {
        const int l = task / 96, cgp = task % 96, col = tid & 31, ks = tid >> 5;
        const float* W = p.in[3] + (size_t)l * D * 3072 + cgp * 32 + col;
        const float* c0 = p.in[1], *c1 = p.in[1] + D;
        float s0 = 0.f, s1 = 0.f;
#pragma unroll 16
        for (int k = ks * 64; k < ks * 64 + 64; ++k) { const float w = W[(size_t)k * 3072]; const float a = c0[k], b = c1[k];
            s0 += a * sigmoidf_(a) * w; s1 += b * sigmoidf_(b) * w; }
        LAS float* red = (LAS float*)(lds + 98304);
        red[(ks * 32 + col) * 2 + 0] = s0; red[(ks * 32 + col) * 2 + 1] = s1;
        __syncthreads();
        if (tid < 64) { const int cc = tid & 31, bb = tid >> 5; float s = 0.f;
#pragma unroll
            for (int k = 0; k < 16; ++k) s += red[(k * 32 + cc) * 2 + bb];
            const int cglob = cgp * 32 + cc;
            ((float*)(ws + WS_MOD))[(l * BATCH + bb) * 3072 + cglob] = s + p.in[4][l * 3072 + cglob]; }
        __syncthreads();
    }
    LAS float* scr = (LAS float*)(lds + wave * 8704);
    const int gw = blockIdx.x * NWAVES + wave, NGW = gridDim.x * NWAVES;
    constexpr int I_IN = 16 * 176, I_UP = 8 * 32, I_OUT = 16 * 32, I_L = I_IN + 2 * I_UP + I_OUT;
    for (int it = gw; it < DEPTH * I_L; it += NGW) {
        const int l = it / I_L; int r = it % I_L;
        if (r < I_IN) { const int kb = r / 176, nb = r % 176, n0 = 32 * nb;
            transpose_item(p.in[5] + (size_t)l * D * IN_TOTAL, IN_TOTAL, n0 < 1536 ? n0 : (n0 < 3584 ? n0 + 16 : 3600 + (((n0 - 3584) >> 7) & 1) * 1024 + ((n0 - 3584) >> 8) * 128 + (n0 & 127)), 64 * kb, (bf16*)(ws + WS_WIN) + (size_t)l * NP * D, n0, 64 * kb, scr, lane); continue; }
        r -= I_IN;
        if (r < I_UP) { const int kb = r / 32, nb = r % 32;
            transpose_item(p.in[12] + (size_t)l * 512 * D, D, 32 * nb, 64 * kb, (bf16*)(ws + WS_WUP) + (size_t)l * D * D, 32 * nb, 64 * kb, scr, lane); continue; }
        r -= I_UP;
        if (r < I_UP) { const int kb = r / 32, nb = r % 32;
            transpose_item(p.in[13] + (size_t)l * 512 * D, D, 32 * nb, 64 * kb, (bf16*)(ws + WS_WUP) + (size_t)l * D * D, 32 * nb, 512 + 64 * kb, scr, lane); continue; }
        r -= I_UP;
        { const int kb = r / 32, nb = r % 32;
            transpose_item(p.in[14] + (size_t)l * D * D, D, 32 * nb, 64 * kb, (bf16*)(ws + WS_WOUT) + (size_t)l * D * D, 32 * nb, 64 * kb, scr, lane); }
    }
}

__device__ __forceinline__ void phase_norm(const Params& p, LAS unsigned char* lds, int l, const float* xin) {
    int tid_ = threadIdx.x; asm volatile("" : "+v"(tid_));
    const int tid = tid_, lane = tid & 63, wave = tid >> 6;
    unsigned char* ws = p.ws;
    LAS float* wl = (LAS float*)lds;
    LAS float* wa2s = (LAS float*)(lds + 65536);
    LAS float* wscr = (LAS float*)(lds + 81920) + wave * 32;
    for (int k = tid; k < D; k += NTHREADS) { const float* src = p.in[5] + (size_t)l * D * IN_TOTAL + (size_t)k * IN_TOTAL + 1536;
#pragma unroll
        for (int q4 = 0; q4 < 4; ++q4) { const f32x4 v = *(const f32x4*)(src + 4 * q4);
#pragma unroll
            for (int i = 0; i < 4; ++i) wl[(q4 * 4 + i) * D + k] = v[i]; } }
    for (int i = tid; i < 16 * 256; i += NTHREADS) wa2s[i] = p.in[6][l * 4096 + i];
    __syncthreads();
    f32x4 nw[4];
#pragma unroll
    for (int j = 0; j < 4; ++j) nw[j] = *(const f32x4*)(p.in[2] + l * D + lane * 4 + 256 * j);
    const f32x4 ba4 = *(const f32x4*)(p.in[7] + l * 256 + lane * 4);
    const float* mod = (const float*)(ws + WS_MOD) + (size_t)l * BATCH * 3072;
    bf16* H = (bf16*)(ws + WS_H); float* LA = (float*)(ws + WS_LOGA);
    const int gw = blockIdx.x * NWAVES + wave, NGW = gridDim.x * NWAVES;
    for (int r = gw * 2; r < T; r += NGW * 2) {
        const int b = r / SEQ;
        f32x4 hm[4], ha[4];
#pragma unroll
        for (int j = 0; j < 4; ++j) { ha[j] = *(const f32x4*)(mod + b * 3072 + lane * 4 + 256 * j); const f32x4 sc = *(const f32x4*)(mod + b * 3072 + 1024 + lane * 4 + 256 * j); hm[j] = nw[j] * (1.0f + sc); }
        f32x4 hv[2][4];
#pragma unroll
        for (int rr = 0; rr < 2; ++rr) {
            const f32x4* xr = (const f32x4*)(xin + (size_t)(r + rr) * D) + lane;
            float s = 0.f;
#pragma unroll
            for (int j = 0; j < 4; ++j) { hv[rr][j] = xr[64 * j]; s += (hv[rr][j].x * hv[rr][j].x + hv[rr][j].y * hv[rr][j].y) + (hv[rr][j].z * hv[rr][j].z + hv[rr][j].w * hv[rr][j].w); }
            const float rstd = 1.0f / sqrtf(wave_sum(s) * (1.0f / D) + EPS);
            unsigned long long* o8 = (unsigned long long*)(H + (size_t)(r + rr) * D) + lane;
#pragma unroll
            for (int j = 0; j < 4; ++j) { hv[rr][j] = hv[rr][j] * rstd * hm[j] + ha[j];
                o8[64 * j] = (unsigned long long)pk2(hv[rr][j].x, hv[rr][j].y) | ((unsigned long long)pk2(hv[rr][j].z, hv[rr][j].w) << 32); }
        }
        float a0[16], a1[16];
#pragma unroll
        for (int n = 0; n < 16; ++n) { float s0 = 0.f, s1 = 0.f;
#pragma unroll
            for (int j = 0; j < 4; ++j) { const f32x4 w = *(const LAS f32x4*)(wl + n * D + 256 * j + lane * 4);
                s0 += (hv[0][j].x * w.x + hv[0][j].y * w.y) + (hv[0][j].z * w.z + hv[0][j].w * w.w);
                s1 += (hv[1][j].x * w.x + hv[1][j].y * w.y) + (hv[1][j].z * w.z + hv[1][j].w * w.w); }
            a0[n] = s0; a1[n] = s1; }
        float r0, r1;
        {
            float u0[8], u1[8];
            const bool b5 = lane & 32, b4 = lane & 16, b3 = lane & 8, b2 = lane & 4;
#pragma unroll
            for (int i = 0; i < 8; ++i) { const float k0 = b5 ? a0[i + 8] : a0[i], s0 = b5 ? a0[i] : a0[i + 8]; u0[i] = k0 + __shfl_xor(s0, 32);
                const float k1 = b5 ? a1[i + 8] : a1[i], s1 = b5 ? a1[i] : a1[i + 8]; u1[i] = k1 + __shfl_xor(s1, 32); }
            float t0[4], t1[4];
#pragma unroll
            for (int i = 0; i < 4; ++i) { const float k0 = b4 ? u0[i + 4] : u0[i], s0 = b4 ? u0[i] : u0[i + 4]; t0[i] = k0 + __shfl_xor(s0, 16);
                const float k1 = b4 ? u1[i + 4] : u1[i], s1 = b4 ? u1[i] : u1[i + 4]; t1[i] = k1 + __shfl_xor(s1, 16); }
            float v0[2], v1[2];
#pragma unroll
            for (int i = 0; i < 2; ++i) { const float k0 = b3 ? t0[i + 2] : t0[i], s0 = b3 ? t0[i] : t0[i + 2]; v0[i] = k0 + __shfl_xor(s0, 8);
                const float k1 = b3 ? t1[i + 2] : t1[i], s1 = b3 ? t1[i] : t1[i + 2]; v1[i] = k1 + __shfl_xor(s1, 8); }
            { const float k0 = b2 ? v0[1] : v0[0], s0 = b2 ? v0[0] : v0[1]; r0 = k0 + __shfl_xor(s0, 4);
              const float k1 = b2 ? v1[1] : v1[0], s1 = b2 ? v1[0] : v1[1]; r1 = k1 + __shfl_xor(s1, 4); }
            r0 += __shfl_xor(r0, 2); r0 += __shfl_xor(r0, 1);
            r1 += __shfl_xor(r1, 2); r1 += __shfl_xor(r1, 1);
        }
        if ((lane & 3) == 0) { wscr[lane >> 2] = r0; wscr[16 + (lane >> 2)] = r1; }
        LDS_WAIT();
        f32x4 z0 = ba4, z1 = ba4;
#pragma unroll
        for (int n = 0; n < 16; ++n) { const f32x4 w = *(const LAS f32x4*)(wa2s + n * 256 + lane * 4); const float g0 = wscr[n], g1 = wscr[16 + n]; z0 += w * g0; z1 += w * g1; }
        LDS_WAIT();
        f32x4 l0, l1;
#pragma unroll
        for (int i = 0; i < 4; ++i) {
            l0[i] = -(fmaxf(-z0[i], 0.f) + __logf(1.0f + __expf(-fabsf(z0[i])))) * 0.0625f;
            l1[i] = -(fmaxf(-z1[i], 0.f) + __logf(1.0f + __expf(-fabsf(z1[i])))) * 0.0625f; }
        *(f32x4*)(LA + (size_t)r * 256 + lane * 4) = l0;
        *(f32x4*)(LA + (size_t)(r + 1) * 256 + lane * 4) = l1;
    }
}

constexpr int MX_KD = 0, MX_QS = 16384, MX_OCT = 33792, MX_ADEC = 37888, MX_OT = 38400;

template <bool HG, bool FIN>
__device__ __forceinline__ void mixer_unit(const Params& p, LAS unsigned char* lds, int l, int b, int h, int jg) {
    constexpr int DK = HG ? 128 : 64, KT = DK / 16, QSTR = DK + 8;
    constexpr int KCOL = HG ? C_HF : C_GK, VCOL = HG ? C_HI : C_GV, QCOL = HG ? C_HQ : C_GQ, ZCOL = HG ? C_HZ : C_GZ;
    int tid_ = threadIdx.x; asm volatile("" : "+v"(tid_));
    const int tid = tid_, lane = tid & 63, w = tid >> 6, n = lane & 15, q = lane >> 4;
    unsigned char* ws = p.ws;
    const bf16* P1 = (const bf16*)(ws + WS_P1);
    const float* LA = (const float*)(ws + WS_LOGA);
    bf16* OB = (bf16*)(ws + WS_H);
    float* SB = (float*)(ws + (HG ? WS_STATE_HG : WS_STATE)) + (size_t)((b * 4 + h) * NG + jg) * (DK * 128);
    float* PD = (float*)(ws + WS_PDEC) + (size_t)(((HG ? 0 : 8) + b * 4 + h) * NG + jg) * 128;
    LAS unsigned char* KD = lds + MX_KD;
    LAS bf16* QS = (LAS bf16*)(lds + MX_QS);
    LAS float* OCT = (LAS float*)(lds + MX_OCT);
    LAS float* ADEC = (LAS float*)(lds + MX_ADEC);
    LAS float* OT = (LAS float*)(lds + MX_OT);

    const int c = HG ? (tid & 127) : (tid & 63);
    const int o_first = HG ? (tid >> 7) : (tid >> 6);
    constexpr int NOCT = HG ? 2 : 1;
    float lb = 0.f, lbf = 1e-30f, oml = 1.0f;
    if (HG) { if (l > 0) { const float g0 = p.in[9][h * 128 + c], g1 = p.in[9][512 + h * 128 + c]; lb = 1.0f / (1.0f + __expf(g0 - g1)); lb = fminf(fmaxf(lb, 0.f), 1.0f - 1e-6f); }
        lbf = fmaxf(lb, 1e-30f); oml = 1.0f - lb; }
    float nwv[16];
    if (FIN) { const float* nwp = (HG ? p.in[10] : p.in[8]) + l * 128 + (tid & 7) * 16;
#pragma unroll
        for (int i = 0; i < 16; ++i) nwv[i] = nwp[i]; }

    f32x4 S[KT];
    if (FIN) {
#pragma unroll
        for (int kt = 0; kt < KT; ++kt) S[kt] = *(const f32x4*)(SB + (size_t)((w * KT + kt) * 64 + lane) * 4);
    } else {
#pragma unroll
        for (int kt = 0; kt < KT; ++kt) S[kt] = (f32x4){0.f, 0.f, 0.f, 0.f};
    }
    float plog = 0.f;

    for (int cc = 0; cc < G_CH; ++cc) {
        const int row0 = b * SEQ + (jg * G_CH + cc) * 64;
        bf16x8 vf[2];
#pragma unroll
        for (int ks = 0; ks < 2; ++ks)
#pragma unroll
            for (int i = 0; i < 8; ++i) vf[ks][i] = (short)P1[(size_t)(row0 + ks * 32 + q * 8 + i) * NP1 + VCOL + h * 128 + w * 16 + n];
        float la[NOCT][8], kv[NOCT][8], osum[NOCT];
#pragma unroll
        for (int oi = 0; oi < NOCT; ++oi) { const int o = o_first + 4 * oi;
#pragma unroll
            for (int i = 0; i < 8; ++i) { const size_t row = (size_t)(row0 + o * 8 + i);
                if (HG) { float zf = bf2f(P1[row * NP1 + KCOL + h * 128 + c]); zf = fminf(fmaxf(zf, -80.f), 80.f);
                    const float e = __expf(-zf), s = 1.0f / (1.0f + e);
                    la[oi][i] = __logf(lbf + oml * s); kv[oi][i] = oml * e * s; }
                else { la[oi][i] = LA[row * 256 + h * 64 + c]; kv[oi][i] = bf2f(P1[row * NP1 + KCOL + h * 64 + c]); } }
            float s = 0.f;
#pragma unroll
            for (int i = 0; i < 8; ++i) s += la[oi][i];
            osum[oi] = s; OCT[o * 128 + c] = s; }
        if (FIN) {
            constexpr int PPR = DK / 8;
#pragma unroll
            for (int pp = 0; pp < (64 * PPR) / NTHREADS; ++pp) { const int pc = tid + pp * NTHREADS, row = pc / PPR, pk = pc % PPR;
                const u32x4 v = *(const u32x4*)(P1 + (size_t)(row0 + row) * NP1 + QCOL + h * DK + pk * 8);
                *(LAS u32x4*)(QS + row * QSTR + pk * 8) = v; } }
        LDS_WAIT(); __syncthreads();
#pragma unroll
        for (int oi = 0; oi < NOCT; ++oi) { const int o = o_first + 4 * oi;
            float later = 0.f;
            for (int o2 = o + 1; o2 < 8; ++o2) later += OCT[o2 * 128 + c];
            float suf = later; unsigned pk[4]; float kd[8];
#pragma unroll
            for (int i = 7; i >= 0; --i) { kd[i] = kv[oi][i] * __expf(suf); suf += la[oi][i]; }
#pragma unroll
            for (int i = 0; i < 4; ++i) pk[i] = pk2(kd[2 * i], kd[2 * i + 1]);
            *(LAS u32x4*)(KD + (size_t)((((c >> 4) * 2 + (o >> 2)) * 64 + (o & 3) * 16 + (c & 15)) * 16)) = (u32x4){pk[0], pk[1], pk[2], pk[3]};
            if (o == 0) { ADEC[c] = __expf(suf); plog += suf; } }
        LDS_WAIT(); __syncthreads();
#pragma unroll
        for (int kt = 0; kt < KT; ++kt) { const f32x4 a4 = *(const LAS f32x4*)(ADEC + kt * 16 + q * 4); S[kt] = S[kt] * a4;
#pragma unroll
            for (int ks = 0; ks < 2; ++ks) { const bf16x8 af = *(const LAS bf16x8*)(KD + (size_t)(((kt * 2 + ks) * 64 + lane) * 16));
                S[kt] = __builtin_amdgcn_mfma_f32_16x16x32_bf16(af, vf[ks], S[kt], 0, 0, 0); } }
        if (FIN) {
            f32x4 oacc[4];
#pragma unroll
            for (int lt = 0; lt < 4; ++lt) oacc[lt] = (f32x4){0.f, 0.f, 0.f, 0.f};
#pragma unroll
            for (int kk = 0; kk < KT / 2; ++kk) {
                union { u32x4 u; bf16x8 v; } bs;
                bs.u.x = pk2(S[2 * kk][0], S[2 * kk][1]); bs.u.y = pk2(S[2 * kk][2], S[2 * kk][3]); bs.u.z = pk2(S[2 * kk + 1][0], S[2 * kk + 1][1]); bs.u.w = pk2(S[2 * kk + 1][2], S[2 * kk + 1][3]);
#pragma unroll
                for (int lt = 0; lt < 4; ++lt) {
                    union { u32x4 u; bf16x8 v; } aq;
                    const u32x2 q0 = *(const LAS u32x2*)(QS + (lt * 16 + n) * QSTR + (2 * kk) * 16 + q * 4), q1 = *(const LAS u32x2*)(QS + (lt * 16 + n) * QSTR + (2 * kk + 1) * 16 + q * 4);
                    aq.u = (u32x4){q0.x, q0.y, q1.x, q1.y};
                    oacc[lt] = __builtin_amdgcn_mfma_f32_16x16x32_bf16(aq.v, bs.v, oacc[lt], 0, 0, 0); } }
#pragma unroll
            for (int lt = 0; lt < 4; ++lt)
#pragma unroll
                for (int j = 0; j < 4; ++j) OT[(lt * 16 + q * 4 + j) * 132 + w * 16 + n] = oacc[lt][j];
            LDS_WAIT(); __syncthreads();
            { const int fl = tid >> 3, seg = tid & 7;
                f32x4 ov[4]; float ssq = 0.f;
#pragma unroll
                for (int i = 0; i < 4; ++i) { ov[i] = *(const LAS f32x4*)(OT + fl * 132 + seg * 16 + i * 4); ssq += (ov[i].x * ov[i].x + ov[i].y * ov[i].y) + (ov[i].z * ov[i].z + ov[i].w * ov[i].w); }
                ssq += __shfl_xor(ssq, 1); ssq += __shfl_xor(ssq, 2); ssq += __shfl_xor(ssq, 4);
                const float rstd = 1.0f / sqrtf(ssq * (1.0f / 128.0f) + EPS);
                const size_t row = (size_t)(row0 + fl);
                const u32x4 zg0 = *(const u32x4*)(P1 + row * NP1 + ZCOL + h * 128 + seg * 16), zg1 = *(const u32x4*)(P1 + row * NP1 + ZCOL + h * 128 + seg * 16 + 8);
                u32x4 w0, w1;
                w0.x = pk2(ov[0].x * rstd * nwv[0] * bflo(zg0.x), ov[0].y * rstd * nwv[1] * bfhi(zg0.x)); w0.y = pk2(ov[0].z * rstd * nwv[2] * bflo(zg0.y), ov[0].w * rstd * nwv[3] * bfhi(zg0.y));
                w0.z = pk2(ov[1].x * rstd * nwv[4] * bflo(zg0.z), ov[1].y * rstd * nwv[5] * bfhi(zg0.z)); w0.w = pk2(ov[1].z * rstd * nwv[6] * bflo(zg0.w), ov[1].w * rstd * nwv[7] * bfhi(zg0.w));
                w1.x = pk2(ov[2].x * rstd * nwv[8] * bflo(zg1.x), ov[2].y * rstd * nwv[9] * bfhi(zg1.x)); w1.y = pk2(ov[2].z * rstd * nwv[10] * bflo(zg1.y), ov[2].w * rstd * nwv[11] * bfhi(zg1.y));
                w1.z = pk2(ov[3].x * rstd * nwv[12] * bflo(zg1.z), ov[3].y * rstd * nwv[13] * bfhi(zg1.z)); w1.w = pk2(ov[3].z * rstd * nwv[14] * bflo(zg1.w), ov[3].w * rstd * nwv[15] * bfhi(zg1.w));
                bf16* op = OB + row * D + (HG ? 512 : 0) + h * 128 + seg * 16;
                *(u32x4*)op = w0; *(u32x4*)(op + 8) = w1; }
        }
    }
    if (!FIN) {
#pragma unroll
        for (int kt = 0; kt < KT; ++kt) *(f32x4*)(SB + (size_t)((w * KT + kt) * 64 + lane) * 4) = S[kt];
        if (o_first == 0) PD[c] = __expf(plog);
    }
    __syncthreads();
}

template <bool FIN>
__device__ __forceinline__ void phase_mixer(const Params& p, LAS unsigned char* lds, int l) {
    for (int u = blockIdx.x; u < 512; u += gridDim.x) {
        const int rem = u & 255, b = rem >> 7, h = (rem >> 5) & 3, jg = rem & 31;
        if (!FIN && jg == NG - 1) continue;
        if (u < 256) mixer_unit<true, FIN>(p, lds, l, b, h, jg); else mixer_unit<false, FIN>(p, lds, l, b, h, jg);
    }
}

__device__ __forceinline__ void phase_scan(const Params& p) {
    unsigned char* ws = p.ws;
    int tid_ = threadIdx.x; asm volatile("" : "+v"(tid_));
    const int gt = blockIdx.x * NTHREADS + tid_, NT = gridDim.x * NTHREADS;
    for (int tt = gt; tt < 8 * 4096 + 8 * 2048; tt += NT) {
        const bool hg = tt < 32768; const int t2 = hg ? tt : tt - 32768, per = hg ? 4096 : 2048, bh = t2 / per, e = t2 % per, KT = hg ? 8 : 4;
        const int kt = (e >> 6) % KT, lane = e & 63, c4 = kt * 16 + (lane >> 4) * 4;
        float* base = (float*)(ws + (hg ? WS_STATE_HG : WS_STATE)) + (size_t)bh * NG * (per * 4) + (size_t)e * 4;
        const float* pd = (const float*)(ws + WS_PDEC) + (size_t)(((hg ? 0 : 8) + bh) * NG) * 128 + c4;
        f32x4 S = (f32x4){0.f, 0.f, 0.f, 0.f};
        for (int j0 = 0; j0 < NG; j0 += 8) {
            f32x4 Lv[8], Pv[8];
#pragma unroll
            for (int j = 0; j < 8; ++j) { if (j0 + j < NG - 1) { Lv[j] = *(const f32x4*)(base + (size_t)(j0 + j) * (per * 4)); Pv[j] = *(const f32x4*)(pd + (size_t)(j0 + j) * 128); } else { Lv[j] = (f32x4){0.f, 0.f, 0.f, 0.f}; Pv[j] = Lv[j]; } }
#pragma unroll
            for (int j = 0; j < 8; ++j) { *(f32x4*)(base + (size_t)(j0 + j) * (per * 4)) = S; S = Pv[j] * S + Lv[j]; }
        }
    }
}

__device__ __forceinline__ void phase_final_norm(const Params& p) {
    int tid_ = threadIdx.x; asm volatile("" : "+v"(tid_));
    const int tid = tid_, lane = tid & 63, wave = tid >> 6;
    f32x4 nw[4];
#pragma unroll
    for (int j = 0; j < 4; ++j) nw[j] = *(const f32x4*)(p.in[15] + lane * 4 + 256 * j);
    const int gw = blockIdx.x * NWAVES + wave, NGW = gridDim.x * NWAVES;
    for (int r = gw; r < T; r += NGW) {
        f32x4* xr = (f32x4*)(p.out + (size_t)r * D) + lane;
        f32x4 v[4]; float s = 0.f;
#pragma unroll
        for (int j = 0; j < 4; ++j) { v[j] = xr[64 * j]; s += (v[j].x * v[j].x + v[j].y * v[j].y) + (v[j].z * v[j].z + v[j].w * v[j].w); }
        const float rstd = 1.0f / sqrtf(wave_sum(s) * (1.0f / D) + EPS);
#pragma unroll
        for (int j = 0; j < 4; ++j) xr[64 * j] = v[j] * rstd * nw[j];
    }
}

#define XB_TMO      128
#define XB_XCNT(j)  (256  + 64 * (j))
#define XB_XSUB(j)  (1280 + 64 * (j))
#define XB_XGEN(j)  (2304 + 64 * (j))
#define XB_TOP      3328
#define XB_TOPGEN   3392
#define XCD_BAR_WORDS 3456
#define XB_SPIN_CAP (1u << 18)

__device__ __forceinline__ unsigned xb_ld(unsigned* p)              { return __hip_atomic_load(p, __ATOMIC_RELAXED, __HIP_MEMORY_SCOPE_AGENT); }
__device__ __forceinline__ unsigned xb_add(unsigned* p, unsigned v) { return __hip_atomic_fetch_add(p, v, __ATOMIC_RELAXED, __HIP_MEMORY_SCOPE_AGENT); }
__device__ __forceinline__ unsigned xb_xcc_id() { return (unsigned)__builtin_amdgcn_s_getreg((3 << 11) | 20) & 0xFu; }
#define XB_SPIN(cond, bar) do { unsigned _sp = 0; while (cond) { __builtin_amdgcn_s_sleep(1); \
    if ((++_sp & 255u) == 0u) { if (xb_ld(&(bar)[XB_TMO])) break; if (_sp > XB_SPIN_CAP) { atomicAdd(&(bar)[XB_TMO], 1u); break; } } } } while (0)

struct XcdBarrier {
    unsigned* bar; unsigned x;
    volatile LAS unsigned* st;
};

__device__ __forceinline__ XcdBarrier xcd_barrier_post(unsigned* bar, volatile LAS unsigned* st) {
    XcdBarrier b; b.bar = bar; b.x = xb_xcc_id(); b.st = st;
    if (threadIdx.x == 0) (void)xb_add(&bar[XB_XCNT(b.x)], 1u);
    return b;
}
__device__ __forceinline__ void xcd_barrier_complete(unsigned* bar, unsigned x, unsigned& nloc, unsigned& nx) {
    const unsigned G = gridDim.x * gridDim.y * gridDim.z;
    unsigned sum, cnt, mine, sp = 0u;
    for (;;) {
        sum = 0u; cnt = 0u; mine = 0u;
#pragma unroll
        for (unsigned j = 0; j < 16; ++j) { const unsigned c = xb_ld(&bar[XB_XCNT(j)]); sum += c; cnt += (c > 0u) ? 1u : 0u; mine = (j == x) ? c : mine; }
        if (sum == G) break;
        __builtin_amdgcn_s_sleep(1);
        if ((++sp & 255u) == 0u) { if (xb_ld(&bar[XB_TMO])) break; if (sp > XB_SPIN_CAP) { atomicAdd(&bar[XB_TMO], 1u); break; } }
    }
    nloc = mine > 0u ? mine : 1u; nx = cnt > 0u ? cnt : 1u;
}

__device__ __forceinline__ void xcd_barrier(const XcdBarrier& b) {
    asm volatile("s_waitcnt vmcnt(0)" ::: "memory");
    __syncthreads();
    if (threadIdx.x == 0) {
        unsigned* bar = b.bar;
        __builtin_amdgcn_s_waitcnt(0);
        unsigned nloc = b.st[0], nx = b.st[1];
        if (nloc == 0u) { xcd_barrier_complete(bar, b.x, nloc, nx); b.st[0] = nloc; b.st[1] = nx; }
        const unsigned old = xb_add(&bar[XB_XSUB(b.x)], 1u);
        const unsigned gen = old / nloc;
        if (old + 1u == (gen + 1u) * nloc) {
            __builtin_amdgcn_fence(__ATOMIC_RELEASE, "agent");
            asm volatile("s_waitcnt vmcnt(0)" ::: "memory");
            const unsigned og = xb_add(&bar[XB_TOP], 1u);
            const unsigned tg = og / nx;
            if (og + 1u == (tg + 1u) * nx) xb_add(&bar[XB_TOPGEN], 1u);
            else XB_SPIN(xb_ld(&bar[XB_TOPGEN]) == tg, bar);
            __builtin_amdgcn_fence(__ATOMIC_ACQUIRE, "agent");
            xb_add(&bar[XB_XGEN(b.x)], 1u);
            asm volatile("s_waitcnt vmcnt(0)" ::: "memory");
        } else {
            XB_SPIN(xb_ld(&bar[XB_XGEN(b.x)]) == gen, bar);
            __builtin_amdgcn_fence(__ATOMIC_ACQUIRE, "agent");
            asm volatile("s_waitcnt vmcnt(0)" ::: "memory");
        }
    }
    __syncthreads();
}


__global__ void __launch_bounds__(NTHREADS, 2) mega_fwd(Params p) {
    extern __shared__ __attribute__((aligned(16))) unsigned char lds_raw[];
    LAS unsigned char* lds = (LAS unsigned char*)lds_raw;
    cg::grid_group grid = cg::this_grid();
    unsigned char* ws = p.ws;
    unsigned* barw = (unsigned*)(ws + WS_BAR);
    volatile LAS unsigned* bst = (volatile LAS unsigned*)(lds + 131072 + 64);
    if (threadIdx.x < 2) bst[threadIdx.x] = 0u;
    if (blockIdx.x == 0) for (int i = threadIdx.x; i < XCD_BAR_WORDS; i += NTHREADS) barw[i] = 0u;
    phase_prologue(p, lds);
    grid.sync();
    const XcdBarrier xb = xcd_barrier_post(barw, bst);
#pragma unroll 1
    for (int l_ = 0; l_ < DEPTH; ++l_) {
        int l = l_; asm volatile("" : "+s"(l));
        const float* xin = (l == 0) ? p.in[0] : p.out;
        phase_norm(p, lds, l, xin);
        xcd_barrier(xb);
        {
            pg8::Gemm g{(const pg8::bf16_t*)(ws + WS_H), (const pg8::bf16_t*)(ws + WS_WIN) + (size_t)l * NP * D, T, NP, D};
            pg8::StaticOrder S; S.init(T, NP, (int)gridDim.x, (int)blockIdx.x);
            pg8::EpiIn E{(pg8::bf16_t*)(ws + WS_P1), (pg8::bf16_t*)(ws + WS_PG), p.in[11] + l * 2048};
            pg8::gemm_phase<pg8::EpiIn, pg8::StaticOrder, true, true>(lds, g, S, E);
        }
        xcd_barrier(xb);
        phase_mixer<false>(p, lds, l);
        xcd_barrier(xb);
        phase_scan(p);
        xcd_barrier(xb);
        phase_mixer<true>(p, lds, l);
        xcd_barrier(xb);
        {
            pg8::Gemm g{(const pg8::bf16_t*)(ws + WS_H), (const pg8::bf16_t*)(ws + WS_WUP) + (size_t)l * D * D, T, D, D};
            pg8::StaticOrder S; S.init(T, D, (int)gridDim.x, (int)blockIdx.x);
            pg8::EpiUp E{(const pg8::bf16_t*)(ws + WS_PG), (pg8::bf16_t*)(ws + WS_P1)};
            pg8::gemm_phase<pg8::EpiUp, pg8::StaticOrder, true, true>(lds, g, S, E);
        }
        xcd_barrier(xb);
        {
            pg8::Gemm g{(const pg8::bf16_t*)(ws + WS_P1), (const pg8::bf16_t*)(ws + WS_WOUT) + (size_t)l * D * D, T, D, D};
            pg8::StaticOrder S; S.init(T, D, (int)gridDim.x, (int)blockIdx.x);
            pg8::EpiOut E{xin, p.out, (const float*)(ws + WS_MOD) + (size_t)l * BATCH * 3072 + 2048};
            pg8::gemm_phase<pg8::EpiOut, pg8::StaticOrder, true, true>(lds, g, S, E);
        }
        xcd_barrier(xb);
    }
    phase_final_norm(p);
}

extern "C" void kernel_launch(void* const* d_in, const int* in_sizes, int n_in, void* d_out, int out_size, void* d_ws, size_t ws_size, hipStream_t stream) {
    static int grid = 0;
    if (grid == 0) {
        if (n_in != 16 || in_sizes[0] != T * D || out_size != T * D || ws_size < WS_END) { fprintf(stderr, "kernel_launch: unexpected shapes (n_in %d, in0 %d, out %d, ws %zu)\n", n_in, n_in > 0 ? in_sizes[0] : -1, out_size, ws_size); grid = -1; return; }
        int dev = 0, cus = 0, per_cu = 0;
        if (hipGetDevice(&dev) != hipSuccess || hipDeviceGetAttribute(&cus, hipDeviceAttributeMultiprocessorCount, dev) != hipSuccess) { fprintf(stderr, "kernel_launch: device query failed\n"); grid = -1; return; }
        if (hipFuncSetAttribute((const void*)mega_fwd, hipFuncAttributeMaxDynamicSharedMemorySize, LDS_BYTES) != hipSuccess) { fprintf(stderr, "kernel_launch: hipFuncSetAttribute failed\n"); grid = -1; return; }
        if (hipOccupancyMaxActiveBlocksPerMultiprocessor(&per_cu, (const void*)mega_fwd, NTHREADS, LDS_BYTES) != hipSuccess || per_cu < 1) { fprintf(stderr, "kernel_launch: occupancy query failed (%d)\n", per_cu); (void)hipGetLastError(); per_cu = 1; }
        grid = cus * per_cu;
    }
    if (grid < 0) return;
    Params p{};
    for (int i = 0; i < 16; ++i) p.in[i] = (const float*)d_in[i];
    p.out = (float*)d_out; p.ws = (unsigned char*)d_ws;
    void* args[] = {&p};
    const hipError_t e = hipLaunchCooperativeKernel((const void*)mega_fwd, dim3(grid), dim3(NTHREADS), args, LDS_BYTES, stream);
    if (e != hipSuccess) fprintf(stderr, "kernel_launch: cooperative launch failed: %s (grid %d)\n", hipGetErrorString(e), grid);
}
```

```cpp
#include <hip/hip_runtime.h>
#include <hip/hip_cooperative_groups.h>
#include <cstdio>
#include <cstdint>
namespace cg = cooperative_groups;
namespace pg8 {
#define PG8_LAS __attribute__((address_space(3)))
typedef unsigned short bf16_t;
typedef short bf16x8 __attribute__((ext_vector_type(8)));
typedef float f32x4 __attribute__((ext_vector_type(4)));
typedef unsigned u32x4 __attribute__((ext_vector_type(4)));
constexpr int BM = 256, BK = 64, HALF = 128, HTB = HALF * BK * 2  , STAGE_BYTES = 8 * HTB, NXCD = 8, WGM = 8;

__host__ __device__ __forceinline__ int lds_byte(int r, int c) { const int st = (r >> 4) * 2 + (c >> 5), rr = r & 15, cc = c & 31, ob = rr * 64 + cc * 2; return st * 1024 + (ob ^ (((ob >> 9) & 1) << 5)); }
__host__ __device__ __forceinline__ void stage_rc(int b, int& R, int& C) { const int st = b / 1024, sb = b % 1024, swz = sb ^ (((sb >> 9) & 1) << 5); R = (st >> 1) * 16 + swz / 64; C = (st & 1) * 32 + (swz % 64) / 2; }
__host__ __device__ __forceinline__ int perm32(int rho) { const int n = rho >> 4, i = rho & 15; return 8 * (i >> 2) + 4 * n + (i & 3); }

struct Unit { int pm, pn; };
struct Gemm { const bf16_t* A; const bf16_t* Bt; int M, N, K; };

struct StaticOrder {
    int nM, nN, nwg, G, c;
    __host__ __device__ void init(int M, int N, int G_, int c_) { nM = M / BM; nN = N / BM; nwg = nM * nN; G = G_; c = c_; }
    __host__ __device__ bool next(int i, Unit& u) const {
        const long L = (long)i * G + c; if (L >= nwg) return false;
        int wgid = (int)L; { const int q = nwg / NXCD, r = nwg % NXCD, xcd = wgid % NXCD, off = wgid / NXCD; wgid = (xcd < r ? xcd * (q + 1) : r * (q + 1) + (xcd - r) * q) + off; }
        const int nig = WGM * nN, gid = wgid / nig, fm = gid * WGM, gsz = (nM - fm) < WGM ? (nM - fm) : WGM;
        u.pm = fm + ((wgid % nig) % gsz); u.pn = (wgid % nig) / gsz; return true;
    }
    __device__ __forceinline__ void a_ready(const Unit&) const {}
    __device__ __forceinline__ void done(const Unit&) const {}
};
__device__ __forceinline__ unsigned cvt_pk_bf16(float lo, float hi) { unsigned r; asm volatile("v_cvt_pk_bf16_f32 %0, %1, %2" : "=v"(r) : "v"(lo), "v"(hi)); return r; }
template <class Epi, class Sched, bool ALIGN_EPI = false, bool SP2 = false>
__device__ __forceinline__ void gemm_phase(PG8_LAS unsigned char* lds, const Gemm g, const Sched& S, const Epi& E) {
    int tid_ = threadIdx.x; asm volatile("" : "+v"(tid_));
    const int tid = tid_, wid = __builtin_amdgcn_readfirstlane(tid >> 6), lane = tid & 63, wr = wid >> 2, wc = wid & 3, fr = lane & 15, fq = lane >> 4;
    const int K = g.K, nt = K / BK;
    unsigned voffA[2], voffB[2];
#pragma unroll
    for (int i = 0; i < 2; ++i) { int R, C; stage_rc(tid * 16 + i * 8192, R, C); const int Rb = Epi::PERM ? ((R & ~31) + perm32(R & 31)) : R;
        voffA[i] = (unsigned)(R * K + C) * 2u; voffB[i] = (unsigned)(Rb * K + C) * 2u; }
    const size_t kstep = (size_t)(BK * 2);
    const size_t hstep = (size_t)HALF * K * 2;
    const size_t tstep = 2 * hstep;
    const unsigned ldsw = (unsigned)wid * 1024u;
    const int aoff = lds_byte(wr * 64 + fr, fq * 8), boff = lds_byte(wc * 32 + fr, fq * 8);
#define PG8_SA(b, h) (((b) * 2 + (h)) * HTB)
#define PG8_SB(b, h) ((4 + (b) * 2 + (h)) * HTB)
#define PG8_STAGE(bufoff, gbase, voff) do { _Pragma("unroll") for (int _i = 0; _i < 2; ++_i) \
        __builtin_amdgcn_global_load_lds((const unsigned*)((const char*)(gbase) + (voff)[_i]), (PG8_LAS unsigned*)(lds + (bufoff) + ldsw + _i * 8192), 16, 0, 0); } while (0)
#define PG8_LDA(dst, b, h) do { _Pragma("unroll") for (int m = 0; m < 4; ++m) _Pragma("unroll") for (int k = 0; k < 2; ++k) dst[m][k] = *(const PG8_LAS bf16x8*)(lds + PG8_SA(b, h) + aoff + m * 2048 + k * 1024); } while (0)
#define PG8_LDB(dst, b, h) do { _Pragma("unroll") for (int n = 0; n < 2; ++n) _Pragma("unroll") for (int k = 0; k < 2; ++k) dst[n][k] = *(const PG8_LAS bf16x8*)(lds + PG8_SB(b, h) + boff + n * 2048 + k * 1024); } while (0)
#define PG8_MMA(ai, bj, At, Bt) do { __builtin_amdgcn_s_setprio(1); _Pragma("unroll") for (int m = 0; m < 4; ++m) _Pragma("unroll") for (int n = 0; n < 2; ++n) _Pragma("unroll") for (int k = 0; k < 2; ++k) \
        acc[ai][bj][m][n] = __builtin_amdgcn_mfma_f32_16x16x32_bf16(Bt[n][k], At[m][k], acc[ai][bj][m][n], 0, 0, 0); __builtin_amdgcn_s_setprio(0); } while (0)
#define PG8_WAIT_V(n) asm volatile("s_waitcnt vmcnt(" #n ")" ::: "memory")
#define PG8_WAIT_L(n) asm volatile("s_waitcnt lgkmcnt(" #n ")" ::: "memory")
#define PG8_BAR __builtin_amdgcn_s_barrier()
#define PG8_SCHED __builtin_amdgcn_sched_barrier(0)
    Unit cur, nxt; int ui = 0;
    if (!S.next(0, cur)) return;
    f32x4 acc[2][2][4][2];
#pragma unroll
    for (int a = 0; a < 2; ++a)
#pragma unroll
        for (int b = 0; b < 2; ++b)
#pragma unroll
            for (int m = 0; m < 4; ++m)
#pragma unroll
                for (int n = 0; n < 2; ++n) acc[a][b][m][n] = (f32x4){0.f, 0.f, 0.f, 0.f};
    bf16x8 At[4][2], B0[2][2], B1[2][2];
    const char* cA = (const char*)g.A + (size_t)cur.pm * tstep; const char* cB = (const char*)g.Bt + (size_t)cur.pn * tstep;
    S.a_ready(cur);
    if constexpr (SP2) {
        PG8_STAGE(PG8_SB(0, 0), cB, voffB); PG8_STAGE(PG8_SB(0, 1), cB + hstep, voffB); PG8_STAGE(PG8_SA(0, 0), cA, voffA); PG8_STAGE(PG8_SA(0, 1), cA + hstep, voffA);
        if (wr == 1) PG8_BAR;
        PG8_WAIT_V(2); PG8_BAR;
        PG8_STAGE(PG8_SB(1, 0), cB + kstep, voffB); PG8_STAGE(PG8_SA(1, 0), cA + kstep, voffA); PG8_STAGE(PG8_SB(1, 1), cB + hstep + kstep, voffB);
        PG8_WAIT_V(6); PG8_BAR;
    } else {
        PG8_STAGE(PG8_SB(0, 0), cB, voffB); PG8_STAGE(PG8_SA(0, 0), cA, voffA); PG8_STAGE(PG8_SB(0, 1), cB + hstep, voffB); PG8_STAGE(PG8_SA(0, 1), cA + hstep, voffA);
        if (wr == 1) PG8_BAR;
        PG8_WAIT_V(4); PG8_BAR;
        PG8_STAGE(PG8_SB(1, 0), cB + kstep, voffB); PG8_STAGE(PG8_SA(1, 0), cA + kstep, voffA); PG8_STAGE(PG8_SB(1, 1), cB + hstep + kstep, voffB);
        PG8_WAIT_V(6); PG8_BAR;
    }
    for (;;) {
        const bool has_next = S.next(ui + 1, nxt);
        const char* nA = has_next ? (const char*)g.A + (size_t)nxt.pm * tstep : cA; const char* nB = has_next ? (const char*)g.Bt + (size_t)nxt.pn * tstep : cB;
        for (int t = 0; t < nt; t += 2) {
            const bool last = (t == nt - 2);
            const char* a1 = cA + (size_t)(t + 1) * kstep;
            const char* a2 = last ? nA : cA + (size_t)(t + 2) * kstep; const char* b2 = last ? nB : cB + (size_t)(t + 2) * kstep;
            const char* a3 = a2 + kstep; const char* b3 = b2 + kstep;
            if (last && has_next) S.a_ready(nxt);
            if constexpr (Epi::MID) { if (t == nt / 2) E.mid(acc, cur, wr, wc, fr, fq); }
            if constexpr (SP2) {
            PG8_LDB(B0, 0, 0); PG8_LDB(B1, 0, 1); PG8_SCHED; PG8_LDA(At, 0, 0); PG8_STAGE(PG8_SA(1, 1), a1 + hstep, voffA);
            PG8_WAIT_V(8); PG8_WAIT_L(0); PG8_BAR; PG8_MMA(0, 0, At, B0); PG8_MMA(0, 1, At, B1); PG8_BAR; PG8_SCHED;
            PG8_LDA(At, 0, 1); PG8_STAGE(PG8_SB(0, 0), b2, voffB); PG8_STAGE(PG8_SB(0, 1), b2 + hstep, voffB); PG8_STAGE(PG8_SA(0, 0), a2, voffA);
            PG8_WAIT_V(8); PG8_WAIT_L(0); PG8_BAR; PG8_MMA(1, 0, At, B0); PG8_MMA(1, 1, At, B1); PG8_BAR; PG8_SCHED;
            PG8_LDB(B0, 1, 0); PG8_LDB(B1, 1, 1); PG8_SCHED; PG8_LDA(At, 1, 0); PG8_STAGE(PG8_SA(0, 1), a2 + hstep, voffA);
            PG8_WAIT_V(8); PG8_WAIT_L(0); PG8_BAR; PG8_MMA(0, 0, At, B0); PG8_MMA(0, 1, At, B1); PG8_BAR; PG8_SCHED;
            PG8_LDA(At, 1, 1); PG8_STAGE(PG8_SB(1, 0), b3, voffB); PG8_STAGE(PG8_SB(1, 1), b3 + hstep, voffB); PG8_STAGE(PG8_SA(1, 0), a3, voffA);
            PG8_WAIT_V(8); PG8_WAIT_L(0); PG8_BAR; PG8_MMA(1, 0, At, B0); PG8_MMA(1, 1, At, B1); PG8_BAR; PG8_SCHED;
            } else {
            PG8_LDB(B0, 0, 0); PG8_SCHED; PG8_LDA(At, 0, 0); PG8_STAGE(PG8_SA(1, 1), a1 + hstep, voffA);
            PG8_WAIT_L(8); PG8_BAR; PG8_WAIT_L(0); PG8_MMA(0, 0, At, B0); PG8_BAR; PG8_SCHED;
            PG8_LDB(B1, 0, 1); PG8_STAGE(PG8_SB(0, 0), b2, voffB);
            PG8_BAR; PG8_WAIT_L(0); PG8_MMA(0, 1, At, B1); PG8_BAR;
            PG8_LDA(At, 0, 1); PG8_STAGE(PG8_SA(0, 0), a2, voffA);
            PG8_BAR; PG8_WAIT_L(0); PG8_MMA(1, 0, At, B0); PG8_BAR; PG8_SCHED;
            PG8_STAGE(PG8_SB(0, 1), b2 + hstep, voffB);
            PG8_WAIT_V(6); PG8_BAR; PG8_MMA(1, 1, At, B1); PG8_BAR;
            PG8_LDB(B0, 1, 0); PG8_SCHED; PG8_LDA(At, 1, 0); PG8_STAGE(PG8_SA(0, 1), a2 + hstep, voffA);
            PG8_WAIT_L(8); PG8_BAR; PG8_WAIT_L(0); PG8_MMA(0, 0, At, B0); PG8_BAR; PG8_SCHED;
            PG8_LDB(B1, 1, 1); PG8_STAGE(PG8_SB(1, 0), b3, voffB);
            PG8_BAR; PG8_WAIT_L(0); PG8_MMA(0, 1, At, B1); PG8_BAR;
            PG8_LDA(At, 1, 1); PG8_STAGE(PG8_SA(1, 0), a3, voffA);
            PG8_BAR; PG8_WAIT_L(0); PG8_MMA(1, 0, At, B0); PG8_BAR; PG8_SCHED;
            PG8_STAGE(PG8_SB(1, 1), b3 + hstep, voffB);
            PG8_WAIT_V(6); PG8_BAR; PG8_MMA(1, 1, At, B1); PG8_BAR;
            }
        }
        if constexpr (ALIGN_EPI) { if (wr == 0) PG8_BAR; }
        if constexpr (!Epi::AFTER_DRAIN) { E(acc, cur, wr, wc, fr, fq); S.done(cur); }
        if (!has_next) break;
#pragma unroll
        for (int a = 0; a < 2; ++a)
#pragma unroll
            for (int b = 0; b < 2; ++b)
#pragma unroll
                for (int m = 0; m < 4; ++m)
#pragma unroll
                    for (int n = 0; n < 2; ++n) acc[a][b][m][n] = (f32x4){0.f, 0.f, 0.f, 0.f};
        cur = nxt; cA = nA; cB = nB; ++ui;
        if constexpr (ALIGN_EPI) { if (wr == 1) PG8_BAR; }
    }
    PG8_WAIT_V(0);
    if constexpr (!ALIGN_EPI) { if (wr == 0) PG8_BAR; }
    PG8_BAR;
    if constexpr (Epi::AFTER_DRAIN) { E.fused(acc, cur, wr, wc, fr, fq, lds, wid, lane); S.done(cur); }
#undef PG8_SA
#undef PG8_SB
#undef PG8_STAGE
#undef PG8_LDA
#undef PG8_LDB
#undef PG8_MMA
#undef PG8_WAIT_V
#undef PG8_WAIT_L
#undef PG8_BAR
#undef PG8_SCHED
}
}

#define LAS __attribute__((address_space(3)))
typedef unsigned short bf16;
typedef float f32x4 __attribute__((ext_vector_type(4)));
typedef short bf16x8 __attribute__((ext_vector_type(8)));
typedef unsigned u32x4 __attribute__((ext_vector_type(4)));
typedef unsigned u32x2 __attribute__((ext_vector_type(2)));

constexpr int D = 1024, BATCH = 2, SEQ = 16384, T = BATCH * SEQ, DEPTH = 2;
constexpr int IN_TOTAL = 5648, NP = 5632, NP1 = 3584, NPG = 2048;
constexpr int G_CH = 8;
constexpr int NCHUNK = SEQ / 64;
constexpr int NG = NCHUNK / G_CH;
constexpr int NTHREADS = 512, NWAVES = 8;
constexpr int LDS_BYTES = 147456;
constexpr float EPS = 1e-6f;

constexpr int C_GQ = 0, C_GK = 256, C_GV = 512, C_GZ = 1024, C_HQ = 1536, C_HF = 2048, C_HI = 2560, C_HZ = 3072;

constexpr size_t MiB = 1u << 20;
constexpr size_t WS_MOD = 0;
constexpr size_t WS_BAR = 512 * 1024;
constexpr size_t WS_WIN = 1 * MiB;
constexpr size_t WS_WUP = 23 * MiB;
constexpr size_t WS_WOUT = 27 * MiB;
constexpr size_t WS_STATE = 32 * MiB;
constexpr size_t WS_STATE_HG = WS_STATE + 8 * MiB;
constexpr size_t WS_PDEC = 56 * MiB;
constexpr size_t WS_WLR = 57 * MiB;
constexpr size_t WS_LOGA = 64 * MiB;
constexpr size_t WS_H = 96 * MiB;
constexpr size_t WS_P1 = 160 * MiB;
constexpr size_t WS_PG = 384 * MiB;
constexpr size_t WS_END = 512 * MiB;

struct Params { const float* in[16]; float* out; unsigned char* ws; };

__device__ __forceinline__ float bf2f(unsigned short b) { return __builtin_bit_cast(float, (unsigned)b << 16); }
__device__ __forceinline__ float bflo(unsigned w) { return __builtin_bit_cast(float, w << 16); }
__device__ __forceinline__ float bfhi(unsigned w) { return __builtin_bit_cast(float, w & 0xffff0000u); }
__device__ __forceinline__ unsigned f2bf(float f) { unsigned u = __builtin_bit_cast(unsigned, f); return (u + 0x7fffu + ((u >> 16) & 1u)) >> 16; }
__device__ __forceinline__ unsigned pk2(float lo, float hi) { return f2bf(lo) | (f2bf(hi) << 16); }
__device__ __forceinline__ float sigmoidf_(float x) { return 1.0f / (1.0f + __expf(-x)); }
__device__ __forceinline__ float wave_sum(float v) {
#pragma unroll
    for (int o = 1; o < 64; o <<= 1) v += __shfl_xor(v, o);
    return v;
}
#define LDS_WAIT() asm volatile("s_waitcnt lgkmcnt(0)" ::: "memory")

namespace pg8 {
struct EpiIn {
    static constexpr bool PERM = true, AFTER_DRAIN = false, MID = false;
    bf16_t* P1; bf16_t* PG; const float* bias;
    __device__ __forceinline__ void operator()(const f32x4 (&acc)[2][2][4][2], const Unit& u, int wr, int wc, int fr, int fq) const {
        const int pn = u.pn;
        const int row0 = u.pm * BM + wr * 64 + fr;
        if (pn >= 14) {
            const int ch0 = (pn - 14) * 128 + wc * 32 + 8 * fq;
            f32x4 ba[2], bb[2];
#pragma unroll
            for (int n = 0; n < 2; ++n) { ba[n] = *(const f32x4*)(bias + ch0 + 4 * n); bb[n] = *(const f32x4*)(bias + 1024 + ch0 + 4 * n); }
#pragma unroll
            for (int ai = 0; ai < 2; ++ai)
#pragma unroll
                for (int m = 0; m < 4; ++m) { bf16_t* rowp = PG + (size_t)(row0 + ai * HALF + m * 16) * NPG + ch0;
                    f32x4 r[2], g[2];
#pragma unroll
                    for (int n = 0; n < 2; ++n) { const f32x4 a = acc[ai][0][m][n] + ba[n], b = acc[ai][1][m][n] + bb[n];
#pragma unroll
                        for (int j = 0; j < 4; ++j) { const float ea = __expf(-a[j]), eb = __expf(-b[j]); g[n][j] = __builtin_amdgcn_rcpf(1.0f + eb); r[n][j] = (1.0f + eb) * __builtin_amdgcn_rcpf(1.0f + ea); } }
                    u32x4 w; w.x = cvt_pk_bf16(r[0][0], r[0][1]); w.y = cvt_pk_bf16(r[0][2], r[0][3]); w.z = cvt_pk_bf16(r[1][0], r[1][1]); w.w = cvt_pk_bf16(r[1][2], r[1][3]);
                    *(u32x4*)rowp = w;
                    w.x = cvt_pk_bf16(g[0][0], g[0][1]); w.y = cvt_pk_bf16(g[0][2], g[0][3]); w.z = cvt_pk_bf16(g[1][0], g[1][1]); w.w = cvt_pk_bf16(g[1][2], g[1][3]);
                    *(u32x4*)(rowp + 1024) = w; }
            return;
        }
        int mode = 0; float scl = 1.0f;
        if (pn == 0) scl = 0.125f;
        else if (pn == 4 || pn == 5 || pn == 12 || pn == 13) mode = 1;
        else if (pn == 6 || pn == 7) { mode = 1; scl = 0.08838834764831845f; }
        const int col0 = pn * 256 + wc * 32 + 8 * fq;
#pragma unroll
        for (int ai = 0; ai < 2; ++ai)
#pragma unroll
            for (int m = 0; m < 4; ++m) { bf16_t* rowp = P1 + (size_t)(row0 + ai * HALF + m * 16) * NP1 + col0;
#pragma unroll
                for (int bj = 0; bj < 2; ++bj) { f32x4 v0 = acc[ai][bj][m][0], v1 = acc[ai][bj][m][1];
                    if (mode == 0) { v0 = v0 * scl; v1 = v1 * scl; }
                    else {
#pragma unroll
                        for (int j = 0; j < 4; ++j) { v0[j] = v0[j] * scl * __builtin_amdgcn_rcpf(1.0f + __expf(-v0[j])); v1[j] = v1[j] * scl * __builtin_amdgcn_rcpf(1.0f + __expf(-v1[j])); } }
                    u32x4 w; w.x = cvt_pk_bf16(v0[0], v0[1]); w.y = cvt_pk_bf16(v0[2], v0[3]); w.z = cvt_pk_bf16(v1[0], v1[1]); w.w = cvt_pk_bf16(v1[2], v1[3]);
                    *(u32x4*)(rowp + bj * HALF) = w; } }
    }
};
struct EpiUp {
    static constexpr bool PERM = true, AFTER_DRAIN = false, MID = true;
    const bf16_t* PG; bf16_t* Mo;
    __device__ __forceinline__ void mid(f32x4 (&acc)[2][2][4][2], const Unit& u, int wr, int wc, int fr_, int fq) const {
        int fr = fr_; asm volatile("" : "+v"(fr));
        const int row0 = u.pm * BM + wr * 64 + fr, col0 = u.pn * BM + wc * 32 + 8 * fq;
#pragma unroll
        for (int ai = 0; ai < 2; ++ai) {
            u32x4 rv[4][2];
#pragma unroll
            for (int m = 0; m < 4; ++m) { const bf16_t* gp = PG + (size_t)(row0 + ai * HALF + m * 16) * NPG + col0;
#pragma unroll
                for (int bj = 0; bj < 2; ++bj) rv[m][bj] = *(const u32x4*)(gp + bj * HALF); }
#pragma unroll
            for (int m = 0; m < 4; ++m)
#pragma unroll
                for (int bj = 0; bj < 2; ++bj) { const u32x4 ga = rv[m][bj];
                    acc[ai][bj][m][0] = acc[ai][bj][m][0] * (f32x4){bflo(ga.x), bfhi(ga.x), bflo(ga.y), bfhi(ga.y)};
                    acc[ai][bj][m][1] = acc[ai][bj][m][1] * (f32x4){bflo(ga.z), bfhi(ga.z), bflo(ga.w), bfhi(ga.w)}; }
            __builtin_amdgcn_sched_barrier(0);
        }
    }
    __device__ __forceinline__ void operator()(const f32x4 (&acc)[2][2][4][2], const Unit& u, int wr, int wc, int fr, int fq) const {
        const int row0 = u.pm * BM + wr * 64 + fr, col0 = u.pn * BM + wc * 32 + 8 * fq;
#pragma unroll
        for (int ai = 0; ai < 2; ++ai)
#pragma unroll
            for (int m = 0; m < 4; ++m) { const size_t row = (size_t)(row0 + ai * HALF + m * 16); const bf16_t* gp = PG + row * NPG + 1024 + col0; bf16_t* op = Mo + row * D + col0;
#pragma unroll
                for (int bj = 0; bj < 2; ++bj) { const u32x4 gb = *(const u32x4*)(gp + bj * HALF);
                    const f32x4 a0 = acc[ai][bj][m][0], a1 = acc[ai][bj][m][1];
                    u32x4 w; w.x = cvt_pk_bf16(a0[0] * bflo(gb.x), a0[1] * bfhi(gb.x)); w.y = cvt_pk_bf16(a0[2] * bflo(gb.y), a0[3] * bfhi(gb.y));
                    w.z = cvt_pk_bf16(a1[0] * bflo(gb.z), a1[1] * bfhi(gb.z)); w.w = cvt_pk_bf16(a1[2] * bflo(gb.w), a1[3] * bfhi(gb.w));
                    *(u32x4*)(op + bj * HALF) = w; } }
    }
};
struct EpiOut {
    static constexpr bool PERM = false, AFTER_DRAIN = false, MID = false;
    const float* xin; float* out; const float* gate2;
    __device__ __forceinline__ void operator()(const f32x4 (&acc)[2][2][4][2], const Unit& u, int wr, int wc, int fr, int fq) const {
        const int row0 = u.pm * BM + wr * 64 + fr, col0 = u.pn * BM + wc * 32 + 4 * fq;
        const float* gate = gate2 + ((u.pm * BM) / SEQ) * 3072;
        f32x4 gv[2][2];
#pragma unroll
        for (int bj = 0; bj < 2; ++bj)
#pragma unroll
            for (int n = 0; n < 2; ++n) gv[bj][n] = *(const f32x4*)(gate + col0 + bj * HALF + n * 16);
#pragma unroll
        for (int ai = 0; ai < 2; ++ai)
#pragma unroll
            for (int m = 0; m < 4; ++m) { const size_t off = (size_t)(row0 + ai * HALF + m * 16) * D + col0;
#pragma unroll
                for (int bj = 0; bj < 2; ++bj)
#pragma unroll
                    for (int n = 0; n < 2; ++n) { const f32x4 xv = *(const f32x4*)(xin + off + bj * HALF + n * 16);
                        *(f32x4*)(out + off + bj * HALF + n * 16) = xv + gv[bj][n] * acc[ai][bj][m][n]; } }
    }
};
}

__device__ __forceinline__ void transpose_item(const float* W, int ldw, int src_col0, int k0, bf16* WT, int dst_row0, int dst_k0, LAS float* scr, int lane) {
#pragma unroll
    for (int i = 0; i < 32; ++i) { const int kk = 2 * i + (lane >> 5); scr[kk * 33 + (lane & 31)] = W[(size_t)(k0 + kk) * ldw + src_col0 + (lane & 31)]; }
    LDS_WAIT();
    const int c = lane & 7;
#pragma unroll
    for (int j = 0; j < 4; ++j) { const int n = (lane >> 3) + 8 * j; const LAS float* s = scr + (8 * c) * 33 + n;
        u32x4 o; o.x = pk2(s[0 * 33], s[1 * 33]); o.y = pk2(s[2 * 33], s[3 * 33]); o.z = pk2(s[4 * 33], s[5 * 33]); o.w = pk2(s[6 * 33], s[7 * 33]);
        *(u32x4*)(WT + (size_t)(dst_row0 + n) * D + dst_k0 + 8 * c) = o; }
    LDS_WAIT();
}

__device__ __forceinline__ void phase_prologue(const Params& p, LAS unsigned char* lds) {
    int tid_ = threadIdx.x; asm volatile("" : "+v"(tid_));
    const int tid = tid_, lane = tid & 63, wave = tid >> 6;
    unsigned char* ws = p.ws;
    for (int task = blockIdx.x; task < DEPTH * 96; task += gridDim.x) {
        const int l = task / 96, cgp = task % 96, col = tid & 31, ks = tid >> 5;
        const float* W = p.in[3] + (size_t)l * D * 3072 + cgp * 32 + col;
        const float* c0 = p.in[1], *c1 = p.in[1] + D;
        float s0 = 0.f, s1 = 0.f;
#pragma unroll 16
        for (int k = ks * 64; k < ks * 64 + 64; ++k) { const float w = W[(size_t)k * 3072]; const float a = c0[k], b = c1[k];
            s0 += a * sigmoidf_(a) * w; s1 += b * sigmoidf_(b) * w; }
        LAS float* red = (LAS float*)(lds + 98304);
        red[(ks * 32 + col) * 2 + 0] = s0; red[(ks * 32 + col) * 2 + 1] = s1;
        __syncthreads();
        if (tid < 64) { const int cc = tid & 31, bb = tid >> 5; float s = 0.f;
#pragma unroll
            for (int k = 0; k < 16; ++k) s += red[(k * 32 + cc) * 2 + bb];
            const int cglob = cgp * 32 + cc;
            ((float*)(ws + WS_MOD))[(l * BATCH + bb) * 3072 + cglob] = s + p.in[4][l * 3072 + cglob]; }
        __syncthreads();
    }
    LAS float* scr = (LAS float*)(lds + wave * 8704);
    const int gw = blockIdx.x * NWAVES + wave, NGW = gridDim.x * NWAVES;
    constexpr int I_IN = 16 * 176, I_UP = 8 * 32, I_OUT = 16 * 32, I_LR = 16, I_L = I_IN + 2 * I_UP + I_OUT + I_LR;
    for (int it = gw; it < DEPTH * I_L; it += NGW) {
        const int l = it / I_L; int r = it % I_L;
        if (r < I_IN) { const int kb = r / 176, nb = r % 176, n0 = 32 * nb;
            transpose_item(p.in[5] + (size_t)l * D * IN_TOTAL, IN_TOTAL, n0 < 1536 ? n0 : (n0 < 3584 ? n0 + 16 : 3600 + (((n0 - 3584) >> 7) & 1) * 1024 + ((n0 - 3584) >> 8) * 128 + (n0 & 127)), 64 * kb, (bf16*)(ws + WS_WIN) + (size_t)l * NP * D, n0, 64 * kb, scr, lane); continue; }
        r -= I_IN;
        if (r < I_UP) { const int kb = r / 32, nb = r % 32;
            transpose_item(p.in[12] + (size_t)l * 512 * D, D, 32 * nb, 64 * kb, (bf16*)(ws + WS_WUP) + (size_t)l * D * D, 32 * nb, 64 * kb, scr, lane); continue; }
        r -= I_UP;
        if (r < I_UP) { const int kb = r / 32, nb = r % 32;
            transpose_item(p.in[13] + (size_t)l * 512 * D, D, 32 * nb, 64 * kb, (bf16*)(ws + WS_WUP) + (size_t)l * D * D, 32 * nb, 512 + 64 * kb, scr, lane); continue; }
        r -= I_UP;
        if (r >= I_OUT) { const int kb = r - I_OUT;
            transpose_item(p.in[5] + (size_t)l * D * IN_TOTAL, IN_TOTAL, 1536, 64 * kb, (bf16*)(ws + WS_WLR) + (size_t)l * 32 * D, 0, 64 * kb, scr, lane); continue; }
        { const int kb = r / 32, nb = r % 32;
            transpose_item(p.in[14] + (size_t)l * D * D, D, 32 * nb, 64 * kb, (bf16*)(ws + WS_WOUT) + (size_t)l * D * D, 32 * nb, 64 * kb, scr, lane); }
    }
}

__device__ __forceinline__ void phase_norm(const Params& p, LAS unsigned char* lds, int l, const float* xin) {
    int tid_ = threadIdx.x; asm volatile("" : "+v"(tid_));
    const int tid = tid_, lane = tid & 63, wave = tid >> 6, m = lane & 15, q = lane >> 4;
    unsigned char* ws = p.ws;
    constexpr int TRS = 2064;
    LAS unsigned char* tile = lds + wave * (8 * TRS);
    LAS float* wscr = (LAS float*)(lds + 8 * 8 * TRS) + wave * 128;
    f32x4 wa2r[16];
#pragma unroll
    for (int n = 0; n < 16; ++n) wa2r[n] = *(const f32x4*)(p.in[6] + l * 4096 + n * 256 + lane * 4);
    f32x4 nw[4];
#pragma unroll
    for (int j = 0; j < 4; ++j) nw[j] = *(const f32x4*)(p.in[2] + l * D + lane * 4 + 256 * j);
    const f32x4 ba4 = *(const f32x4*)(p.in[7] + l * 256 + lane * 4);
    const float* mod = (const float*)(ws + WS_MOD) + (size_t)l * BATCH * 3072;
    bf16* H = (bf16*)(ws + WS_H); float* LA = (float*)(ws + WS_LOGA);
    const bf16* wlr = (const bf16*)(ws + WS_WLR) + (size_t)l * 32 * D + m * D + q * 8;
    const LAS unsigned char* arow = tile + (m & 7) * TRS + q * 16;
    const int gw = blockIdx.x * NWAVES + wave, NGW = gridDim.x * NWAVES;
    int bcur = -1;
    f32x4 hm[4], ha[4], xn[2][4];
    if (gw * 8 < T) {
#pragma unroll
        for (int rr = 0; rr < 2; ++rr)
#pragma unroll
            for (int j = 0; j < 4; ++j) xn[rr][j] = ((const f32x4*)(xin + (size_t)(gw * 8 + rr) * D) + lane)[64 * j]; }
#pragma unroll 1
    for (int t = gw; t < T / 8; t += NGW) {
        const int r0 = t * 8, b = r0 / SEQ;
        if (b != bcur) { bcur = b;
#pragma unroll
            for (int j = 0; j < 4; ++j) { ha[j] = *(const f32x4*)(mod + b * 3072 + lane * 4 + 256 * j); const f32x4 sc = *(const f32x4*)(mod + b * 3072 + 1024 + lane * 4 + 256 * j); hm[j] = nw[j] * (1.0f + sc); } }
#pragma unroll 1
        for (int rp = 0; rp < 4; ++rp) {
            f32x4 hv[2][4];
#pragma unroll
            for (int rr = 0; rr < 2; ++rr)
#pragma unroll
                for (int j = 0; j < 4; ++j) hv[rr][j] = xn[rr][j];
            {
                int rn = r0 + 2 * rp + 2;
                if (rp == 3) rn = (t + NGW < T / 8) ? (t + NGW) * 8 : r0;
#pragma unroll
                for (int rr = 0; rr < 2; ++rr)
#pragma unroll
                    for (int j = 0; j < 4; ++j) xn[rr][j] = ((const f32x4*)(xin + (size_t)(rn + rr) * D) + lane)[64 * j];
            }
#pragma unroll
            for (int rr = 0; rr < 2; ++rr) {
                float s = 0.f;
#pragma unroll
                for (int j = 0; j < 4; ++j) s += (hv[rr][j].x * hv[rr][j].x + hv[rr][j].y * hv[rr][j].y) + (hv[rr][j].z * hv[rr][j].z + hv[rr][j].w * hv[rr][j].w);
                const float rstd = __builtin_amdgcn_rsqf(wave_sum(s) * (1.0f / D) + EPS);
                const int row = 2 * rp + rr;
                u32x2* o8 = (u32x2*)(H + (size_t)(r0 + row) * D) + lane;
                LAS u32x2* t8 = (LAS u32x2*)(tile + row * TRS) + lane;
#pragma unroll
                for (int j = 0; j < 4; ++j) { const f32x4 hh = hv[rr][j] * rstd * hm[j] + ha[j];
                    const u32x2 pk = (u32x2){pg8::cvt_pk_bf16(hh.x, hh.y), pg8::cvt_pk_bf16(hh.z, hh.w)};
                    o8[64 * j] = pk; t8[64 * j] = pk; }
            }
        }
        LDS_WAIT();
        f32x4 acc = (f32x4){0.f, 0.f, 0.f, 0.f};
#pragma unroll 8
        for (int ks = 0; ks < 32; ++ks) {
            const bf16x8 af = *(const LAS bf16x8*)(arow + ks * 64);
            const bf16x8 bfr = *(const bf16x8*)(wlr + ks * 32);
            acc = __builtin_amdgcn_mfma_f32_16x16x32_bf16(af, bfr, acc, 0, 0, 0);
        }
        if (q < 2) {
#pragma unroll
            for (int j = 0; j < 4; ++j) wscr[(q * 4 + j) * 16 + m] = acc[j]; }
        LDS_WAIT();
#pragma unroll 2
        for (int row = 0; row < 8; ++row) {
            f32x4 z = ba4;
#pragma unroll
            for (int n4 = 0; n4 < 4; ++n4) { const f32x4 g = *(const LAS f32x4*)(wscr + row * 16 + n4 * 4);
                z += wa2r[n4 * 4 + 0] * g.x; z += wa2r[n4 * 4 + 1] * g.y; z += wa2r[n4 * 4 + 2] * g.z; z += wa2r[n4 * 4 + 3] * g.w; }
            f32x4 lo;
#pragma unroll
            for (int i = 0; i < 4; ++i) lo[i] = -(fmaxf(-z[i], 0.f) + __logf(1.0f + __expf(-fabsf(z[i])))) * 0.0625f;
            *(f32x4*)(LA + (size_t)(r0 + row) * 256 + lane * 4) = lo;
        }
        LDS_WAIT();
    }
}

constexpr int MX_KD = 0, MX_QS = 16384, MX_OCT = 33792, MX_ADEC = 37888, MX_OT = 38400, MX_RA = 72192, MX_RV = 89600;
constexpr int MX_RSV = 272;

#define TR_READ(dst, addr, OFF) asm volatile("ds_read_b64_tr_b16 %0, %1 offset:%2" : "=&v"(dst) : "v"(addr), "n"(OFF) : "memory")

template <bool HG, bool FIN>
__device__ __forceinline__ void mixer_unit(const Params& p, LAS unsigned char* lds, int l, int b, int h, int jg) {
    constexpr int DK = HG ? 128 : 64, KT = DK / 16, QSTR = DK + 8, RSA = DK * 2 + 16;
    constexpr int KCOL = HG ? C_HF : C_GK, VCOL = HG ? C_HI : C_GV, QCOL = HG ? C_HQ : C_GQ, ZCOL = HG ? C_HZ : C_GZ;
    constexpr int NOCT = HG ? 2 : 1;
    constexpr int PPR = DK / 8, NQ = (64 * PPR) / NTHREADS;
    int tid_ = threadIdx.x; asm volatile("" : "+v"(tid_));
    const int tid = tid_, lane = tid & 63, w = tid >> 6, n = lane & 15, q = lane >> 4, qq = n >> 2, pp = lane & 3;
    unsigned char* ws = p.ws;
    const bf16* P1 = (const bf16*)(ws + WS_P1);
    const float* LA = (const float*)(ws + WS_LOGA);
    bf16* OB = (bf16*)(ws + WS_H);
    float* SB = (float*)(ws + (HG ? WS_STATE_HG : WS_STATE)) + (size_t)((b * 4 + h) * NG + jg) * (DK * 128);
    float* PD = (float*)(ws + WS_PDEC) + (size_t)(((HG ? 0 : 8) + b * 4 + h) * NG + jg) * 128;
    LAS unsigned char* KD = lds + MX_KD;
    LAS bf16* QS = (LAS bf16*)(lds + MX_QS);
    LAS float* OCT = (LAS float*)(lds + MX_OCT);
    LAS float* ADEC = (LAS float*)(lds + MX_ADEC);
    LAS float* OT = (LAS float*)(lds + MX_OT);
    LAS unsigned char* RA = lds + MX_RA;
    LAS unsigned char* RV = lds + MX_RV;

    const int c = HG ? (tid & 127) : (tid & 63);
    const int o_first = HG ? (tid >> 7) : (tid >> 6);
    const unsigned tra = (unsigned)(size_t)RA + (unsigned)((o_first * 8 + qq) * RSA + ((c & ~15) + 4 * pp) * 2);
    const unsigned trv = (unsigned)(size_t)RV + (unsigned)((8 * q + qq) * MX_RSV + (16 * w + 4 * pp) * 2);
    float lb = 0.f, lbf = 1e-30f, oml = 1.0f;
    if (HG) { if (l > 0) { const float g0 = p.in[9][h * 128 + c], g1 = p.in[9][512 + h * 128 + c]; lb = 1.0f / (1.0f + __expf(g0 - g1)); lb = fminf(fmaxf(lb, 0.f), 1.0f - 1e-6f); }
        lbf = fmaxf(lb, 1e-30f); oml = 1.0f - lb; }
    float nwv[16];
    if (FIN) { const float* nwp = (HG ? p.in[10] : p.in[8]) + l * 128 + (tid & 7) * 16;
#pragma unroll
        for (int i = 0; i < 16; ++i) nwv[i] = nwp[i]; }

    f32x4 S[KT];
    if (FIN) {
#pragma unroll
        for (int kt = 0; kt < KT; ++kt) S[kt] = *(const f32x4*)(SB + (size_t)((w * KT + kt) * 64 + lane) * 4);
    } else {
#pragma unroll
        for (int kt = 0; kt < KT; ++kt) S[kt] = (f32x4){0.f, 0.f, 0.f, 0.f};
    }
    float pprod = 1.0f;

    const int rowg = b * SEQ + jg * G_CH * 64;
    u32x4 araw[NQ], vraw[2], qraw[NQ], zraw[2]; float laraw[8];
    const bf16* aptr = P1 + (size_t)rowg * NP1 + KCOL + h * DK;
    const float* laptr = LA + (size_t)rowg * 256 + h * 64 + c;
    const bf16* vptr = P1 + (size_t)rowg * NP1 + VCOL + h * 128;
    const bf16* qptr = P1 + (size_t)rowg * NP1 + QCOL + h * DK;
    const bf16* zptr = P1 + (size_t)(rowg + (tid >> 3)) * NP1 + ZCOL + h * 128 + (tid & 7) * 16;
#define MX_LOAD_A(cc_) do { const size_t ro_ = (size_t)(cc_) * 64; \
        _Pragma("unroll") for (int pq = 0; pq < NQ; ++pq) { const int pc = tid + pq * NTHREADS; araw[pq] = *(const u32x4*)(aptr + (ro_ + pc / PPR) * NP1 + (pc % PPR) * 8); } \
        if (!HG) { _Pragma("unroll") for (int i = 0; i < 8; ++i) laraw[i] = laptr[(ro_ + o_first * 8 + i) * 256]; } } while (0)
#define MX_LOAD_V(cc_) do { const size_t ro_ = (size_t)(cc_) * 64; \
        _Pragma("unroll") for (int pq = 0; pq < 2; ++pq) { const int pc = tid + pq * NTHREADS; vraw[pq] = *(const u32x4*)(vptr + (ro_ + pc / 16) * NP1 + (pc % 16) * 8); } } while (0)
#define MX_LOAD_Q(cc_) do { const size_t ro_ = (size_t)(cc_) * 64; \
        _Pragma("unroll") for (int pq = 0; pq < NQ; ++pq) { const int pc = tid + pq * NTHREADS; qraw[pq] = *(const u32x4*)(qptr + (ro_ + pc / PPR) * NP1 + (pc % PPR) * 8); } } while (0)
#define MX_LOAD_Z(cc_) do { const size_t ro_ = (size_t)(cc_) * 64; zraw[0] = *(const u32x4*)(zptr + ro_ * NP1); zraw[1] = *(const u32x4*)(zptr + ro_ * NP1 + 8); } while (0)
    MX_LOAD_A(0); MX_LOAD_V(0);
    if (FIN) { MX_LOAD_Q(0); MX_LOAD_Z(0); }

#pragma unroll 1
    for (int cc = 0; cc < G_CH; ++cc) {
        const int ccn = (cc + 1 < G_CH) ? cc + 1 : cc;
        const int row0 = rowg + cc * 64;
#pragma unroll
        for (int pq = 0; pq < NQ; ++pq) { const int pc = tid + pq * NTHREADS; *(LAS u32x4*)(RA + (pc / PPR) * RSA + (pc % PPR) * 16) = araw[pq]; }
#pragma unroll
        for (int pq = 0; pq < 2; ++pq) { const int pc = tid + pq * NTHREADS; *(LAS u32x4*)(RV + (pc / 16) * MX_RSV + (pc % 16) * 16) = vraw[pq]; }
        if (FIN) {
#pragma unroll
            for (int pq = 0; pq < NQ; ++pq) { const int pc = tid + pq * NTHREADS; *(LAS u32x4*)(QS + (pc / PPR) * QSTR + (pc % PPR) * 8) = qraw[pq]; } }
        float lacur[8];
        if (!HG) {
#pragma unroll
            for (int i = 0; i < 8; ++i) lacur[i] = laraw[i]; }
        MX_LOAD_A(ccn); MX_LOAD_V(ccn);
        if (FIN) MX_LOAD_Q(ccn);
        LDS_WAIT(); __syncthreads();
        u32x2 art[NOCT][2], vrt[2][2];
        TR_READ(art[0][0], tra, 0); TR_READ(art[0][1], tra, 4 * RSA);
        if (HG) { TR_READ(art[NOCT - 1][0], tra, 32 * RSA); TR_READ(art[NOCT - 1][1], tra, 36 * RSA); }
        TR_READ(vrt[0][0], trv, 0); TR_READ(vrt[0][1], trv, 4 * MX_RSV); TR_READ(vrt[1][0], trv, 32 * MX_RSV); TR_READ(vrt[1][1], trv, 36 * MX_RSV);
        if (HG) asm volatile("s_waitcnt lgkmcnt(0)" : "+v"(art[0][0]), "+v"(art[0][1]), "+v"(art[NOCT - 1][0]), "+v"(art[NOCT - 1][1]), "+v"(vrt[0][0]), "+v"(vrt[0][1]), "+v"(vrt[1][0]), "+v"(vrt[1][1]) :: "memory");
        else asm volatile("s_waitcnt lgkmcnt(0)" : "+v"(art[0][0]), "+v"(art[0][1]), "+v"(vrt[0][0]), "+v"(vrt[0][1]), "+v"(vrt[1][0]), "+v"(vrt[1][1]) :: "memory");
        float fg[NOCT][8], kv[NOCT][8];
#pragma unroll
        for (int oi = 0; oi < NOCT; ++oi) { const int o = o_first + 4 * oi;
#pragma unroll
            for (int i = 0; i < 8; ++i) { const unsigned wv = (i & 2) ? art[oi][i >> 2].y : art[oi][i >> 2].x; const float x = (i & 1) ? bfhi(wv) : bflo(wv);
                if (HG) { const float zf = fminf(fmaxf(x, -80.f), 80.f);
                    const float e = __expf(-zf), s = __builtin_amdgcn_rcpf(1.0f + e);
                    fg[oi][i] = lbf + oml * s; kv[oi][i] = oml * e * s; }
                else { fg[oi][i] = __expf(lacur[i]); kv[oi][i] = x; } }
            float pr = 1.0f;
#pragma unroll
            for (int i = 0; i < 8; ++i) pr *= fg[oi][i];
            OCT[o * 128 + c] = pr; }
        LDS_WAIT(); __syncthreads();
#pragma unroll
        for (int oi = 0; oi < NOCT; ++oi) { const int o = o_first + 4 * oi;
            float suf = 1.0f;
#pragma unroll
            for (int o2 = 1; o2 < 8; ++o2) { const float t = OCT[o2 * 128 + c]; suf *= (o2 > o) ? t : 1.0f; }
            float kd[8];
#pragma unroll
            for (int i = 7; i >= 0; --i) { kd[i] = kv[oi][i] * suf; suf *= fg[oi][i]; }
            u32x4 pk; pk.x = pg8::cvt_pk_bf16(kd[0], kd[1]); pk.y = pg8::cvt_pk_bf16(kd[2], kd[3]); pk.z = pg8::cvt_pk_bf16(kd[4], kd[5]); pk.w = pg8::cvt_pk_bf16(kd[6], kd[7]);
            *(LAS u32x4*)(KD + (size_t)((((c >> 4) * 2 + (o >> 2)) * 64 + (o & 3) * 16 + (c & 15)) * 16)) = pk;
            if (o == 0) { ADEC[c] = suf; pprod *= suf; } }
        LDS_WAIT(); __syncthreads();
        union { u32x4 u; bf16x8 v; } vf[2];
        vf[0].u = (u32x4){vrt[0][0].x, vrt[0][0].y, vrt[0][1].x, vrt[0][1].y}; vf[1].u = (u32x4){vrt[1][0].x, vrt[1][0].y, vrt[1][1].x, vrt[1][1].y};
#pragma unroll
        for (int kt = 0; kt < KT; ++kt) { const f32x4 a4 = *(const LAS f32x4*)(ADEC + kt * 16 + q * 4); S[kt] = S[kt] * a4;
#pragma unroll
            for (int ks = 0; ks < 2; ++ks) { const bf16x8 af = *(const LAS bf16x8*)(KD + (size_t)(((kt * 2 + ks) * 64 + lane) * 16));
                S[kt] = __builtin_amdgcn_mfma_f32_16x16x32_bf16(af, vf[ks].v, S[kt], 0, 0, 0); } }
        if (FIN) {
            f32x4 oacc[4];
#pragma unroll
            for (int lt = 0; lt < 4; ++lt) oacc[lt] = (f32x4){0.f, 0.f, 0.f, 0.f};
#pragma unroll
            for (int kk = 0; kk < KT / 2; ++kk) {
                union { u32x4 u; bf16x8 v; } bs;
                bs.u.x = pg8::cvt_pk_bf16(S[2 * kk][0], S[2 * kk][1]); bs.u.y = pg8::cvt_pk_bf16(S[2 * kk][2], S[2 * kk][3]); bs.u.z = pg8::cvt_pk_bf16(S[2 * kk + 1][0], S[2 * kk + 1][1]); bs.u.w = pg8::cvt_pk_bf16(S[2 * kk + 1][2], S[2 * kk + 1][3]);
#pragma unroll
                for (int lt = 0; lt < 4; ++lt) {
                    union { u32x4 u; bf16x8 v; } aq;
                    const u32x2 q0 = *(const LAS u32x2*)(QS + (lt * 16 + n) * QSTR + (2 * kk) * 16 + q * 4), q1 = *(const LAS u32x2*)(QS + (lt * 16 + n) * QSTR + (2 * kk + 1) * 16 + q * 4);
                    aq.u = (u32x4){q0.x, q0.y, q1.x, q1.y};
                    oacc[lt] = __builtin_amdgcn_mfma_f32_16x16x32_bf16(aq.v, bs.v, oacc[lt], 0, 0, 0); } }
#pragma unroll
            for (int lt = 0; lt < 4; ++lt)
#pragma unroll
                for (int j = 0; j < 4; ++j) OT[(lt * 16 + q * 4 + j) * 132 + w * 16 + n] = oacc[lt][j];
            LDS_WAIT(); __syncthreads();
            { const int fl = tid >> 3, seg = tid & 7;
                f32x4 ov[4]; float ssq = 0.f;
#pragma unroll
                for (int i = 0; i < 4; ++i) { ov[i] = *(const LAS f32x4*)(OT + fl * 132 + seg * 16 + i * 4); ssq += (ov[i].x * ov[i].x + ov[i].y * ov[i].y) + (ov[i].z * ov[i].z + ov[i].w * ov[i].w); }
                ssq += __shfl_xor(ssq, 1); ssq += __shfl_xor(ssq, 2); ssq += __shfl_xor(ssq, 4);
                const float rstd = __builtin_amdgcn_rsqf(ssq * (1.0f / 128.0f) + EPS);
                const u32x4 zg0 = zraw[0], zg1 = zraw[1];
                MX_LOAD_Z(ccn);
                u32x4 w0, w1;
                w0.x = pg8::cvt_pk_bf16(ov[0].x * rstd * nwv[0] * bflo(zg0.x), ov[0].y * rstd * nwv[1] * bfhi(zg0.x)); w0.y = pg8::cvt_pk_bf16(ov[0].z * rstd * nwv[2] * bflo(zg0.y), ov[0].w * rstd * nwv[3] * bfhi(zg0.y));
                w0.z = pg8::cvt_pk_bf16(ov[1].x * rstd * nwv[4] * bflo(zg0.z), ov[1].y * rstd * nwv[5] * bfhi(zg0.z)); w0.w = pg8::cvt_pk_bf16(ov[1].z * rstd * nwv[6] * bflo(zg0.w), ov[1].w * rstd * nwv[7] * bfhi(zg0.w));
                w1.x = pg8::cvt_pk_bf16(ov[2].x * rstd * nwv[8] * bflo(zg1.x), ov[2].y * rstd * nwv[9] * bfhi(zg1.x)); w1.y = pg8::cvt_pk_bf16(ov[2].z * rstd * nwv[10] * bflo(zg1.y), ov[2].w * rstd * nwv[11] * bfhi(zg1.y));
                w1.z = pg8::cvt_pk_bf16(ov[3].x * rstd * nwv[12] * bflo(zg1.z), ov[3].y * rstd * nwv[13] * bfhi(zg1.z)); w1.w = pg8::cvt_pk_bf16(ov[3].z * rstd * nwv[14] * bflo(zg1.w), ov[3].w * rstd * nwv[15] * bfhi(zg1.w));
                bf16* op = OB + (size_t)(row0 + fl) * D + (HG ? 512 : 0) + h * 128 + seg * 16;
                *(u32x4*)op = w0; *(u32x4*)(op + 8) = w1; }
        }
    }
#undef MX_LOAD_A
#undef MX_LOAD_V
#undef MX_LOAD_Q
#undef MX_LOAD_Z
    if (!FIN) {
#pragma unroll
        for (int kt = 0; kt < KT; ++kt) *(f32x4*)(SB + (size_t)((w * KT + kt) * 64 + lane) * 4) = S[kt];
        if (o_first == 0) PD[c] = pprod;
    }
    __syncthreads();
}

template <bool FIN>
__device__ __forceinline__ void phase_mixer(const Params& p, LAS unsigned char* lds, int l) {
    for (int u = blockIdx.x; u < 512; u += gridDim.x) {
        const int rem = u & 255, b = rem >> 7, h = (rem >> 5) & 3, jg = rem & 31;
        if (!FIN && jg == NG - 1) continue;
        if (u < 256) mixer_unit<true, FIN>(p, lds, l, b, h, jg); else mixer_unit<false, FIN>(p, lds, l, b, h, jg);
    }
}

__device__ __forceinline__ void phase_scan(const Params& p) {
    unsigned char* ws = p.ws;
    int tid_ = threadIdx.x; asm volatile("" : "+v"(tid_));
    const int gt = blockIdx.x * NTHREADS + tid_, NT = gridDim.x * NTHREADS;
    for (int tt = gt; tt < 8 * 4096 + 8 * 2048; tt += NT) {
        const bool hg = tt < 32768; const int t2 = hg ? tt : tt - 32768, per = hg ? 4096 : 2048, bh = t2 / per, e = t2 % per, KT = hg ? 8 : 4;
        const int kt = (e >> 6) % KT, lane = e & 63, c4 = kt * 16 + (lane >> 4) * 4;
        float* base = (float*)(ws + (hg ? WS_STATE_HG : WS_STATE)) + (size_t)bh * NG * (per * 4) + (size_t)e * 4;
        const float* pd = (const float*)(ws + WS_PDEC) + (size_t)(((hg ? 0 : 8) + bh) * NG) * 128 + c4;
        f32x4 S = (f32x4){0.f, 0.f, 0.f, 0.f};
        for (int j0 = 0; j0 < NG; j0 += 8) {
            f32x4 Lv[8], Pv[8];
#pragma unroll
            for (int j = 0; j < 8; ++j) { if (j0 + j < NG - 1) { Lv[j] = *(const f32x4*)(base + (size_t)(j0 + j) * (per * 4)); Pv[j] = *(const f32x4*)(pd + (size_t)(j0 + j) * 128); } else { Lv[j] = (f32x4){0.f, 0.f, 0.f, 0.f}; Pv[j] = Lv[j]; } }
#pragma unroll
            for (int j = 0; j < 8; ++j) { *(f32x4*)(base + (size_t)(j0 + j) * (per * 4)) = S; S = Pv[j] * S + Lv[j]; }
        }
    }
}

__device__ __forceinline__ void phase_final_norm(const Params& p) {
    int tid_ = threadIdx.x; asm volatile("" : "+v"(tid_));
    const int tid = tid_, lane = tid & 63, wave = tid >> 6;
    f32x4 nw[4];
#pragma unroll
    for (int j = 0; j < 4; ++j) nw[j] = *(const f32x4*)(p.in[15] + lane * 4 + 256 * j);
    const int gw = blockIdx.x * NWAVES + wave, NGW = gridDim.x * NWAVES;
    f32x4 vn[4];
    if (gw < T) {
#pragma unroll
        for (int j = 0; j < 4; ++j) vn[j] = ((const f32x4*)(p.out + (size_t)gw * D) + lane)[64 * j]; }
#pragma unroll 1
    for (int r = gw; r < T; r += NGW) {
        f32x4* xr = (f32x4*)(p.out + (size_t)r * D) + lane;
        f32x4 v[4]; float s = 0.f;
#pragma unroll
        for (int j = 0; j < 4; ++j) v[j] = vn[j];
        { const int rn = (r + NGW < T) ? r + NGW : r;
#pragma unroll
          for (int j = 0; j < 4; ++j) vn[j] = ((const f32x4*)(p.out + (size_t)rn * D) + lane)[64 * j]; }
#pragma unroll
        for (int j = 0; j < 4; ++j) s += (v[j].x * v[j].x + v[j].y * v[j].y) + (v[j].z * v[j].z + v[j].w * v[j].w);
        const float rstd = __builtin_amdgcn_rsqf(wave_sum(s) * (1.0f / D) + EPS);
#pragma unroll
        for (int j = 0; j < 4; ++j) xr[64 * j] = v[j] * rstd * nw[j];
    }
}

#define XB_TMO      128
#define XB_XCNT(j)  (256  + 64 * (j))
#define XB_XSUB(j)  (1280 + 64 * (j))
#define XB_XGEN(j)  (2304 + 64 * (j))
#define XB_TOP      3328
#define XB_TOPGEN   3392
#define XCD_BAR_WORDS 3456
#define XB_SPIN_CAP (1u << 18)

__device__ __forceinline__ unsigned xb_ld(unsigned* p)              { return __hip_atomic_load(p, __ATOMIC_RELAXED, __HIP_MEMORY_SCOPE_AGENT); }
__device__ __forceinline__ unsigned xb_add(unsigned* p, unsigned v) { return __hip_atomic_fetch_add(p, v, __ATOMIC_RELAXED, __HIP_MEMORY_SCOPE_AGENT); }
__device__ __forceinline__ unsigned xb_xcc_id() { return (unsigned)__builtin_amdgcn_s_getreg((3 << 11) | 20) & 0xFu; }
#define XB_SPIN(cond, bar) do { unsigned _sp = 0; while (cond) { __builtin_amdgcn_s_sleep(1); \
    if ((++_sp & 255u) == 0u) { if (xb_ld(&(bar)[XB_TMO])) break; if (_sp > XB_SPIN_CAP) { atomicAdd(&(bar)[XB_TMO], 1u); break; } } } } while (0)

struct XcdBarrier {
    unsigned* bar; unsigned x;
    volatile LAS unsigned* st;
};

__device__ __forceinline__ XcdBarrier xcd_barrier_post(unsigned* bar, volatile LAS unsigned* st) {
    XcdBarrier b; b.bar = bar; b.x = xb_xcc_id(); b.st = st;
    if (threadIdx.x == 0) (void)xb_add(&bar[XB_XCNT(b.x)], 1u);
    return b;
}
__device__ __forceinline__ void xcd_barrier_complete(unsigned* bar, unsigned x, unsigned& nloc, unsigned& nx) {
    const unsigned G = gridDim.x * gridDim.y * gridDim.z;
    unsigned sum, cnt, mine, sp = 0u;
    for (;;) {
        sum = 0u; cnt = 0u; mine = 0u;
#pragma unroll
        for (unsigned j = 0; j < 16; ++j) { const unsigned c = xb_ld(&bar[XB_XCNT(j)]); sum += c; cnt += (c > 0u) ? 1u : 0u; mine = (j == x) ? c : mine; }
        if (sum == G) break;
        __builtin_amdgcn_s_sleep(1);
        if ((++sp & 255u) == 0u) { if (xb_ld(&bar[XB_TMO])) break; if (sp > XB_SPIN_CAP) { atomicAdd(&bar[XB_TMO], 1u); break; } }
    }
    nloc = mine > 0u ? mine : 1u; nx = cnt > 0u ? cnt : 1u;
}

__device__ __forceinline__ void xcd_barrier(const XcdBarrier& b) {
    asm volatile("s_waitcnt vmcnt(0)" ::: "memory");
    __syncthreads();
    if (threadIdx.x == 0) {
        unsigned* bar = b.bar;
        __builtin_amdgcn_s_waitcnt(0);
        unsigned nloc = b.st[0], nx = b.st[1];
        if (nloc == 0u) { xcd_barrier_complete(bar, b.x, nloc, nx); b.st[0] = nloc; b.st[1] = nx; }
        const unsigned old = xb_add(&bar[XB_XSUB(b.x)], 1u);
        const unsigned gen = old / nloc;
        if (old + 1u == (gen + 1u) * nloc) {
            __builtin_amdgcn_fence(__ATOMIC_RELEASE, "agent");
            asm volatile("s_waitcnt vmcnt(0)" ::: "memory");
            const unsigned og = xb_add(&bar[XB_TOP], 1u);
            const unsigned tg = og / nx;
            if (og + 1u == (tg + 1u) * nx) xb_add(&bar[XB_TOPGEN], 1u);
            else XB_SPIN(xb_ld(&bar[XB_TOPGEN]) == tg, bar);
            __builtin_amdgcn_fence(__ATOMIC_ACQUIRE, "agent");
            xb_add(&bar[XB_XGEN(b.x)], 1u);
            asm volatile("s_waitcnt vmcnt(0)" ::: "memory");
        } else {
            XB_SPIN(xb_ld(&bar[XB_XGEN(b.x)]) == gen, bar);
            __builtin_amdgcn_fence(__ATOMIC_ACQUIRE, "agent");
            asm volatile("s_waitcnt vmcnt(0)" ::: "memory");
        }
    }
    __syncthreads();
}


__global__ void __launch_bounds__(NTHREADS, 2) mega_fwd(Params p) {
    extern __shared__ __attribute__((aligned(16))) unsigned char lds_raw[];
    LAS unsigned char* lds = (LAS unsigned char*)lds_raw;
    cg::grid_group grid = cg::this_grid();
    unsigned char* ws = p.ws;
    unsigned* barw = (unsigned*)(ws + WS_BAR);
    volatile LAS unsigned* bst = (volatile LAS unsigned*)(lds + LDS_BYTES - 64);
    if (threadIdx.x < 2) bst[threadIdx.x] = 0u;
    if (blockIdx.x == 0) for (int i = threadIdx.x; i < XCD_BAR_WORDS; i += NTHREADS) barw[i] = 0u;
    phase_prologue(p, lds);
    grid.sync();
    const XcdBarrier xb = xcd_barrier_post(barw, bst);
#pragma unroll 1
    for (int l_ = 0; l_ < DEPTH; ++l_) {
        int l = l_; asm volatile("" : "+s"(l));
        const float* xin = (l == 0) ? p.in[0] : p.out;
        phase_norm(p, lds, l, xin);
        xcd_barrier(xb);
        {
            pg8::Gemm g{(const pg8::bf16_t*)(ws + WS_H), (const pg8::bf16_t*)(ws + WS_WIN) + (size_t)l * NP * D, T, NP, D};
            pg8::StaticOrder S; S.init(T, NP, (int)gridDim.x, (int)blockIdx.x);
            pg8::EpiIn E{(pg8::bf16_t*)(ws + WS_P1), (pg8::bf16_t*)(ws + WS_PG), p.in[11] + l * 2048};
            pg8::gemm_phase<pg8::EpiIn, pg8::StaticOrder, true, true>(lds, g, S, E);
        }
        xcd_barrier(xb);
        phase_mixer<false>(p, lds, l);
        xcd_barrier(xb);
        phase_scan(p);
        xcd_barrier(xb);
        phase_mixer<true>(p, lds, l);
        xcd_barrier(xb);
        {
            pg8::Gemm g{(const pg8::bf16_t*)(ws + WS_H), (const pg8::bf16_t*)(ws + WS_WUP) + (size_t)l * D * D, T, D, D};
            pg8::StaticOrder S; S.init(T, D, (int)gridDim.x, (int)blockIdx.x);
            pg8::EpiUp E{(const pg8::bf16_t*)(ws + WS_PG), (pg8::bf16_t*)(ws + WS_P1)};
            pg8::gemm_phase<pg8::EpiUp, pg8::StaticOrder, true, true>(lds, g, S, E);
        }
        xcd_barrier(xb);
        {
            pg8::Gemm g{(const pg8::bf16_t*)(ws + WS_P1), (const pg8::bf16_t*)(ws + WS_WOUT) + (size_t)l * D * D, T, D, D};
            pg8::StaticOrder S; S.init(T, D, (int)gridDim.x, (int)blockIdx.x);
            pg8::EpiOut E{xin, p.out, (const float*)(ws + WS_MOD) + (size_t)l * BATCH * 3072 + 2048};
            pg8::gemm_phase<pg8::EpiOut, pg8::StaticOrder, true, true>(lds, g, S, E);
        }
        xcd_barrier(xb);
    }
    phase_final_norm(p);
}

extern "C" void kernel_launch(void* const* d_in, const int* in_sizes, int n_in, void* d_out, int out_size, void* d_ws, size_t ws_size, hipStream_t stream) {
    static int grid = 0;
    if (grid == 0) {
        if (n_in != 16 || in_sizes[0] != T * D || out_size != T * D || ws_size < WS_END) { fprintf(stderr, "kernel_launch: unexpected shapes (n_in %d, in0 %d, out %d, ws %zu)\n", n_in, n_in > 0 ? in_sizes[0] : -1, out_size, ws_size); grid = -1; return; }
        int dev = 0, cus = 0, per_cu = 0;
        if (hipGetDevice(&dev) != hipSuccess || hipDeviceGetAttribute(&cus, hipDeviceAttributeMultiprocessorCount, dev) != hipSuccess) { fprintf(stderr, "kernel_launch: device query failed\n"); grid = -1; return; }
        if (hipFuncSetAttribute((const void*)mega_fwd, hipFuncAttributeMaxDynamicSharedMemorySize, LDS_BYTES) != hipSuccess) { fprintf(stderr, "kernel_launch: hipFuncSetAttribute failed\n"); grid = -1; return; }
        if (hipOccupancyMaxActiveBlocksPerMultiprocessor(&per_cu, (const void*)mega_fwd, NTHREADS, LDS_BYTES) != hipSuccess || per_cu < 1) { fprintf(stderr, "kernel_launch: occupancy query failed (%d)\n", per_cu); (void)hipGetLastError(); per_cu = 1; }
        grid = cus * per_cu;
    }
    if (grid < 0) return;
    Params p{};
    for (int i = 0; i < 16; ++i) p.in[i] = (const float*)d_in[i];
    p.out = (float*)d_out; p.ws = (unsigned char*)d_ws;
    void* args[] = {&p};
    const hipError_t e = hipLaunchCooperativeKernel((const void*)mega_fwd, dim3(grid), dim3(NTHREADS), args, LDS_BYTES, stream);
    if (e != hipSuccess) fprintf(stderr, "kernel_launch: cooperative launch failed: %s (grid %d)\n", hipGetErrorString(e), grid);
}
```

```cpp
#include <hip/hip_runtime.h>
#include <hip/hip_cooperative_groups.h>
#include <cstdio>
#include <cstdint>
namespace cg = cooperative_groups;
namespace pg8 {
#define PG8_LAS __attribute__((address_space(3)))
typedef unsigned short bf16_t;
typedef short bf16x8 __attribute__((ext_vector_type(8)));
typedef float f32x4 __attribute__((ext_vector_type(4)));
typedef unsigned u32x4 __attribute__((ext_vector_type(4)));
constexpr int BM = 256, BK = 64, HALF = 128, HTB = HALF * BK * 2  , STAGE_BYTES = 8 * HTB, NXCD = 8, WGM = 8;

__host__ __device__ __forceinline__ int lds_byte(int r, int c) { const int st = (r >> 4) * 2 + (c >> 5), rr = r & 15, cc = c & 31, ob = rr * 64 + cc * 2; return st * 1024 + (ob ^ (((ob >> 9) & 1) << 5)); }
__host__ __device__ __forceinline__ void stage_rc(int b, int& R, int& C) { const int st = b / 1024, sb = b % 1024, swz = sb ^ (((sb >> 9) & 1) << 5); R = (st >> 1) * 16 + swz / 64; C = (st & 1) * 32 + (swz % 64) / 2; }
__host__ __device__ __forceinline__ int perm32(int rho) { const int n = rho >> 4, i = rho & 15; return 8 * (i >> 2) + 4 * n + (i & 3); }

struct Unit { int pm, pn; };
struct Gemm { const bf16_t* A; const bf16_t* Bt; int M, N, K; };

struct StaticOrder {
    int nM, nN, nwg, G, c;
    __host__ __device__ void init(int M, int N, int G_, int c_) { nM = M / BM; nN = N / BM; nwg = nM * nN; G = G_; c = c_; }
    __host__ __device__ bool next(int i, Unit& u) const {
        const long L = (long)i * G + c; if (L >= nwg) return false;
        int wgid = (int)L; { const int q = nwg / NXCD, r = nwg % NXCD, xcd = wgid % NXCD, off = wgid / NXCD; wgid = (xcd < r ? xcd * (q + 1) : r * (q + 1) + (xcd - r) * q) + off; }
        const int nig = WGM * nN, gid = wgid / nig, fm = gid * WGM, gsz = (nM - fm) < WGM ? (nM - fm) : WGM;
        u.pm = fm + ((wgid % nig) % gsz); u.pn = (wgid % nig) / gsz; return true;
    }
    __device__ __forceinline__ void a_ready(const Unit&) const {}
    __device__ __forceinline__ void done(const Unit&) const {}
};
__device__ __forceinline__ unsigned cvt_pk_bf16(float lo, float hi) { unsigned r; asm volatile("v_cvt_pk_bf16_f32 %0, %1, %2" : "=v"(r) : "v"(lo), "v"(hi)); return r; }
template <class Epi, class Sched, bool ALIGN_EPI = false, bool SP2 = false>
__device__ __forceinline__ void gemm_phase(PG8_LAS unsigned char* lds, const Gemm g, const Sched& S, const Epi& E) {
    int tid_ = threadIdx.x; asm volatile("" : "+v"(tid_));
    const int tid = tid_, wid = __builtin_amdgcn_readfirstlane(tid >> 6), lane = tid & 63, wr = wid >> 2, wc = wid & 3, fr = lane & 15, fq = lane >> 4;
    const int K = g.K, nt = K / BK;
    unsigned voffA[2], voffB[2];
#pragma unroll
    for (int i = 0; i < 2; ++i) { int R, C; stage_rc(tid * 16 + i * 8192, R, C); const int Rb = Epi::PERM ? ((R & ~31) + perm32(R & 31)) : R;
        voffA[i] = (unsigned)(R * K + C) * 2u; voffB[i] = (unsigned)(Rb * K + C) * 2u; }
    const size_t kstep = (size_t)(BK * 2);
    const size_t hstep = (size_t)HALF * K * 2;
    const size_t tstep = 2 * hstep;
    const unsigned ldsw = (unsigned)wid * 1024u;
    const int aoff = lds_byte(wr * 64 + fr, fq * 8), boff = lds_byte(wc * 32 + fr, fq * 8);
#define PG8_SA(b, h) (((b) * 2 + (h)) * HTB)
#define PG8_SB(b, h) ((4 + (b) * 2 + (h)) * HTB)
#define PG8_STAGE(bufoff, gbase, voff) do { _Pragma("unroll") for (int _i = 0; _i < 2; ++_i) \
        __builtin_amdgcn_global_load_lds((const unsigned*)((const char*)(gbase) + (voff)[_i]), (PG8_LAS unsigned*)(lds + (bufoff) + ldsw + _i * 8192), 16, 0, 0); } while (0)
#define PG8_LDA(dst, b, h) do { _Pragma("unroll") for (int m = 0; m < 4; ++m) _Pragma("unroll") for (int k = 0; k < 2; ++k) dst[m][k] = *(const PG8_LAS bf16x8*)(lds + PG8_SA(b, h) + aoff + m * 2048 + k * 1024); } while (0)
#define PG8_LDB(dst, b, h) do { _Pragma("unroll") for (int n = 0; n < 2; ++n) _Pragma("unroll") for (int k = 0; k < 2; ++k) dst[n][k] = *(const PG8_LAS bf16x8*)(lds + PG8_SB(b, h) + boff + n * 2048 + k * 1024); } while (0)
#define PG8_MMA(ai, bj, At, Bt) do { __builtin_amdgcn_s_setprio(1); _Pragma("unroll") for (int m = 0; m < 4; ++m) _Pragma("unroll") for (int n = 0; n < 2; ++n) _Pragma("unroll") for (int k = 0; k < 2; ++k) \
        acc[ai][bj][m][n] = __builtin_amdgcn_mfma_f32_16x16x32_bf16(Bt[n][k], At[m][k], acc[ai][bj][m][n], 0, 0, 0); __builtin_amdgcn_s_setprio(0); } while (0)
#define PG8_WAIT_V(n) asm volatile("s_waitcnt vmcnt(" #n ")" ::: "memory")
#define PG8_WAIT_L(n) asm volatile("s_waitcnt lgkmcnt(" #n ")" ::: "memory")
#define PG8_BAR __builtin_amdgcn_s_barrier()
#define PG8_SCHED __builtin_amdgcn_sched_barrier(0)
    Unit cur, nxt; int ui = 0;
    if (!S.next(0, cur)) return;
    f32x4 acc[2][2][4][2];
#pragma unroll
    for (int a = 0; a < 2; ++a)
#pragma unroll
        for (int b = 0; b < 2; ++b)
#pragma unroll
            for (int m = 0; m < 4; ++m)
#pragma unroll
                for (int n = 0; n < 2; ++n) acc[a][b][m][n] = (f32x4){0.f, 0.f, 0.f, 0.f};
    bf16x8 At[4][2], B0[2][2], B1[2][2];
    const char* cA = (const char*)g.A + (size_t)cur.pm * tstep; const char* cB = (const char*)g.Bt + (size_t)cur.pn * tstep;
    S.a_ready(cur);
    if constexpr (SP2) {
        PG8_STAGE(PG8_SB(0, 0), cB, voffB); PG8_STAGE(PG8_SB(0, 1), cB + hstep, voffB); PG8_STAGE(PG8_SA(0, 0), cA, voffA); PG8_STAGE(PG8_SA(0, 1), cA + hstep, voffA);
        if (wr == 1) PG8_BAR;
        PG8_WAIT_V(2); PG8_BAR;
        PG8_STAGE(PG8_SB(1, 0), cB + kstep, voffB); PG8_STAGE(PG8_SA(1, 0), cA + kstep, voffA); PG8_STAGE(PG8_SB(1, 1), cB + hstep + kstep, voffB);
        PG8_WAIT_V(6); PG8_BAR;
    } else {
        PG8_STAGE(PG8_SB(0, 0), cB, voffB); PG8_STAGE(PG8_SA(0, 0), cA, voffA); PG8_STAGE(PG8_SB(0, 1), cB + hstep, voffB); PG8_STAGE(PG8_SA(0, 1), cA + hstep, voffA);
        if (wr == 1) PG8_BAR;
        PG8_WAIT_V(4); PG8_BAR;
        PG8_STAGE(PG8_SB(1, 0), cB + kstep, voffB); PG8_STAGE(PG8_SA(1, 0), cA + kstep, voffA); PG8_STAGE(PG8_SB(1, 1), cB + hstep + kstep, voffB);
        PG8_WAIT_V(6); PG8_BAR;
    }
    for (;;) {
        const bool has_next = S.next(ui + 1, nxt);
        const char* nA = has_next ? (const char*)g.A + (size_t)nxt.pm * tstep : cA; const char* nB = has_next ? (const char*)g.Bt + (size_t)nxt.pn * tstep : cB;
        for (int t = 0; t < nt; t += 2) {
            const bool last = (t == nt - 2);
            const char* a1 = cA + (size_t)(t + 1) * kstep;
            const char* a2 = last ? nA : cA + (size_t)(t + 2) * kstep; const char* b2 = last ? nB : cB + (size_t)(t + 2) * kstep;
            const char* a3 = a2 + kstep; const char* b3 = b2 + kstep;
            if (last && has_next) S.a_ready(nxt);
            if constexpr (Epi::MID) { if (t == nt / 2) E.mid(acc, cur, wr, wc, fr, fq); }
            if constexpr (SP2) {
            PG8_LDB(B0, 0, 0); PG8_LDB(B1, 0, 1); PG8_SCHED; PG8_LDA(At, 0, 0); PG8_STAGE(PG8_SA(1, 1), a1 + hstep, voffA);
            PG8_WAIT_V(8); PG8_WAIT_L(0); PG8_BAR; PG8_MMA(0, 0, At, B0); PG8_MMA(0, 1, At, B1); PG8_BAR; PG8_SCHED;
            PG8_LDA(At, 0, 1); PG8_STAGE(PG8_SB(0, 0), b2, voffB); PG8_STAGE(PG8_SB(0, 1), b2 + hstep, voffB); PG8_STAGE(PG8_SA(0, 0), a2, voffA);
            PG8_WAIT_V(8); PG8_WAIT_L(0); PG8_BAR; PG8_MMA(1, 0, At, B0); PG8_MMA(1, 1, At, B1); PG8_BAR; PG8_SCHED;
            PG8_LDB(B0, 1, 0); PG8_LDB(B1, 1, 1); PG8_SCHED; PG8_LDA(At, 1, 0); PG8_STAGE(PG8_SA(0, 1), a2 + hstep, voffA);
            PG8_WAIT_V(8); PG8_WAIT_L(0); PG8_BAR; PG8_MMA(0, 0, At, B0); PG8_MMA(0, 1, At, B1); PG8_BAR; PG8_SCHED;
            PG8_LDA(At, 1, 1); PG8_STAGE(PG8_SB(1, 0), b3, voffB); PG8_STAGE(PG8_SB(1, 1), b3 + hstep, voffB); PG8_STAGE(PG8_SA(1, 0), a3, voffA);
            PG8_WAIT_V(8); PG8_WAIT_L(0); PG8_BAR; PG8_MMA(1, 0, At, B0); PG8_MMA(1, 1, At, B1); PG8_BAR; PG8_SCHED;
            } else {
            PG8_LDB(B0, 0, 0); PG8_SCHED; PG8_LDA(At, 0, 0); PG8_STAGE(PG8_SA(1, 1), a1 + hstep, voffA);
            PG8_WAIT_L(8); PG8_BAR; PG8_WAIT_L(0); PG8_MMA(0, 0, At, B0); PG8_BAR; PG8_SCHED;
            PG8_LDB(B1, 0, 1); PG8_STAGE(PG8_SB(0, 0), b2, voffB);
            PG8_BAR; PG8_WAIT_L(0); PG8_MMA(0, 1, At, B1); PG8_BAR;
            PG8_LDA(At, 0, 1); PG8_STAGE(PG8_SA(0, 0), a2, voffA);
            PG8_BAR; PG8_WAIT_L(0); PG8_MMA(1, 0, At, B0); PG8_BAR; PG8_SCHED;
            PG8_STAGE(PG8_SB(0, 1), b2 + hstep, voffB);
            PG8_WAIT_V(6); PG8_BAR; PG8_MMA(1, 1, At, B1); PG8_BAR;
            PG8_LDB(B0, 1, 0); PG8_SCHED; PG8_LDA(At, 1, 0); PG8_STAGE(PG8_SA(0, 1), a2 + hstep, voffA);
            PG8_WAIT_L(8); PG8_BAR; PG8_WAIT_L(0); PG8_MMA(0, 0, At, B0); PG8_BAR; PG8_SCHED;
            PG8_LDB(B1, 1, 1); PG8_STAGE(PG8_SB(1, 0), b3, voffB);
            PG8_BAR; PG8_WAIT_L(0); PG8_MMA(0, 1, At, B1); PG8_BAR;
            PG8_LDA(At, 1, 1); PG8_STAGE(PG8_SA(1, 0), a3, voffA);
            PG8_BAR; PG8_WAIT_L(0); PG8_MMA(1, 0, At, B0); PG8_BAR; PG8_SCHED;
            PG8_STAGE(PG8_SB(1, 1), b3 + hstep, voffB);
            PG8_WAIT_V(6); PG8_BAR; PG8_MMA(1, 1, At, B1); PG8_BAR;
            }
        }
        if constexpr (ALIGN_EPI) { if (wr == 0) PG8_BAR; }
        if constexpr (!Epi::AFTER_DRAIN) { E(acc, cur, wr, wc, fr, fq); S.done(cur); }
        if (!has_next) break;
#pragma unroll
        for (int a = 0; a < 2; ++a)
#pragma unroll
            for (int b = 0; b < 2; ++b)
#pragma unroll
                for (int m = 0; m < 4; ++m)
#pragma unroll
                    for (int n = 0; n < 2; ++n) acc[a][b][m][n] = (f32x4){0.f, 0.f, 0.f, 0.f};
        cur = nxt; cA = nA; cB = nB; ++ui;
        if constexpr (ALIGN_EPI) { if (wr == 1) PG8_BAR; }
    }
    PG8_WAIT_V(0);
    if constexpr (!ALIGN_EPI) { if (wr == 0) PG8_BAR; }
    PG8_BAR;
    if constexpr (Epi::AFTER_DRAIN) { E.fused(acc, cur, wr, wc, fr, fq, lds, wid, lane); S.done(cur); }
#undef PG8_SA
#undef PG8_SB
#undef PG8_STAGE
#undef PG8_LDA
#undef PG8_LDB
#undef PG8_MMA
#undef PG8_WAIT_V
#undef PG8_WAIT_L
#undef PG8_BAR
#undef PG8_SCHED
}
}

#define LAS __attribute__((address_space(3)))
typedef unsigned short bf16;
typedef float f32x4 __attribute__((ext_vector_type(4)));
typedef short bf16x8 __attribute__((ext_vector_type(8)));
typedef unsigned u32x4 __attribute__((ext_vector_type(4)));
typedef unsigned u32x2 __attribute__((ext_vector_type(2)));

constexpr int D = 1024, BATCH = 2, SEQ = 16384, T = BATCH * SEQ, DEPTH = 2;
constexpr int IN_TOTAL = 5648, NP = 5632, NP1 = 3584, NPG = 2048;
constexpr int G_CH = 8;
constexpr int NCHUNK = SEQ / 64;
constexpr int NG = NCHUNK / G_CH;
constexpr int NTHREADS = 512, NWAVES = 8;
constexpr int LDS_BYTES = 147456;
constexpr float EPS = 1e-6f;

constexpr int C_GQ = 0, C_GK = 256, C_GV = 512, C_GZ = 1024, C_HQ = 1536, C_HF = 2048, C_HI = 2560, C_HZ = 3072;

constexpr size_t MiB = 1u << 20;
constexpr size_t WS_MOD = 0;
constexpr size_t WS_BAR = 512 * 1024;
constexpr size_t WS_WIN = 1 * MiB;
constexpr size_t WS_WUP = 23 * MiB;
constexpr size_t WS_WOUT = 27 * MiB;
constexpr size_t WS_STATE = 32 * MiB;
constexpr size_t WS_STATE_HG = WS_STATE + 8 * MiB;
constexpr size_t WS_PDEC = 56 * MiB;
constexpr size_t WS_WLR = 57 * MiB;
constexpr size_t WS_LOGA = 64 * MiB;
constexpr size_t WS_H = 96 * MiB;
constexpr size_t WS_P1 = 160 * MiB;
constexpr size_t WS_PG = 384 * MiB;
constexpr size_t WS_END = 512 * MiB;

struct Params { const float* in[16]; float* out; unsigned char* ws; };

__device__ __forceinline__ float bf2f(unsigned short b) { return __builtin_bit_cast(float, (unsigned)b << 16); }
__device__ __forceinline__ float bflo(unsigned w) { return __builtin_bit_cast(float, w << 16); }
__device__ __forceinline__ float bfhi(unsigned w) { return __builtin_bit_cast(float, w & 0xffff0000u); }
__device__ __forceinline__ unsigned f2bf(float f) { unsigned u = __builtin_bit_cast(unsigned, f); return (u + 0x7fffu + ((u >> 16) & 1u)) >> 16; }
__device__ __forceinline__ unsigned pk2(float lo, float hi) { return f2bf(lo) | (f2bf(hi) << 16); }
__device__ __forceinline__ float sigmoidf_(float x) { return 1.0f / (1.0f + __expf(-x)); }
__device__ __forceinline__ float wave_sum(float v) {
#pragma unroll
    for (int o = 1; o < 64; o <<= 1) v += __shfl_xor(v, o);
    return v;
}
#define LDS_WAIT() asm volatile("s_waitcnt lgkmcnt(0)" ::: "memory")

namespace pg8 {
struct EpiIn {
    static constexpr bool PERM = true, AFTER_DRAIN = false, MID = false;
    bf16_t* P1; bf16_t* PG; const float* bias;
    __device__ __forceinline__ void operator()(const f32x4 (&acc)[2][2][4][2], const Unit& u, int wr, int wc, int fr, int fq) const {
        const int pn = u.pn;
        const int row0 = u.pm * BM + wr * 64 + fr;
        if (pn >= 14) {
            const int ch0 = (pn - 14) * 128 + wc * 32 + 8 * fq;
            f32x4 ba[2], bb[2];
#pragma unroll
            for (int n = 0; n < 2; ++n) { ba[n] = *(const f32x4*)(bias + ch0 + 4 * n); bb[n] = *(const f32x4*)(bias + 1024 + ch0 + 4 * n); }
#pragma unroll
            for (int ai = 0; ai < 2; ++ai)
#pragma unroll
                for (int m = 0; m < 4; ++m) { bf16_t* rowp = PG + (size_t)(row0 + ai * HALF + m * 16) * NPG + ch0;
                    f32x4 r[2], g[2];
#pragma unroll
                    for (int n = 0; n < 2; ++n) { const f32x4 a = acc[ai][0][m][n] + ba[n], b = acc[ai][1][m][n] + bb[n];
#pragma unroll
                        for (int j = 0; j < 4; ++j) { const float ea = __expf(-a[j]), eb = __expf(-b[j]); g[n][j] = __builtin_amdgcn_rcpf(1.0f + eb); r[n][j] = (1.0f + eb) * __builtin_amdgcn_rcpf(1.0f + ea); } }
                    u32x4 w; w.x = cvt_pk_bf16(r[0][0], r[0][1]); w.y = cvt_pk_bf16(r[0][2], r[0][3]); w.z = cvt_pk_bf16(r[1][0], r[1][1]); w.w = cvt_pk_bf16(r[1][2], r[1][3]);
                    *(u32x4*)rowp = w;
                    w.x = cvt_pk_bf16(g[0][0], g[0][1]); w.y = cvt_pk_bf16(g[0][2], g[0][3]); w.z = cvt_pk_bf16(g[1][0], g[1][1]); w.w = cvt_pk_bf16(g[1][2], g[1][3]);
                    *(u32x4*)(rowp + 1024) = w; }
            return;
        }
        int mode = 0; float scl = 1.0f;
        if (pn == 0) scl = 0.125f;
        else if (pn == 4 || pn == 5 || pn == 12 || pn == 13) mode = 1;
        else if (pn == 6 || pn == 7) { mode = 1; scl = 0.08838834764831845f; }
        const int col0 = pn * 256 + wc * 32 + 8 * fq;
#pragma unroll
        for (int ai = 0; ai < 2; ++ai)
#pragma unroll
            for (int m = 0; m < 4; ++m) { bf16_t* rowp = P1 + (size_t)(row0 + ai * HALF + m * 16) * NP1 + col0;
#pragma unroll
                for (int bj = 0; bj < 2; ++bj) { f32x4 v0 = acc[ai][bj][m][0], v1 = acc[ai][bj][m][1];
                    if (mode == 0) { v0 = v0 * scl; v1 = v1 * scl; }
                    else {
#pragma unroll
                        for (int j = 0; j < 4; ++j) { v0[j] = v0[j] * scl * __builtin_amdgcn_rcpf(1.0f + __expf(-v0[j])); v1[j] = v1[j] * scl * __builtin_amdgcn_rcpf(1.0f + __expf(-v1[j])); } }
                    u32x4 w; w.x = cvt_pk_bf16(v0[0], v0[1]); w.y = cvt_pk_bf16(v0[2], v0[3]); w.z = cvt_pk_bf16(v1[0], v1[1]); w.w = cvt_pk_bf16(v1[2], v1[3]);
                    *(u32x4*)(rowp + bj * HALF) = w; } }
    }
};
struct EpiUp {
    static constexpr bool PERM = true, AFTER_DRAIN = false, MID = true;
    const bf16_t* PG; bf16_t* Mo;
    __device__ __forceinline__ void mid(f32x4 (&acc)[2][2][4][2], const Unit& u, int wr, int wc, int fr_, int fq) const {
        int fr = fr_; asm volatile("" : "+v"(fr));
        const int row0 = u.pm * BM + wr * 64 + fr, col0 = u.pn * BM + wc * 32 + 8 * fq;
#pragma unroll
        for (int ai = 0; ai < 2; ++ai) {
            u32x4 rv[4][2];
#pragma unroll
            for (int m = 0; m < 4; ++m) { const bf16_t* gp = PG + (size_t)(row0 + ai * HALF + m * 16) * NPG + col0;
#pragma unroll
                for (int bj = 0; bj < 2; ++bj) rv[m][bj] = *(const u32x4*)(gp + bj * HALF); }
#pragma unroll
            for (int m = 0; m < 4; ++m)
#pragma unroll
                for (int bj = 0; bj < 2; ++bj) { const u32x4 ga = rv[m][bj];
                    acc[ai][bj][m][0] = acc[ai][bj][m][0] * (f32x4){bflo(ga.x), bfhi(ga.x), bflo(ga.y), bfhi(ga.y)};
                    acc[ai][bj][m][1] = acc[ai][bj][m][1] * (f32x4){bflo(ga.z), bfhi(ga.z), bflo(ga.w), bfhi(ga.w)}; }
            __builtin_amdgcn_sched_barrier(0);
        }
    }
    __device__ __forceinline__ void operator()(const f32x4 (&acc)[2][2][4][2], const Unit& u, int wr, int wc, int fr, int fq) const {
        const int row0 = u.pm * BM + wr * 64 + fr, col0 = u.pn * BM + wc * 32 + 8 * fq;
#pragma unroll
        for (int ai = 0; ai < 2; ++ai)
#pragma unroll
            for (int m = 0; m < 4; ++m) { const size_t row = (size_t)(row0 + ai * HALF + m * 16); const bf16_t* gp = PG + row * NPG + 1024 + col0; bf16_t* op = Mo + row * D + col0;
#pragma unroll
                for (int bj = 0; bj < 2; ++bj) { const u32x4 gb = *(const u32x4*)(gp + bj * HALF);
                    const f32x4 a0 = acc[ai][bj][m][0], a1 = acc[ai][bj][m][1];
                    u32x4 w; w.x = cvt_pk_bf16(a0[0] * bflo(gb.x), a0[1] * bfhi(gb.x)); w.y = cvt_pk_bf16(a0[2] * bflo(gb.y), a0[3] * bfhi(gb.y));
                    w.z = cvt_pk_bf16(a1[0] * bflo(gb.z), a1[1] * bfhi(gb.z)); w.w = cvt_pk_bf16(a1[2] * bflo(gb.w), a1[3] * bfhi(gb.w));
                    *(u32x4*)(op + bj * HALF) = w; } }
    }
};
template <bool XBF> struct EpiOut {
    static constexpr bool PERM = true, AFTER_DRAIN = false, MID = false;
    const void* xin; bf16_t* out; const float* gate2;
    __device__ __forceinline__ void operator()(const f32x4 (&acc)[2][2][4][2], const Unit& u, int wr, int wc, int fr, int fq) const {
        const int row0 = u.pm * BM + wr * 64 + fr, col0 = u.pn * BM + wc * 32 + 8 * fq;
        const float* gate = gate2 + ((u.pm * BM) / SEQ) * 3072;
        f32x4 gv[2][2];
#pragma unroll
        for (int bj = 0; bj < 2; ++bj)
#pragma unroll
            for (int n = 0; n < 2; ++n) gv[bj][n] = *(const f32x4*)(gate + col0 + bj * HALF + 4 * n);
#pragma unroll
        for (int ai = 0; ai < 2; ++ai)
#pragma unroll
            for (int m = 0; m < 4; ++m) { const size_t off = (size_t)(row0 + ai * HALF + m * 16) * D + col0;
#pragma unroll
                for (int bj = 0; bj < 2; ++bj) { f32x4 x0, x1;
                    if (XBF) { const u32x4 xb = *(const u32x4*)((const bf16_t*)xin + off + bj * HALF);
                        x0 = (f32x4){__builtin_bit_cast(float, xb.x << 16), __builtin_bit_cast(float, xb.x & 0xffff0000u), __builtin_bit_cast(float, xb.y << 16), __builtin_bit_cast(float, xb.y & 0xffff0000u)};
                        x1 = (f32x4){__builtin_bit_cast(float, xb.z << 16), __builtin_bit_cast(float, xb.z & 0xffff0000u), __builtin_bit_cast(float, xb.w << 16), __builtin_bit_cast(float, xb.w & 0xffff0000u)}; }
                    else { x0 = *(const f32x4*)((const float*)xin + off + bj * HALF); x1 = *(const f32x4*)((const float*)xin + off + bj * HALF + 4); }
                    const f32x4 y0 = x0 + gv[bj][0] * acc[ai][bj][m][0], y1 = x1 + gv[bj][1] * acc[ai][bj][m][1];
                    u32x4 w; w.x = cvt_pk_bf16(y0[0], y0[1]); w.y = cvt_pk_bf16(y0[2], y0[3]); w.z = cvt_pk_bf16(y1[0], y1[1]); w.w = cvt_pk_bf16(y1[2], y1[3]);
                    *(u32x4*)(out + off + bj * HALF) = w; } }
    }
};
}

__device__ __forceinline__ void transpose_item(const float* W, int ldw, int src_col0, int k0, bf16* WT, int dst_row0, int dst_k0, LAS float* scr, int lane) {
#pragma unroll
    for (int i = 0; i < 32; ++i) { const int kk = 2 * i + (lane >> 5); scr[kk * 33 + (lane & 31)] = W[(size_t)(k0 + kk) * ldw + src_col0 + (lane & 31)]; }
    LDS_WAIT();
    const int c = lane & 7;
#pragma unroll
    for (int j = 0; j < 4; ++j) { const int n = (lane >> 3) + 8 * j; const LAS float* s = scr + (8 * c) * 33 + n;
        u32x4 o; o.x = pk2(s[0 * 33], s[1 * 33]); o.y = pk2(s[2 * 33], s[3 * 33]); o.z = pk2(s[4 * 33], s[5 * 33]); o.w = pk2(s[6 * 33], s[7 * 33]);
        *(u32x4*)(WT + (size_t)(dst_row0 + n) * D + dst_k0 + 8 * c) = o; }
    LDS_WAIT();
}

__device__ __forceinline__ void phase_prologue(const Params& p, LAS unsigned char* lds) {
    int tid_ = threadIdx.x; asm volatile("" : "+v"(tid_));
    const int tid = tid_, lane = tid & 63, wave = tid >> 6;
    unsigned char* ws = p.ws;
    for (int task = blockIdx.x; task < DEPTH * 96; task += gridDim.x) {
        const int l = task / 96, cgp = task % 96, col = tid & 31, ks = tid >> 5;
        const float* W = p.in[3] + (size_t)l * D * 3072 + cgp * 32 + col;
        const float* c0 = p.in[1], *c1 = p.in[1] + D;
        float s0 = 0.f, s1 = 0.f;
#pragma unroll 16
        for (int k = ks * 64; k < ks * 64 + 64; ++k) { const float w = W[(size_t)k * 3072]; const float a = c0[k], b = c1[k];
            s0 += a * sigmoidf_(a) * w; s1 += b * sigmoidf_(b) * w; }
        LAS float* red = (LAS float*)(lds + 98304);
        red[(ks * 32 + col) * 2 + 0] = s0; red[(ks * 32 + col) * 2 + 1] = s1;
        __syncthreads();
        if (tid < 64) { const int cc = tid & 31, bb = tid >> 5; float s = 0.f;
#pragma unroll
            for (int k = 0; k < 16; ++k) s += red[(k * 32 + cc) * 2 + bb];
            const int cglob = cgp * 32 + cc;
            ((float*)(ws + WS_MOD))[(l * BATCH + bb) * 3072 + cglob] = s + p.in[4][l * 3072 + cglob]; }
        __syncthreads();
    }
    LAS float* scr = (LAS float*)(lds + wave * 8704);
    const int gw = blockIdx.x * NWAVES + wave, NGW = gridDim.x * NWAVES;
    constexpr int I_IN = 16 * 176, I_UP = 8 * 32, I_OUT = 16 * 32, I_LR = 16, I_L = I_IN + 2 * I_UP + I_OUT + I_LR;
    for (int it = gw; it < DEPTH * I_L; it += NGW) {
        const int l = it / I_L; int r = it % I_L;
        if (r < I_IN) { const int kb = r / 176, nb = r % 176, n0 = 32 * nb;
            transpose_item(p.in[5] + (size_t)l * D * IN_TOTAL, IN_TOTAL, n0 < 1536 ? n0 : (n0 < 3584 ? n0 + 16 : 3600 + (((n0 - 3584) >> 7) & 1) * 1024 + ((n0 - 3584) >> 8) * 128 + (n0 & 127)), 64 * kb, (bf16*)(ws + WS_WIN) + (size_t)l * NP * D, n0, 64 * kb, scr, lane); continue; }
        r -= I_IN;
        if (r < I_UP) { const int kb = r / 32, nb = r % 32;
            transpose_item(p.in[12] + (size_t)l * 512 * D, D, 32 * nb, 64 * kb, (bf16*)(ws + WS_WUP) + (size_t)l * D * D, 32 * nb, 64 * kb, scr, lane); continue; }
        r -= I_UP;
        if (r < I_UP) { const int kb = r / 32, nb = r % 32;
            transpose_item(p.in[13] + (size_t)l * 512 * D, D, 32 * nb, 64 * kb, (bf16*)(ws + WS_WUP) + (size_t)l * D * D, 32 * nb, 512 + 64 * kb, scr, lane); continue; }
        r -= I_UP;
        if (r >= I_OUT) { const int kb = r - I_OUT;
            transpose_item(p.in[5] + (size_t)l * D * IN_TOTAL, IN_TOTAL, 1536, 64 * kb, (bf16*)(ws + WS_WLR) + (size_t)l * 32 * D, 0, 64 * kb, scr, lane); continue; }
        { const int kb = r / 32, nb = r % 32;
            transpose_item(p.in[14] + (size_t)l * D * D, D, 32 * nb, 64 * kb, (bf16*)(ws + WS_WOUT) + (size_t)l * D * D, 32 * nb, 64 * kb, scr, lane); }
    }
}

template <bool XBF> struct XRaw;
template <> struct XRaw<false> { typedef f32x4 T; static __device__ __forceinline__ f32x4 cvt(const f32x4& v) { return v; } };
template <> struct XRaw<true> { typedef u32x2 T; static __device__ __forceinline__ f32x4 cvt(const u32x2& v) { return (f32x4){bflo(v.x), bfhi(v.x), bflo(v.y), bfhi(v.y)}; } };
template <bool XBF>
__device__ __forceinline__ void phase_norm(const Params& p, LAS unsigned char* lds, int l, const void* xin_) {
    int tid_ = threadIdx.x; asm volatile("" : "+v"(tid_));
    const int tid = tid_, lane = tid & 63, wave = tid >> 6, m = lane & 15, q = lane >> 4;
    unsigned char* ws = p.ws;
    constexpr int TRS = 2064;
    LAS unsigned char* tile = lds + wave * (8 * TRS);
    LAS float* wscr = (LAS float*)(lds + 8 * 8 * TRS) + wave * 128;
    f32x4 wa2r[16];
#pragma unroll
    for (int n = 0; n < 16; ++n) wa2r[n] = *(const f32x4*)(p.in[6] + l * 4096 + n * 256 + lane * 4);
    f32x4 nw[4];
#pragma unroll
    for (int j = 0; j < 4; ++j) nw[j] = *(const f32x4*)(p.in[2] + l * D + lane * 4 + 256 * j);
    const f32x4 ba4 = *(const f32x4*)(p.in[7] + l * 256 + lane * 4);
    const float* mod = (const float*)(ws + WS_MOD) + (size_t)l * BATCH * 3072;
    bf16* H = (bf16*)(ws + WS_H); float* LA = (float*)(ws + WS_LOGA);
    const bf16* wlr = (const bf16*)(ws + WS_WLR) + (size_t)l * 32 * D + m * D + q * 8;
    const LAS unsigned char* arow = tile + (m & 7) * TRS + q * 16;
    const int gw = blockIdx.x * NWAVES + wave, NGW = gridDim.x * NWAVES;
    int bcur = -1;
    typedef typename XRaw<XBF>::T xraw_t;
    f32x4 hm[4], ha[4]; xraw_t xn[2][4];
    if (gw * 8 < T) {
#pragma unroll
        for (int rr = 0; rr < 2; ++rr)
#pragma unroll
            for (int j = 0; j < 4; ++j) xn[rr][j] = ((const xraw_t*)xin_ + (size_t)(gw * 8 + rr) * (D / 4) + lane)[64 * j]; }
#pragma unroll 1
    for (int t = gw; t < T / 8; t += NGW) {
        const int r0 = t * 8, b = r0 / SEQ;
        if (b != bcur) { bcur = b;
#pragma unroll
            for (int j = 0; j < 4; ++j) { ha[j] = *(const f32x4*)(mod + b * 3072 + lane * 4 + 256 * j); const f32x4 sc = *(const f32x4*)(mod + b * 3072 + 1024 + lane * 4 + 256 * j); hm[j] = nw[j] * (1.0f + sc); } }
#pragma unroll 1
        for (int rp = 0; rp < 4; ++rp) {
            f32x4 hv[2][4];
#pragma unroll
            for (int rr = 0; rr < 2; ++rr)
#pragma unroll
                for (int j = 0; j < 4; ++j) hv[rr][j] = XRaw<XBF>::cvt(xn[rr][j]);
            {
                int rn = r0 + 2 * rp + 2;
                if (rp == 3) rn = (t + NGW < T / 8) ? (t + NGW) * 8 : r0;
#pragma unroll
                for (int rr = 0; rr < 2; ++rr)
#pragma unroll
                    for (int j = 0; j < 4; ++j) xn[rr][j] = ((const xraw_t*)xin_ + (size_t)(rn + rr) * (D / 4) + lane)[64 * j];
            }
#pragma unroll
            for (int rr = 0; rr < 2; ++rr) {
                float s = 0.f;
#pragma unroll
                for (int j = 0; j < 4; ++j) s += (hv[rr][j].x * hv[rr][j].x + hv[rr][j].y * hv[rr][j].y) + (hv[rr][j].z * hv[rr][j].z + hv[rr][j].w * hv[rr][j].w);
                const float rstd = __builtin_amdgcn_rsqf(wave_sum(s) * (1.0f / D) + EPS);
                const int row = 2 * rp + rr;
                u32x2* o8 = (u32x2*)(H + (size_t)(r0 + row) * D) + lane;
                LAS u32x2* t8 = (LAS u32x2*)(tile + row * TRS) + lane;
#pragma unroll
                for (int j = 0; j < 4; ++j) { const f32x4 hh = hv[rr][j] * rstd * hm[j] + ha[j];
                    const u32x2 pk = (u32x2){pg8::cvt_pk_bf16(hh.x, hh.y), pg8::cvt_pk_bf16(hh.z, hh.w)};
                    o8[64 * j] = pk; t8[64 * j] = pk; }
            }
        }
        LDS_WAIT();
        f32x4 acc = (f32x4){0.f, 0.f, 0.f, 0.f};
#pragma unroll 8
        for (int ks = 0; ks < 32; ++ks) {
            const bf16x8 af = *(const LAS bf16x8*)(arow + ks * 64);
            const bf16x8 bfr = *(const bf16x8*)(wlr + ks * 32);
            acc = __builtin_amdgcn_mfma_f32_16x16x32_bf16(af, bfr, acc, 0, 0, 0);
        }
        if (q < 2) {
#pragma unroll
            for (int j = 0; j < 4; ++j) wscr[(q * 4 + j) * 16 + m] = acc[j]; }
        LDS_WAIT();
#pragma unroll 2
        for (int row = 0; row < 8; ++row) {
            f32x4 z = ba4;
#pragma unroll
            for (int n4 = 0; n4 < 4; ++n4) { const f32x4 g = *(const LAS f32x4*)(wscr + row * 16 + n4 * 4);
                z += wa2r[n4 * 4 + 0] * g.x; z += wa2r[n4 * 4 + 1] * g.y; z += wa2r[n4 * 4 + 2] * g.z; z += wa2r[n4 * 4 + 3] * g.w; }
            f32x4 lo;
#pragma unroll
            for (int i = 0; i < 4; ++i) lo[i] = -(fmaxf(-z[i], 0.f) + __logf(1.0f + __expf(-fabsf(z[i])))) * 0.0625f;
            *(f32x4*)(LA + (size_t)(r0 + row) * 256 + lane * 4) = lo;
        }
        LDS_WAIT();
    }
}

constexpr int MX_KD = 0, MX_QS = 16384, MX_OCT = 33792, MX_ADEC = 37888, MX_OT = 38400, MX_RA = 72192, MX_RV = 89600;
constexpr int MX_RSV = 272;

#define TR_READ(dst, addr, OFF) asm volatile("ds_read_b64_tr_b16 %0, %1 offset:%2" : "=&v"(dst) : "v"(addr), "n"(OFF) : "memory")

template <bool HG, bool FIN>
__device__ __forceinline__ void mixer_unit(const Params& p, LAS unsigned char* lds, int l, int b, int h, int jg) {
    constexpr int DK = HG ? 128 : 64, KT = DK / 16, QSTR = DK + 8, RSA = DK * 2 + 16;
    constexpr int KCOL = HG ? C_HF : C_GK, VCOL = HG ? C_HI : C_GV, QCOL = HG ? C_HQ : C_GQ, ZCOL = HG ? C_HZ : C_GZ;
    constexpr int NOCT = HG ? 2 : 1;
    constexpr int PPR = DK / 8, NQ = (64 * PPR) / NTHREADS;
    int tid_ = threadIdx.x; asm volatile("" : "+v"(tid_));
    const int tid = tid_, lane = tid & 63, w = tid >> 6, n = lane & 15, q = lane >> 4, qq = n >> 2, pp = lane & 3;
    unsigned char* ws = p.ws;
    const bf16* P1 = (const bf16*)(ws + WS_P1);
    const float* LA = (const float*)(ws + WS_LOGA);
    bf16* OB = (bf16*)(ws + WS_H);
    float* SB = (float*)(ws + (HG ? WS_STATE_HG : WS_STATE)) + (size_t)((b * 4 + h) * NG + jg) * (DK * 128);
    float* PD = (float*)(ws + WS_PDEC) + (size_t)(((HG ? 0 : 8) + b * 4 + h) * NG + jg) * 128;
    LAS unsigned char* KD = lds + MX_KD;
    LAS bf16* QS = (LAS bf16*)(lds + MX_QS);
    LAS float* OCT = (LAS float*)(lds + MX_OCT);
    LAS float* ADEC = (LAS float*)(lds + MX_ADEC);
    LAS float* OT = (LAS float*)(lds + MX_OT);
    LAS unsigned char* RA = lds + MX_RA;
    LAS unsigned char* RV = lds + MX_RV;

    const int c = HG ? (tid & 127) : (tid & 63);
    const int o_first = HG ? (tid >> 7) : (tid >> 6);
    const unsigned tra = (unsigned)(size_t)RA + (unsigned)((o_first * 8 + qq) * RSA + ((c & ~15) + 4 * pp) * 2);
    const unsigned trv = (unsigned)(size_t)RV + (unsigned)((8 * q + qq) * MX_RSV + (16 * w + 4 * pp) * 2);
    float lb = 0.f, lbf = 1e-30f, oml = 1.0f;
    if (HG) { if (l > 0) { const float g0 = p.in[9][h * 128 + c], g1 = p.in[9][512 + h * 128 + c]; lb = 1.0f / (1.0f + __expf(g0 - g1)); lb = fminf(fmaxf(lb, 0.f), 1.0f - 1e-6f); }
        lbf = fmaxf(lb, 1e-30f); oml = 1.0f - lb; }
    float nwv[16];
    if (FIN) { const float* nwp = (HG ? p.in[10] : p.in[8]) + l * 128 + (tid & 7) * 16;
#pragma unroll
        for (int i = 0; i < 16; ++i) nwv[i] = nwp[i]; }

    f32x4 S[KT];
    if (FIN) {
#pragma unroll
        for (int kt = 0; kt < KT; ++kt) S[kt] = *(const f32x4*)(SB + (size_t)((w * KT + kt) * 64 + lane) * 4);
    } else {
#pragma unroll
        for (int kt = 0; kt < KT; ++kt) S[kt] = (f32x4){0.f, 0.f, 0.f, 0.f};
    }
    float pprod = 1.0f;

    const int rowg = b * SEQ + jg * G_CH * 64;
    u32x4 araw[NQ], vraw[2], qraw[NQ], zraw[2]; float laraw[8];
    const bf16* aptr = P1 + (size_t)rowg * NP1 + KCOL + h * DK;
    const float* laptr = LA + (size_t)rowg * 256 + h * 64 + c;
    const bf16* vptr = P1 + (size_t)rowg * NP1 + VCOL + h * 128;
    const bf16* qptr = P1 + (size_t)rowg * NP1 + QCOL + h * DK;
    const bf16* zptr = P1 + (size_t)(rowg + (tid >> 3)) * NP1 + ZCOL + h * 128 + (tid & 7) * 16;
#define MX_LOAD_A(cc_) do { const size_t ro_ = (size_t)(cc_) * 64; \
        _Pragma("unroll") for (int pq = 0; pq < NQ; ++pq) { const int pc = tid + pq * NTHREADS; araw[pq] = *(const u32x4*)(aptr + (ro_ + pc / PPR) * NP1 + (pc % PPR) * 8); } \
        if (!HG) { _Pragma("unroll") for (int i = 0; i < 8; ++i) laraw[i] = laptr[(ro_ + o_first * 8 + i) * 256]; } } while (0)
#define MX_LOAD_V(cc_) do { const size_t ro_ = (size_t)(cc_) * 64; \
        _Pragma("unroll") for (int pq = 0; pq < 2; ++pq) { const int pc = tid + pq * NTHREADS; vraw[pq] = *(const u32x4*)(vptr + (ro_ + pc / 16) * NP1 + (pc % 16) * 8); } } while (0)
#define MX_LOAD_Q(cc_) do { const size_t ro_ = (size_t)(cc_) * 64; \
        _Pragma("unroll") for (int pq = 0; pq < NQ; ++pq) { const int pc = tid + pq * NTHREADS; qraw[pq] = *(const u32x4*)(qptr + (ro_ + pc / PPR) * NP1 + (pc % PPR) * 8); } } while (0)
#define MX_LOAD_Z(cc_) do { const size_t ro_ = (size_t)(cc_) * 64; zraw[0] = *(const u32x4*)(zptr + ro_ * NP1); zraw[1] = *(const u32x4*)(zptr + ro_ * NP1 + 8); } while (0)
    MX_LOAD_A(0); MX_LOAD_V(0);
    if (FIN) { MX_LOAD_Q(0); MX_LOAD_Z(0); }

#pragma unroll 1
    for (int cc = 0; cc < G_CH; ++cc) {
        const int ccn = (cc + 1 < G_CH) ? cc + 1 : cc;
        const int row0 = rowg + cc * 64;
#pragma unroll
        for (int pq = 0; pq < NQ; ++pq) { const int pc = tid + pq * NTHREADS; *(LAS u32x4*)(RA + (pc / PPR) * RSA + (pc % PPR) * 16) = araw[pq]; }
#pragma unroll
        for (int pq = 0; pq < 2; ++pq) { const int pc = tid + pq * NTHREADS; *(LAS u32x4*)(RV + (pc / 16) * MX_RSV + (pc % 16) * 16) = vraw[pq]; }
        if (FIN) {
#pragma unroll
            for (int pq = 0; pq < NQ; ++pq) { const int pc = tid + pq * NTHREADS; *(LAS u32x4*)(QS + (pc / PPR) * QSTR + (pc % PPR) * 8) = qraw[pq]; } }
        float lacur[8];
        if (!HG) {
#pragma unroll
            for (int i = 0; i < 8; ++i) lacur[i] = laraw[i]; }
        MX_LOAD_A(ccn); MX_LOAD_V(ccn);
        if (FIN) MX_LOAD_Q(ccn);
        LDS_WAIT(); __syncthreads();
        u32x2 art[NOCT][2], vrt[2][2];
        TR_READ(art[0][0], tra, 0); TR_READ(art[0][1], tra, 4 * RSA);
        if (HG) { TR_READ(art[NOCT - 1][0], tra, 32 * RSA); TR_READ(art[NOCT - 1][1], tra, 36 * RSA); }
        TR_READ(vrt[0][0], trv, 0); TR_READ(vrt[0][1], trv, 4 * MX_RSV); TR_READ(vrt[1][0], trv, 32 * MX_RSV); TR_READ(vrt[1][1], trv, 36 * MX_RSV);
        if (HG) asm volatile("s_waitcnt lgkmcnt(0)" : "+v"(art[0][0]), "+v"(art[0][1]), "+v"(art[NOCT - 1][0]), "+v"(art[NOCT - 1][1]), "+v"(vrt[0][0]), "+v"(vrt[0][1]), "+v"(vrt[1][0]), "+v"(vrt[1][1]) :: "memory");
        else asm volatile("s_waitcnt lgkmcnt(0)" : "+v"(art[0][0]), "+v"(art[0][1]), "+v"(vrt[0][0]), "+v"(vrt[0][1]), "+v"(vrt[1][0]), "+v"(vrt[1][1]) :: "memory");
        float fg[NOCT][8], kv[NOCT][8];
#pragma unroll
        for (int oi = 0; oi < NOCT; ++oi) { const int o = o_first + 4 * oi;
#pragma unroll
            for (int i = 0; i < 8; ++i) { const unsigned wv = (i & 2) ? art[oi][i >> 2].y : art[oi][i >> 2].x; const float x = (i & 1) ? bfhi(wv) : bflo(wv);
                if (HG) { const float zf = fminf(fmaxf(x, -80.f), 80.f);
                    const float e = __expf(-zf), s = __builtin_amdgcn_rcpf(1.0f + e);
                    fg[oi][i] = lbf + oml * s; kv[oi][i] = oml * e * s; }
                else { fg[oi][i] = __expf(lacur[i]); kv[oi][i] = x; } }
            float pr = 1.0f;
#pragma unroll
            for (int i = 0; i < 8; ++i) pr *= fg[oi][i];
            OCT[o * 128 + c] = pr; }
        LDS_WAIT(); __syncthreads();
#pragma unroll
        for (int oi = 0; oi < NOCT; ++oi) { const int o = o_first + 4 * oi;
            float suf = 1.0f;
#pragma unroll
            for (int o2 = 1; o2 < 8; ++o2) { const float t = OCT[o2 * 128 + c]; suf *= (o2 > o) ? t : 1.0f; }
            float kd[8];
#pragma unroll
            for (int i = 7; i >= 0; --i) { kd[i] = kv[oi][i] * suf; suf *= fg[oi][i]; }
            u32x4 pk; pk.x = pg8::cvt_pk_bf16(kd[0], kd[1]); pk.y = pg8::cvt_pk_bf16(kd[2], kd[3]); pk.z = pg8::cvt_pk_bf16(kd[4], kd[5]); pk.w = pg8::cvt_pk_bf16(kd[6], kd[7]);
            *(LAS u32x4*)(KD + (size_t)((((c >> 4) * 2 + (o >> 2)) * 64 + (o & 3) * 16 + (c & 15)) * 16)) = pk;
            if (o == 0) { ADEC[c] = suf; pprod *= suf; } }
        LDS_WAIT(); __syncthreads();
        union { u32x4 u; bf16x8 v; } vf[2];
        vf[0].u = (u32x4){vrt[0][0].x, vrt[0][0].y, vrt[0][1].x, vrt[0][1].y}; vf[1].u = (u32x4){vrt[1][0].x, vrt[1][0].y, vrt[1][1].x, vrt[1][1].y};
#pragma unroll
        for (int kt = 0; kt < KT; ++kt) { const f32x4 a4 = *(const LAS f32x4*)(ADEC + kt * 16 + q * 4); S[kt] = S[kt] * a4;
#pragma unroll
            for (int ks = 0; ks < 2; ++ks) { const bf16x8 af = *(const LAS bf16x8*)(KD + (size_t)(((kt * 2 + ks) * 64 + lane) * 16));
                S[kt] = __builtin_amdgcn_mfma_f32_16x16x32_bf16(af, vf[ks].v, S[kt], 0, 0, 0); } }
        if (FIN) {
            f32x4 oacc[4];
#pragma unroll
            for (int lt = 0; lt < 4; ++lt) oacc[lt] = (f32x4){0.f, 0.f, 0.f, 0.f};
#pragma unroll
            for (int kk = 0; kk < KT / 2; ++kk) {
                union { u32x4 u; bf16x8 v; } bs;
                bs.u.x = pg8::cvt_pk_bf16(S[2 * kk][0], S[2 * kk][1]); bs.u.y = pg8::cvt_pk_bf16(S[2 * kk][2], S[2 * kk][3]); bs.u.z = pg8::cvt_pk_bf16(S[2 * kk + 1][0], S[2 * kk + 1][1]); bs.u.w = pg8::cvt_pk_bf16(S[2 * kk + 1][2], S[2 * kk + 1][3]);
#pragma unroll
                for (int lt = 0; lt < 4; ++lt) {
                    union { u32x4 u; bf16x8 v; } aq;
                    const u32x2 q0 = *(const LAS u32x2*)(QS + (lt * 16 + n) * QSTR + (2 * kk) * 16 + q * 4), q1 = *(const LAS u32x2*)(QS + (lt * 16 + n) * QSTR + (2 * kk + 1) * 16 + q * 4);
                    aq.u = (u32x4){q0.x, q0.y, q1.x, q1.y};
                    oacc[lt] = __builtin_amdgcn_mfma_f32_16x16x32_bf16(aq.v, bs.v, oacc[lt], 0, 0, 0); } }
#pragma unroll
            for (int lt = 0; lt < 4; ++lt)
#pragma unroll
                for (int j = 0; j < 4; ++j) OT[(lt * 16 + q * 4 + j) * 132 + w * 16 + n] = oacc[lt][j];
            LDS_WAIT(); __syncthreads();
            { const int fl = tid >> 3, seg = tid & 7;
                f32x4 ov[4]; float ssq = 0.f;
#pragma unroll
                for (int i = 0; i < 4; ++i) { ov[i] = *(const LAS f32x4*)(OT + fl * 132 + seg * 16 + i * 4); ssq += (ov[i].x * ov[i].x + ov[i].y * ov[i].y) + (ov[i].z * ov[i].z + ov[i].w * ov[i].w); }
                ssq += __shfl_xor(ssq, 1); ssq += __shfl_xor(ssq, 2); ssq += __shfl_xor(ssq, 4);
                const float rstd = __builtin_amdgcn_rsqf(ssq * (1.0f / 128.0f) + EPS);
                const u32x4 zg0 = zraw[0], zg1 = zraw[1];
                MX_LOAD_Z(ccn);
                u32x4 w0, w1;
                w0.x = pg8::cvt_pk_bf16(ov[0].x * rstd * nwv[0] * bflo(zg0.x), ov[0].y * rstd * nwv[1] * bfhi(zg0.x)); w0.y = pg8::cvt_pk_bf16(ov[0].z * rstd * nwv[2] * bflo(zg0.y), ov[0].w * rstd * nwv[3] * bfhi(zg0.y));
                w0.z = pg8::cvt_pk_bf16(ov[1].x * rstd * nwv[4] * bflo(zg0.z), ov[1].y * rstd * nwv[5] * bfhi(zg0.z)); w0.w = pg8::cvt_pk_bf16(ov[1].z * rstd * nwv[6] * bflo(zg0.w), ov[1].w * rstd * nwv[7] * bfhi(zg0.w));
                w1.x = pg8::cvt_pk_bf16(ov[2].x * rstd * nwv[8] * bflo(zg1.x), ov[2].y * rstd * nwv[9] * bfhi(zg1.x)); w1.y = pg8::cvt_pk_bf16(ov[2].z * rstd * nwv[10] * bflo(zg1.y), ov[2].w * rstd * nwv[11] * bfhi(zg1.y));
                w1.z = pg8::cvt_pk_bf16(ov[3].x * rstd * nwv[12] * bflo(zg1.z), ov[3].y * rstd * nwv[13] * bfhi(zg1.z)); w1.w = pg8::cvt_pk_bf16(ov[3].z * rstd * nwv[14] * bflo(zg1.w), ov[3].w * rstd * nwv[15] * bfhi(zg1.w));
                bf16* op = OB + (size_t)(row0 + fl) * D + (HG ? 512 : 0) + h * 128 + seg * 16;
                *(u32x4*)op = w0; *(u32x4*)(op + 8) = w1; }
        }
    }
#undef MX_LOAD_A
#undef MX_LOAD_V
#undef MX_LOAD_Q
#undef MX_LOAD_Z
    if (!FIN) {
#pragma unroll
        for (int kt = 0; kt < KT; ++kt) *(f32x4*)(SB + (size_t)((w * KT + kt) * 64 + lane) * 4) = S[kt];
        if (o_first == 0) PD[c] = pprod;
    }
    __syncthreads();
}

template <bool FIN>
__device__ __forceinline__ void phase_mixer(const Params& p, LAS unsigned char* lds, int l) {
    for (int u = blockIdx.x; u < 512; u += gridDim.x) {
        const int rem = u & 255, b = rem >> 7, h = (rem >> 5) & 3, jg = rem & 31;
        if (!FIN && jg == NG - 1) continue;
        if (u < 256) mixer_unit<true, FIN>(p, lds, l, b, h, jg); else mixer_unit<false, FIN>(p, lds, l, b, h, jg);
    }
}

__device__ __forceinline__ void phase_scan(const Params& p) {
    unsigned char* ws = p.ws;
    int tid_ = threadIdx.x; asm volatile("" : "+v"(tid_));
    const int gt = blockIdx.x * NTHREADS + tid_, NT = gridDim.x * NTHREADS;
    for (int tt = gt; tt < 8 * 4096 + 8 * 2048; tt += NT) {
        const bool hg = tt < 32768; const int t2 = hg ? tt : tt - 32768, per = hg ? 4096 : 2048, bh = t2 / per, e = t2 % per, KT = hg ? 8 : 4;
        const int kt = (e >> 6) % KT, lane = e & 63, c4 = kt * 16 + (lane >> 4) * 4;
        float* base = (float*)(ws + (hg ? WS_STATE_HG : WS_STATE)) + (size_t)bh * NG * (per * 4) + (size_t)e * 4;
        const float* pd = (const float*)(ws + WS_PDEC) + (size_t)(((hg ? 0 : 8) + bh) * NG) * 128 + c4;
        f32x4 S = (f32x4){0.f, 0.f, 0.f, 0.f};
        for (int j0 = 0; j0 < NG; j0 += 8) {
            f32x4 Lv[8], Pv[8];
#pragma unroll
            for (int j = 0; j < 8; ++j) { if (j0 + j < NG - 1) { Lv[j] = *(const f32x4*)(base + (size_t)(j0 + j) * (per * 4)); Pv[j] = *(const f32x4*)(pd + (size_t)(j0 + j) * 128); } else { Lv[j] = (f32x4){0.f, 0.f, 0.f, 0.f}; Pv[j] = Lv[j]; } }
#pragma unroll
            for (int j = 0; j < 8; ++j) { *(f32x4*)(base + (size_t)(j0 + j) * (per * 4)) = S; S = Pv[j] * S + Lv[j]; }
        }
    }
}

__device__ __forceinline__ void phase_final_norm(const Params& p) {
    int tid_ = threadIdx.x; asm volatile("" : "+v"(tid_));
    const int tid = tid_, lane = tid & 63, wave = tid >> 6;
    const u32x2* xb = (const u32x2*)(p.ws + WS_H);
    f32x4 nw[4];
#pragma unroll
    for (int j = 0; j < 4; ++j) nw[j] = *(const f32x4*)(p.in[15] + lane * 4 + 256 * j);
    const int gw = blockIdx.x * NWAVES + wave, NGW = gridDim.x * NWAVES;
    u32x2 vn[4];
    if (gw < T) {
#pragma unroll
        for (int j = 0; j < 4; ++j) vn[j] = (xb + (size_t)gw * (D / 4) + lane)[64 * j]; }
#pragma unroll 1
    for (int r = gw; r < T; r += NGW) {
        f32x4* xr = (f32x4*)(p.out + (size_t)r * D) + lane;
        f32x4 v[4]; float s = 0.f;
#pragma unroll
        for (int j = 0; j < 4; ++j) v[j] = (f32x4){bflo(vn[j].x), bfhi(vn[j].x), bflo(vn[j].y), bfhi(vn[j].y)};
        { const int rn = (r + NGW < T) ? r + NGW : r;
#pragma unroll
          for (int j = 0; j < 4; ++j) vn[j] = (xb + (size_t)rn * (D / 4) + lane)[64 * j]; }
#pragma unroll
        for (int j = 0; j < 4; ++j) s += (v[j].x * v[j].x + v[j].y * v[j].y) + (v[j].z * v[j].z + v[j].w * v[j].w);
        const float rstd = __builtin_amdgcn_rsqf(wave_sum(s) * (1.0f / D) + EPS);
#pragma unroll
        for (int j = 0; j < 4; ++j) xr[64 * j] = v[j] * rstd * nw[j];
    }
}

#define XB_TMO      128
#define XB_XCNT(j)  (256  + 64 * (j))
#define XB_XSUB(j)  (1280 + 64 * (j))
#define XB_XGEN(j)  (2304 + 64 * (j))
#define XB_TOP      3328
#define XB_TOPGEN   3392
#define XCD_BAR_WORDS 3456
#define XB_SPIN_CAP (1u << 18)

__device__ __forceinline__ unsigned xb_ld(unsigned* p)              { return __hip_atomic_load(p, __ATOMIC_RELAXED, __HIP_MEMORY_SCOPE_AGENT); }
__device__ __forceinline__ unsigned xb_add(unsigned* p, unsigned v) { return __hip_atomic_fetch_add(p, v, __ATOMIC_RELAXED, __HIP_MEMORY_SCOPE_AGENT); }
__device__ __forceinline__ unsigned xb_xcc_id() { return (unsigned)__builtin_amdgcn_s_getreg((3 << 11) | 20) & 0xFu; }
#define XB_SPIN(cond, bar) do { unsigned _sp = 0; while (cond) { __builtin_amdgcn_s_sleep(1); \
    if ((++_sp & 255u) == 0u) { if (xb_ld(&(bar)[XB_TMO])) break; if (_sp > XB_SPIN_CAP) { atomicAdd(&(bar)[XB_TMO], 1u); break; } } } } while (0)

struct XcdBarrier {
    unsigned* bar; unsigned x;
    volatile LAS unsigned* st;
};

__device__ __forceinline__ XcdBarrier xcd_barrier_post(unsigned* bar, volatile LAS unsigned* st) {
    XcdBarrier b; b.bar = bar; b.x = xb_xcc_id(); b.st = st;
    if (threadIdx.x == 0) (void)xb_add(&bar[XB_XCNT(b.x)], 1u);
    return b;
}
__device__ __forceinline__ void xcd_barrier_complete(unsigned* bar, unsigned x, unsigned& nloc, unsigned& nx) {
    const unsigned G = gridDim.x * gridDim.y * gridDim.z;
    unsigned sum, cnt, mine, sp = 0u;
    for (;;) {
        sum = 0u; cnt = 0u; mine = 0u;
#pragma unroll
        for (unsigned j = 0; j < 16; ++j) { const unsigned c = xb_ld(&bar[XB_XCNT(j)]); sum += c; cnt += (c > 0u) ? 1u : 0u; mine = (j == x) ? c : mine; }
        if (sum == G) break;
        __builtin_amdgcn_s_sleep(1);
        if ((++sp & 255u) == 0u) { if (xb_ld(&bar[XB_TMO])) break; if (sp > XB_SPIN_CAP) { atomicAdd(&bar[XB_TMO], 1u); break; } }
    }
    nloc = mine > 0u ? mine : 1u; nx = cnt > 0u ? cnt : 1u;
}

__device__ __forceinline__ void xcd_barrier(const XcdBarrier& b) {
    asm volatile("s_waitcnt vmcnt(0)" ::: "memory");
    __syncthreads();
    if (threadIdx.x == 0) {
        unsigned* bar = b.bar;
        __builtin_amdgcn_s_waitcnt(0);
        unsigned nloc = b.st[0], nx = b.st[1];
        if (nloc == 0u) { xcd_barrier_complete(bar, b.x, nloc, nx); b.st[0] = nloc; b.st[1] = nx; }
        const unsigned old = xb_add(&bar[XB_XSUB(b.x)], 1u);
        const unsigned gen = old / nloc;
        if (old + 1u == (gen + 1u) * nloc) {
            __builtin_amdgcn_fence(__ATOMIC_RELEASE, "agent");
            asm volatile("s_waitcnt vmcnt(0)" ::: "memory");
            const unsigned og = xb_add(&bar[XB_TOP], 1u);
            const unsigned tg = og / nx;
            if (og + 1u == (tg + 1u) * nx) xb_add(&bar[XB_TOPGEN], 1u);
            else XB_SPIN(xb_ld(&bar[XB_TOPGEN]) == tg, bar);
            __builtin_amdgcn_fence(__ATOMIC_ACQUIRE, "agent");
            xb_add(&bar[XB_XGEN(b.x)], 1u);
            asm volatile("s_waitcnt vmcnt(0)" ::: "memory");
        } else {
            XB_SPIN(xb_ld(&bar[XB_XGEN(b.x)]) == gen, bar);
            __builtin_amdgcn_fence(__ATOMIC_ACQUIRE, "agent");
            asm volatile("s_waitcnt vmcnt(0)" ::: "memory");
        }
    }
    __syncthreads();
}


__global__ void __launch_bounds__(NTHREADS, 2) mega_fwd(Params p) {
    extern __shared__ __attribute__((aligned(16))) unsigned char lds_raw[];
    LAS unsigned char* lds = (LAS unsigned char*)lds_raw;
    cg::grid_group grid = cg::this_grid();
    unsigned char* ws = p.ws;
    unsigned* barw = (unsigned*)(ws + WS_BAR);
    volatile LAS unsigned* bst = (volatile LAS unsigned*)(lds + LDS_BYTES - 64);
    if (threadIdx.x < 2) bst[threadIdx.x] = 0u;
    if (blockIdx.x == 0) for (int i = threadIdx.x; i < XCD_BAR_WORDS; i += NTHREADS) barw[i] = 0u;
    phase_prologue(p, lds);
    grid.sync();
    const XcdBarrier xb = xcd_barrier_post(barw, bst);
#pragma unroll 1
    for (int l_ = 0; l_ < DEPTH; ++l_) {
        int l = l_; asm volatile("" : "+s"(l));
        if (l == 0) phase_norm<false>(p, lds, l, p.in[0]); else phase_norm<true>(p, lds, l, p.out);
        xcd_barrier(xb);
        {
            pg8::Gemm g{(const pg8::bf16_t*)(ws + WS_H), (const pg8::bf16_t*)(ws + WS_WIN) + (size_t)l * NP * D, T, NP, D};
            pg8::StaticOrder S; S.init(T, NP, (int)gridDim.x, (int)blockIdx.x);
            pg8::EpiIn E{(pg8::bf16_t*)(ws + WS_P1), (pg8::bf16_t*)(ws + WS_PG), p.in[11] + l * 2048};
            pg8::gemm_phase<pg8::EpiIn, pg8::StaticOrder, true, true>(lds, g, S, E);
        }
        xcd_barrier(xb);
        phase_mixer<false>(p, lds, l);
        xcd_barrier(xb);
        phase_scan(p);
        xcd_barrier(xb);
        phase_mixer<true>(p, lds, l);
        xcd_barrier(xb);
        {
            pg8::Gemm g{(const pg8::bf16_t*)(ws + WS_H), (const pg8::bf16_t*)(ws + WS_WUP) + (size_t)l * D * D, T, D, D};
            pg8::StaticOrder S; S.init(T, D, (int)gridDim.x, (int)blockIdx.x);
            pg8::EpiUp E{(const pg8::bf16_t*)(ws + WS_PG), (pg8::bf16_t*)(ws + WS_P1)};
            pg8::gemm_phase<pg8::EpiUp, pg8::StaticOrder, true, true>(lds, g, S, E);
        }
        xcd_barrier(xb);
        {
            pg8::Gemm g{(const pg8::bf16_t*)(ws + WS_P1), (const pg8::bf16_t*)(ws + WS_WOUT) + (size_t)l * D * D, T, D, D};
            pg8::StaticOrder S; S.init(T, D, (int)gridDim.x, (int)blockIdx.x);
            const float* gate2 = (const float*)(ws + WS_MOD) + (size_t)l * BATCH * 3072 + 2048;
            if (l == 0) { pg8::EpiOut<false> E{(const void*)p.in[0], (pg8::bf16_t*)p.out, gate2}; pg8::gemm_phase<pg8::EpiOut<false>, pg8::StaticOrder, true, true>(lds, g, S, E); }
            else { pg8::EpiOut<true> E{(const void*)p.out, (pg8::bf16_t*)(ws + WS_H), gate2}; pg8::gemm_phase<pg8::EpiOut<true>, pg8::StaticOrder, true, true>(lds, g, S, E); }
        }
        xcd_barrier(xb);
    }
    phase_final_norm(p);
}

extern "C" void kernel_launch(void* const* d_in, const int* in_sizes, int n_in, void* d_out, int out_size, void* d_ws, size_t ws_size, hipStream_t stream) {
    static int grid = 0;
    if (grid == 0) {
        if (n_in != 16 || in_sizes[0] != T * D || out_size != T * D || ws_size < WS_END) { fprintf(stderr, "kernel_launch: unexpected shapes (n_in %d, in0 %d, out %d, ws %zu)\n", n_in, n_in > 0 ? in_sizes[0] : -1, out_size, ws_size); grid = -1; return; }
        int dev = 0, cus = 0, per_cu = 0;
        if (hipGetDevice(&dev) != hipSuccess || hipDeviceGetAttribute(&cus, hipDeviceAttributeMultiprocessorCount, dev) != hipSuccess) { fprintf(stderr, "kernel_launch: device query failed\n"); grid = -1; return; }
        if (hipFuncSetAttribute((const void*)mega_fwd, hipFuncAttributeMaxDynamicSharedMemorySize, LDS_BYTES) != hipSuccess) { fprintf(stderr, "kernel_launch: hipFuncSetAttribute failed\n"); grid = -1; return; }
        if (hipOccupancyMaxActiveBlocksPerMultiprocessor(&per_cu, (const void*)mega_fwd, NTHREADS, LDS_BYTES) != hipSuccess || per_cu < 1) { fprintf(stderr, "kernel_launch: occupancy query failed (%d)\n", per_cu); (void)hipGetLastError(); per_cu = 1; }
        grid = cus * per_cu;
    }
    if (grid < 0) return;
    Params p{};
    for (int i = 0; i < 16; ++i) p.in[i] = (const float*)d_in[i];
    p.out = (float*)d_out; p.ws = (unsigned char*)d_ws;
    void* args[] = {&p};
    const hipError_t e = hipLaunchCooperativeKernel((const void*)mega_fwd, dim3(grid), dim3(NTHREADS), args, LDS_BYTES, stream);
    if (e != hipSuccess) fprintf(stderr, "kernel_launch: cooperative launch failed: %s (grid %d)\n", hipGetErrorString(e), grid);
}
```

```cpp
#include <hip/hip_runtime.h>
#include <hip/hip_cooperative_groups.h>
#include <cstdio>
#include <cstdint>
namespace cg = cooperative_groups;
namespace pg8 {
#define PG8_LAS __attribute__((address_space(3)))
typedef unsigned short bf16_t;
typedef short bf16x8 __attribute__((ext_vector_type(8)));
typedef float f32x4 __attribute__((ext_vector_type(4)));
typedef unsigned u32x4 __attribute__((ext_vector_type(4)));
constexpr int BM = 256, BK = 64, HALF = 128, HTB = HALF * BK * 2  , STAGE_BYTES = 8 * HTB, NXCD = 8, WGM = 8;

__host__ __device__ __forceinline__ int lds_byte(int r, int c) { const int st = (r >> 4) * 2 + (c >> 5), rr = r & 15, cc = c & 31, ob = rr * 64 + cc * 2; return st * 1024 + (ob ^ (((ob >> 9) & 1) << 5)); }
__host__ __device__ __forceinline__ void stage_rc(int b, int& R, int& C) { const int st = b / 1024, sb = b % 1024, swz = sb ^ (((sb >> 9) & 1) << 5); R = (st >> 1) * 16 + swz / 64; C = (st & 1) * 32 + (swz % 64) / 2; }
__host__ __device__ __forceinline__ int perm32(int rho) { const int n = rho >> 4, i = rho & 15; return 8 * (i >> 2) + 4 * n + (i & 3); }

struct Unit { int pm, pn; };
struct Gemm { const bf16_t* A; const bf16_t* Bt; int M, N, K; };

struct StaticOrder {
    int nM, nN, nwg, G, c;
    __host__ __device__ void init(int M, int N, int G_, int c_) { nM = M / BM; nN = N / BM; nwg = nM * nN; G = G_; c = c_; }
    __host__ __device__ bool next(int i, Unit& u) const {
        const long L = (long)i * G + c; if (L >= nwg) return false;
        int wgid = (int)L; { const int q = nwg / NXCD, r = nwg % NXCD, xcd = wgid % NXCD, off = wgid / NXCD; wgid = (xcd < r ? xcd * (q + 1) : r * (q + 1) + (xcd - r) * q) + off; }
        const int nig = WGM * nN, gid = wgid / nig, fm = gid * WGM, gsz = (nM - fm) < WGM ? (nM - fm) : WGM;
        u.pm = fm + ((wgid % nig) % gsz); u.pn = (wgid % nig) / gsz; return true;
    }
    __device__ __forceinline__ void a_ready(const Unit&) const {}
    __device__ __forceinline__ void done(const Unit&) const {}
};
__device__ __forceinline__ unsigned cvt_pk_bf16(float lo, float hi) { unsigned r; asm volatile("v_cvt_pk_bf16_f32 %0, %1, %2" : "=v"(r) : "v"(lo), "v"(hi)); return r; }
template <class Epi, class Sched, bool ALIGN_EPI = false, bool SP2 = false>
__device__ __forceinline__ void gemm_phase(PG8_LAS unsigned char* lds, const Gemm g, const Sched& S, const Epi& E) {
    int tid_ = threadIdx.x; asm volatile("" : "+v"(tid_));
    const int tid = tid_, wid = __builtin_amdgcn_readfirstlane(tid >> 6), lane = tid & 63, wr = wid >> 2, wc = wid & 3, fr = lane & 15, fq = lane >> 4;
    const int K = g.K, nt = K / BK;
    unsigned voffA[2], voffB[2];
#pragma unroll
    for (int i = 0; i < 2; ++i) { int R, C; stage_rc(tid * 16 + i * 8192, R, C); const int Rb = Epi::PERM ? ((R & ~31) + perm32(R & 31)) : R;
        voffA[i] = (unsigned)(R * K + C) * 2u; voffB[i] = (unsigned)(Rb * K + C) * 2u; }
    const size_t kstep = (size_t)(BK * 2);
    const size_t hstep = (size_t)HALF * K * 2;
    const size_t tstep = 2 * hstep;
    const unsigned ldsw = (unsigned)wid * 1024u;
    const int aoff = lds_byte(wr * 64 + fr, fq * 8), boff = lds_byte(wc * 32 + fr, fq * 8);
#define PG8_SA(b, h) (((b) * 2 + (h)) * HTB)
#define PG8_SB(b, h) ((4 + (b) * 2 + (h)) * HTB)
#define PG8_STAGE(bufoff, gbase, voff) do { _Pragma("unroll") for (int _i = 0; _i < 2; ++_i) \
        __builtin_amdgcn_global_load_lds((const unsigned*)((const char*)(gbase) + (voff)[_i]), (PG8_LAS unsigned*)(lds + (bufoff) + ldsw + _i * 8192), 16, 0, 0); } while (0)
#define PG8_LDA(dst, b, h) do { _Pragma("unroll") for (int m = 0; m < 4; ++m) _Pragma("unroll") for (int k = 0; k < 2; ++k) dst[m][k] = *(const PG8_LAS bf16x8*)(lds + PG8_SA(b, h) + aoff + m * 2048 + k * 1024); } while (0)
#define PG8_LDB(dst, b, h) do { _Pragma("unroll") for (int n = 0; n < 2; ++n) _Pragma("unroll") for (int k = 0; k < 2; ++k) dst[n][k] = *(const PG8_LAS bf16x8*)(lds + PG8_SB(b, h) + boff + n * 2048 + k * 1024); } while (0)
#define PG8_MMA(ai, bj, At, Bt) do { __builtin_amdgcn_s_setprio(1); _Pragma("unroll") for (int m = 0; m < 4; ++m) _Pragma("unroll") for (int n = 0; n < 2; ++n) _Pragma("unroll") for (int k = 0; k < 2; ++k) \
        acc[ai][bj][m][n] = __builtin_amdgcn_mfma_f32_16x16x32_bf16(Bt[n][k], At[m][k], acc[ai][bj][m][n], 0, 0, 0); __builtin_amdgcn_s_setprio(0); } while (0)
#define PG8_WAIT_V(n) asm volatile("s_waitcnt vmcnt(" #n ")" ::: "memory")
#define PG8_WAIT_L(n) asm volatile("s_waitcnt lgkmcnt(" #n ")" ::: "memory")
#define PG8_BAR __builtin_amdgcn_s_barrier()
#define PG8_SCHED __builtin_amdgcn_sched_barrier(0)
    Unit cur, nxt; int ui = 0;
    if (!S.next(0, cur)) return;
    f32x4 acc[2][2][4][2];
#pragma unroll
    for (int a = 0; a < 2; ++a)
#pragma unroll
        for (int b = 0; b < 2; ++b)
#pragma unroll
            for (int m = 0; m < 4; ++m)
#pragma unroll
                for (int n = 0; n < 2; ++n) acc[a][b][m][n] = (f32x4){0.f, 0.f, 0.f, 0.f};
    bf16x8 At[4][2], B0[2][2], B1[2][2];
    const char* cA = (const char*)g.A + (size_t)cur.pm * tstep; const char* cB = (const char*)g.Bt + (size_t)cur.pn * tstep;
    S.a_ready(cur);
    if constexpr (SP2) {
        PG8_STAGE(PG8_SB(0, 0), cB, voffB); PG8_STAGE(PG8_SB(0, 1), cB + hstep, voffB); PG8_STAGE(PG8_SA(0, 0), cA, voffA); PG8_STAGE(PG8_SA(0, 1), cA + hstep, voffA);
        if (wr == 1) PG8_BAR;
        PG8_WAIT_V(2); PG8_BAR;
        PG8_STAGE(PG8_SB(1, 0), cB + kstep, voffB); PG8_STAGE(PG8_SA(1, 0), cA + kstep, voffA); PG8_STAGE(PG8_SB(1, 1), cB + hstep + kstep, voffB);
        PG8_WAIT_V(6); PG8_BAR;
    } else {
        PG8_STAGE(PG8_SB(0, 0), cB, voffB); PG8_STAGE(PG8_SA(0, 0), cA, voffA); PG8_STAGE(PG8_SB(0, 1), cB + hstep, voffB); PG8_STAGE(PG8_SA(0, 1), cA + hstep, voffA);
        if (wr == 1) PG8_BAR;
        PG8_WAIT_V(4); PG8_BAR;
        PG8_STAGE(PG8_SB(1, 0), cB + kstep, voffB); PG8_STAGE(PG8_SA(1, 0), cA + kstep, voffA); PG8_STAGE(PG8_SB(1, 1), cB + hstep + kstep, voffB);
        PG8_WAIT_V(6); PG8_BAR;
    }
    for (;;) {
        const bool has_next = S.next(ui + 1, nxt);
        const char* nA = has_next ? (const char*)g.A + (size_t)nxt.pm * tstep : cA; const char* nB = has_next ? (const char*)g.Bt + (size_t)nxt.pn * tstep : cB;
        for (int t = 0; t < nt; t += 2) {
            const bool last = (t == nt - 2);
            const char* a1 = cA + (size_t)(t + 1) * kstep;
            const char* a2 = last ? nA : cA + (size_t)(t + 2) * kstep; const char* b2 = last ? nB : cB + (size_t)(t + 2) * kstep;
            const char* a3 = a2 + kstep; const char* b3 = b2 + kstep;
            if (last && has_next) S.a_ready(nxt);
            if constexpr (Epi::MID) { if (t == nt / 2) E.mid(acc, cur, wr, wc, fr, fq); }
            if constexpr (SP2) {
            PG8_LDB(B0, 0, 0); PG8_LDB(B1, 0, 1); PG8_SCHED; PG8_LDA(At, 0, 0); PG8_STAGE(PG8_SA(1, 1), a1 + hstep, voffA);
            PG8_WAIT_V(8); PG8_WAIT_L(0); PG8_BAR; PG8_MMA(0, 0, At, B0); PG8_MMA(0, 1, At, B1); PG8_BAR; PG8_SCHED;
            PG8_LDA(At, 0, 1); PG8_STAGE(PG8_SB(0, 0), b2, voffB); PG8_STAGE(PG8_SB(0, 1), b2 + hstep, voffB); PG8_STAGE(PG8_SA(0, 0), a2, voffA);
            PG8_WAIT_V(8); PG8_WAIT_L(0); PG8_BAR; PG8_MMA(1, 0, At, B0); PG8_MMA(1, 1, At, B1); PG8_BAR; PG8_SCHED;
            PG8_LDB(B0, 1, 0); PG8_LDB(B1, 1, 1); PG8_SCHED; PG8_LDA(At, 1, 0); PG8_STAGE(PG8_SA(0, 1), a2 + hstep, voffA);
            PG8_WAIT_V(8); PG8_WAIT_L(0); PG8_BAR; PG8_MMA(0, 0, At, B0); PG8_MMA(0, 1, At, B1); PG8_BAR; PG8_SCHED;
            PG8_LDA(At, 1, 1); PG8_STAGE(PG8_SB(1, 0), b3, voffB); PG8_STAGE(PG8_SB(1, 1), b3 + hstep, voffB); PG8_STAGE(PG8_SA(1, 0), a3, voffA);
            PG8_WAIT_V(8); PG8_WAIT_L(0); PG8_BAR; PG8_MMA(1, 0, At, B0); PG8_MMA(1, 1, At, B1); PG8_BAR; PG8_SCHED;
            } else {
            PG8_LDB(B0, 0, 0); PG8_SCHED; PG8_LDA(At, 0, 0); PG8_STAGE(PG8_SA(1, 1), a1 + hstep, voffA);
            PG8_WAIT_L(8); PG8_BAR; PG8_WAIT_L(0); PG8_MMA(0, 0, At, B0); PG8_BAR; PG8_SCHED;
            PG8_LDB(B1, 0, 1); PG8_STAGE(PG8_SB(0, 0), b2, voffB);
            PG8_BAR; PG8_WAIT_L(0); PG8_MMA(0, 1, At, B1); PG8_BAR;
            PG8_LDA(At, 0, 1); PG8_STAGE(PG8_SA(0, 0), a2, voffA);
            PG8_BAR; PG8_WAIT_L(0); PG8_MMA(1, 0, At, B0); PG8_BAR; PG8_SCHED;
            PG8_STAGE(PG8_SB(0, 1), b2 + hstep, voffB);
            PG8_WAIT_V(6); PG8_BAR; PG8_MMA(1, 1, At, B1); PG8_BAR;
            PG8_LDB(B0, 1, 0); PG8_SCHED; PG8_LDA(At, 1, 0); PG8_STAGE(PG8_SA(0, 1), a2 + hstep, voffA);
            PG8_WAIT_L(8); PG8_BAR; PG8_WAIT_L(0); PG8_MMA(0, 0, At, B0); PG8_BAR; PG8_SCHED;
            PG8_LDB(B1, 1, 1); PG8_STAGE(PG8_SB(1, 0), b3, voffB);
            PG8_BAR; PG8_WAIT_L(0); PG8_MMA(0, 1, At, B1); PG8_BAR;
            PG8_LDA(At, 1, 1); PG8_STAGE(PG8_SA(1, 0), a3, voffA);
            PG8_BAR; PG8_WAIT_L(0); PG8_MMA(1, 0, At, B0); PG8_BAR; PG8_SCHED;
            PG8_STAGE(PG8_SB(1, 1), b3 + hstep, voffB);
            PG8_WAIT_V(6); PG8_BAR; PG8_MMA(1, 1, At, B1); PG8_BAR;
            }
        }
        if constexpr (ALIGN_EPI) { if (wr == 0) PG8_BAR; }
        if constexpr (!Epi::AFTER_DRAIN) { E(acc, cur, wr, wc, fr, fq); S.done(cur); }
        if (!has_next) break;
#pragma unroll
        for (int a = 0; a < 2; ++a)
#pragma unroll
            for (int b = 0; b < 2; ++b)
#pragma unroll
                for (int m = 0; m < 4; ++m)
#pragma unroll
                    for (int n = 0; n < 2; ++n) acc[a][b][m][n] = (f32x4){0.f, 0.f, 0.f, 0.f};
        cur = nxt; cA = nA; cB = nB; ++ui;
        if constexpr (ALIGN_EPI) { if (wr == 1) PG8_BAR; }
    }
    PG8_WAIT_V(0);
    if constexpr (!ALIGN_EPI) { if (wr == 0) PG8_BAR; }
    PG8_BAR;
    if constexpr (Epi::AFTER_DRAIN) { E.fused(acc, cur, wr, wc, fr, fq, lds, wid, lane); S.done(cur); }
#undef PG8_SA
#undef PG8_SB
#undef PG8_STAGE
#undef PG8_LDA
#undef PG8_LDB
#undef PG8_MMA
#undef PG8_WAIT_V
#undef PG8_WAIT_L
#undef PG8_BAR
#undef PG8_SCHED
}
}

#define LAS __attribute__((address_space(3)))
typedef unsigned short bf16;
typedef float f32x4 __attribute__((ext_vector_type(4)));
typedef short bf16x8 __attribute__((ext_vector_type(8)));
typedef unsigned u32x4 __attribute__((ext_vector_type(4)));
typedef unsigned u32x2 __attribute__((ext_vector_type(2)));

constexpr int D = 1024, BATCH = 2, SEQ = 16384, T = BATCH * SEQ, DEPTH = 2;
constexpr int IN_TOTAL = 5648, NP = 5632, NP1 = 3584, NPG = 2048;
constexpr int G_CH = 8;
constexpr int NCHUNK = SEQ / 64;
constexpr int NG = NCHUNK / G_CH;
constexpr int NTHREADS = 512, NWAVES = 8;
constexpr int LDS_BYTES = 147456;
constexpr float EPS = 1e-6f;

constexpr int C_GQ = 0, C_GK = 256, C_GV = 512, C_GZ = 1024, C_HQ = 1536, C_HF = 2048, C_HI = 2560, C_HZ = 3072;

constexpr size_t MiB = 1u << 20;
constexpr size_t WS_MOD = 0;
constexpr size_t WS_BAR = 512 * 1024;
constexpr size_t WS_WIN = 1 * MiB;
constexpr size_t WS_WUP = 23 * MiB;
constexpr size_t WS_WOUT = 27 * MiB;
constexpr size_t WS_STATE = 32 * MiB;
constexpr size_t WS_STATE_HG = WS_STATE + 8 * MiB;
constexpr size_t WS_PDEC = 56 * MiB;
constexpr size_t WS_WLR = 57 * MiB;
constexpr size_t WS_LOGA = 64 * MiB;
constexpr size_t WS_H = 96 * MiB;
constexpr size_t WS_P1 = 160 * MiB;
constexpr size_t WS_PG = 384 * MiB;
constexpr size_t WS_END = 512 * MiB;

struct Params { const float* in[16]; float* out; unsigned char* ws; };

__device__ __forceinline__ float bf2f(unsigned short b) { return __builtin_bit_cast(float, (unsigned)b << 16); }
__device__ __forceinline__ float bflo(unsigned w) { return __builtin_bit_cast(float, w << 16); }
__device__ __forceinline__ float bfhi(unsigned w) { return __builtin_bit_cast(float, w & 0xffff0000u); }
__device__ __forceinline__ unsigned f2bf(float f) { unsigned u = __builtin_bit_cast(unsigned, f); return (u + 0x7fffu + ((u >> 16) & 1u)) >> 16; }
__device__ __forceinline__ unsigned pk2(float lo, float hi) { return f2bf(lo) | (f2bf(hi) << 16); }
__device__ __forceinline__ float sigmoidf_(float x) { return 1.0f / (1.0f + __expf(-x)); }
__device__ __forceinline__ float wave_sum(float v) {
#pragma unroll
    for (int o = 1; o < 64; o <<= 1) v += __shfl_xor(v, o);
    return v;
}
#define LDS_WAIT() asm volatile("s_waitcnt lgkmcnt(0)" ::: "memory")

namespace pg8 {
struct EpiIn {
    static constexpr bool PERM = true, AFTER_DRAIN = false, MID = false;
    bf16_t* P1; bf16_t* PG; const float* bias;
    __device__ __forceinline__ void operator()(const f32x4 (&acc)[2][2][4][2], const Unit& u, int wr, int wc, int fr, int fq) const {
        const int pn = u.pn;
        const int row0 = u.pm * BM + wr * 64 + fr;
        if (pn >= 14) {
            const int ch0 = (pn - 14) * 128 + wc * 32 + 8 * fq;
            f32x4 ba[2], bb[2];
#pragma unroll
            for (int n = 0; n < 2; ++n) { ba[n] = *(const f32x4*)(bias + ch0 + 4 * n); bb[n] = *(const f32x4*)(bias + 1024 + ch0 + 4 * n); }
#pragma unroll
            for (int ai = 0; ai < 2; ++ai)
#pragma unroll
                for (int m = 0; m < 4; ++m) { bf16_t* rowp = PG + (size_t)(row0 + ai * HALF + m * 16) * NPG + ch0;
                    f32x4 r[2], g[2];
#pragma unroll
                    for (int n = 0; n < 2; ++n) { const f32x4 a = acc[ai][0][m][n] + ba[n], b = acc[ai][1][m][n] + bb[n];
#pragma unroll
                        for (int j = 0; j < 4; ++j) { const float ea = __expf(-a[j]), eb = __expf(-b[j]); g[n][j] = __builtin_amdgcn_rcpf(1.0f + eb); r[n][j] = (1.0f + eb) * __builtin_amdgcn_rcpf(1.0f + ea); } }
                    u32x4 w; w.x = cvt_pk_bf16(r[0][0], r[0][1]); w.y = cvt_pk_bf16(r[0][2], r[0][3]); w.z = cvt_pk_bf16(r[1][0], r[1][1]); w.w = cvt_pk_bf16(r[1][2], r[1][3]);
                    *(u32x4*)rowp = w;
                    w.x = cvt_pk_bf16(g[0][0], g[0][1]); w.y = cvt_pk_bf16(g[0][2], g[0][3]); w.z = cvt_pk_bf16(g[1][0], g[1][1]); w.w = cvt_pk_bf16(g[1][2], g[1][3]);
                    *(u32x4*)(rowp + 1024) = w; }
            return;
        }
        int mode = 0; float scl = 1.0f;
        if (pn == 0) scl = 0.125f;
        else if (pn == 4 || pn == 5 || pn == 12 || pn == 13) mode = 1;
        else if (pn == 6 || pn == 7) { mode = 1; scl = 0.08838834764831845f; }
        const int col0 = pn * 256 + wc * 32 + 8 * fq;
#pragma unroll
        for (int ai = 0; ai < 2; ++ai)
#pragma unroll
            for (int m = 0; m < 4; ++m) { bf16_t* rowp = P1 + (size_t)(row0 + ai * HALF + m * 16) * NP1 + col0;
#pragma unroll
                for (int bj = 0; bj < 2; ++bj) { f32x4 v0 = acc[ai][bj][m][0], v1 = acc[ai][bj][m][1];
                    if (mode == 0) { v0 = v0 * scl; v1 = v1 * scl; }
                    else {
#pragma unroll
                        for (int j = 0; j < 4; ++j) { v0[j] = v0[j] * scl * __builtin_amdgcn_rcpf(1.0f + __expf(-v0[j])); v1[j] = v1[j] * scl * __builtin_amdgcn_rcpf(1.0f + __expf(-v1[j])); } }
                    u32x4 w; w.x = cvt_pk_bf16(v0[0], v0[1]); w.y = cvt_pk_bf16(v0[2], v0[3]); w.z = cvt_pk_bf16(v1[0], v1[1]); w.w = cvt_pk_bf16(v1[2], v1[3]);
                    *(u32x4*)(rowp + bj * HALF) = w; } }
    }
};
struct EpiUp {
    static constexpr bool PERM = true, AFTER_DRAIN = false, MID = true;
    const bf16_t* PG; bf16_t* Mo;
    __device__ __forceinline__ void mid(f32x4 (&acc)[2][2][4][2], const Unit& u, int wr, int wc, int fr_, int fq) const {
        int fr = fr_; asm volatile("" : "+v"(fr));
        const int row0 = u.pm * BM + wr * 64 + fr, col0 = u.pn * BM + wc * 32 + 8 * fq;
#pragma unroll
        for (int ai = 0; ai < 2; ++ai) {
            u32x4 rv[4][2];
#pragma unroll
            for (int m = 0; m < 4; ++m) { const bf16_t* gp = PG + (size_t)(row0 + ai * HALF + m * 16) * NPG + col0;
#pragma unroll
                for (int bj = 0; bj < 2; ++bj) rv[m][bj] = *(const u32x4*)(gp + bj * HALF); }
#pragma unroll
            for (int m = 0; m < 4; ++m)
#pragma unroll
                for (int bj = 0; bj < 2; ++bj) { const u32x4 ga = rv[m][bj];
                    acc[ai][bj][m][0] = acc[ai][bj][m][0] * (f32x4){bflo(ga.x), bfhi(ga.x), bflo(ga.y), bfhi(ga.y)};
                    acc[ai][bj][m][1] = acc[ai][bj][m][1] * (f32x4){bflo(ga.z), bfhi(ga.z), bflo(ga.w), bfhi(ga.w)}; }
            __builtin_amdgcn_sched_barrier(0);
        }
    }
    __device__ __forceinline__ void operator()(const f32x4 (&acc)[2][2][4][2], const Unit& u, int wr, int wc, int fr, int fq) const {
        const int row0 = u.pm * BM + wr * 64 + fr, col0 = u.pn * BM + wc * 32 + 8 * fq;
#pragma unroll
        for (int ai = 0; ai < 2; ++ai)
#pragma unroll
            for (int m = 0; m < 4; ++m) { const size_t row = (size_t)(row0 + ai * HALF + m * 16); const bf16_t* gp = PG + row * NPG + 1024 + col0; bf16_t* op = Mo + row * D + col0;
#pragma unroll
                for (int bj = 0; bj < 2; ++bj) { const u32x4 gb = *(const u32x4*)(gp + bj * HALF);
                    const f32x4 a0 = acc[ai][bj][m][0], a1 = acc[ai][bj][m][1];
                    u32x4 w; w.x = cvt_pk_bf16(a0[0] * bflo(gb.x), a0[1] * bfhi(gb.x)); w.y = cvt_pk_bf16(a0[2] * bflo(gb.y), a0[3] * bfhi(gb.y));
                    w.z = cvt_pk_bf16(a1[0] * bflo(gb.z), a1[1] * bfhi(gb.z)); w.w = cvt_pk_bf16(a1[2] * bflo(gb.w), a1[3] * bfhi(gb.w));
                    *(u32x4*)(op + bj * HALF) = w; } }
    }
};
template <bool XBF> struct EpiOut {
    static constexpr bool PERM = true, AFTER_DRAIN = false, MID = false;
    const void* xin; bf16_t* out; const float* gate2;
    __device__ __forceinline__ void operator()(const f32x4 (&acc)[2][2][4][2], const Unit& u, int wr, int wc, int fr, int fq) const {
        const int row0 = u.pm * BM + wr * 64 + fr, col0 = u.pn * BM + wc * 32 + 8 * fq;
        const float* gate = gate2 + ((u.pm * BM) / SEQ) * 3072;
        f32x4 gv[2][2];
#pragma unroll
        for (int bj = 0; bj < 2; ++bj)
#pragma unroll
            for (int n = 0; n < 2; ++n) gv[bj][n] = *(const f32x4*)(gate + col0 + bj * HALF + 4 * n);
#pragma unroll
        for (int ai = 0; ai < 2; ++ai)
#pragma unroll
            for (int m = 0; m < 4; ++m) { const size_t off = (size_t)(row0 + ai * HALF + m * 16) * D + col0;
#pragma unroll
                for (int bj = 0; bj < 2; ++bj) { f32x4 x0, x1;
                    if (XBF) { const u32x4 xb = *(const u32x4*)((const bf16_t*)xin + off + bj * HALF);
                        x0 = (f32x4){__builtin_bit_cast(float, xb.x << 16), __builtin_bit_cast(float, xb.x & 0xffff0000u), __builtin_bit_cast(float, xb.y << 16), __builtin_bit_cast(float, xb.y & 0xffff0000u)};
                        x1 = (f32x4){__builtin_bit_cast(float, xb.z << 16), __builtin_bit_cast(float, xb.z & 0xffff0000u), __builtin_bit_cast(float, xb.w << 16), __builtin_bit_cast(float, xb.w & 0xffff0000u)}; }
                    else { x0 = *(const f32x4*)((const float*)xin + off + bj * HALF); x1 = *(const f32x4*)((const float*)xin + off + bj * HALF + 4); }
                    const f32x4 y0 = x0 + gv[bj][0] * acc[ai][bj][m][0], y1 = x1 + gv[bj][1] * acc[ai][bj][m][1];
                    u32x4 w; w.x = cvt_pk_bf16(y0[0], y0[1]); w.y = cvt_pk_bf16(y0[2], y0[3]); w.z = cvt_pk_bf16(y1[0], y1[1]); w.w = cvt_pk_bf16(y1[2], y1[3]);
                    *(u32x4*)(out + off + bj * HALF) = w; } }
    }
};
}

__device__ __forceinline__ void transpose_item(const float* W, int ldw, int src_col0, int k0, bf16* WT, int dst_row0, int dst_k0, LAS float* scr, int lane) {
#pragma unroll
    for (int i = 0; i < 32; ++i) { const int kk = 2 * i + (lane >> 5); scr[kk * 33 + (lane & 31)] = W[(size_t)(k0 + kk) * ldw + src_col0 + (lane & 31)]; }
    LDS_WAIT();
    const int c = lane & 7;
#pragma unroll
    for (int j = 0; j < 4; ++j) { const int n = (lane >> 3) + 8 * j; const LAS float* s = scr + (8 * c) * 33 + n;
        u32x4 o; o.x = pk2(s[0 * 33], s[1 * 33]); o.y = pk2(s[2 * 33], s[3 * 33]); o.z = pk2(s[4 * 33], s[5 * 33]); o.w = pk2(s[6 * 33], s[7 * 33]);
        *(u32x4*)(WT + (size_t)(dst_row0 + n) * D + dst_k0 + 8 * c) = o; }
    LDS_WAIT();
}

__device__ __forceinline__ void phase_prologue(const Params& p, LAS unsigned char* lds) {
    int tid_ = threadIdx.x; asm volatile("" : "+v"(tid_));
    const int tid = tid_, lane = tid & 63, wave = tid >> 6;
    unsigned char* ws = p.ws;
    for (int task = blockIdx.x; task < DEPTH * 96; task += gridDim.x) {
        const int l = task / 96, cgp = task % 96, col = tid & 31, ks = tid >> 5;
        const float* W = p.in[3] + (size_t)l * D * 3072 + cgp * 32 + col;
        const float* c0 = p.in[1], *c1 = p.in[1] + D;
        float s0 = 0.f, s1 = 0.f;
#pragma unroll 16
        for (int k = ks * 64; k < ks * 64 + 64; ++k) { const float w = W[(size_t)k * 3072]; const float a = c0[k], b = c1[k];
            s0 += a * sigmoidf_(a) * w; s1 += b * sigmoidf_(b) * w; }
        LAS float* red = (LAS float*)(lds + 98304);
        red[(ks * 32 + col) * 2 + 0] = s0; red[(ks * 32 + col) * 2 + 1] = s1;
        __syncthreads();
        if (tid < 64) { const int cc = tid & 31, bb = tid >> 5; float s = 0.f;
#pragma unroll
            for (int k = 0; k < 16; ++k) s += red[(k * 32 + cc) * 2 + bb];
            const int cglob = cgp * 32 + cc;
            ((float*)(ws + WS_MOD))[(l * BATCH + bb) * 3072 + cglob] = s + p.in[4][l * 3072 + cglob]; }
        __syncthreads();
    }
    LAS float* scr = (LAS float*)(lds + wave * 8704);
    const int gw = blockIdx.x * NWAVES + wave, NGW = gridDim.x * NWAVES;
    constexpr int I_IN = 16 * 176, I_UP = 8 * 32, I_OUT = 16 * 32, I_LR = 16, I_L = I_IN + 2 * I_UP + I_OUT + I_LR;
    for (int it = gw; it < DEPTH * I_L; it += NGW) {
        const int l = it / I_L; int r = it % I_L;
        if (r < I_IN) { const int kb = r / 176, nb = r % 176, n0 = 32 * nb;
            transpose_item(p.in[5] + (size_t)l * D * IN_TOTAL, IN_TOTAL, n0 < 1536 ? n0 : (n0 < 3584 ? n0 + 16 : 3600 + (((n0 - 3584) >> 7) & 1) * 1024 + ((n0 - 3584) >> 8) * 128 + (n0 & 127)), 64 * kb, (bf16*)(ws + WS_WIN) + (size_t)l * NP * D, n0, 64 * kb, scr, lane); continue; }
        r -= I_IN;
        if (r < I_UP) { const int kb = r / 32, nb = r % 32;
            transpose_item(p.in[12] + (size_t)l * 512 * D, D, 32 * nb, 64 * kb, (bf16*)(ws + WS_WUP) + (size_t)l * D * D, 32 * nb, 64 * kb, scr, lane); continue; }
        r -= I_UP;
        if (r < I_UP) { const int kb = r / 32, nb = r % 32;
            transpose_item(p.in[13] + (size_t)l * 512 * D, D, 32 * nb, 64 * kb, (bf16*)(ws + WS_WUP) + (size_t)l * D * D, 32 * nb, 512 + 64 * kb, scr, lane); continue; }
        r -= I_UP;
        if (r >= I_OUT) { const int kb = r - I_OUT;
            transpose_item(p.in[5] + (size_t)l * D * IN_TOTAL, IN_TOTAL, 1536, 64 * kb, (bf16*)(ws + WS_WLR) + (size_t)l * 32 * D, 0, 64 * kb, scr, lane); continue; }
        { const int kb = r / 32, nb = r % 32;
            transpose_item(p.in[14] + (size_t)l * D * D, D, 32 * nb, 64 * kb, (bf16*)(ws + WS_WOUT) + (size_t)l * D * D, 32 * nb, 64 * kb, scr, lane); }
    }
}

template <bool XBF> struct XRaw;
template <> struct XRaw<false> { typedef f32x4 T; static __device__ __forceinline__ f32x4 cvt(const f32x4& v) { return v; } };
template <> struct XRaw<true> { typedef u32x2 T; static __device__ __forceinline__ f32x4 cvt(const u32x2& v) { return (f32x4){bflo(v.x), bfhi(v.x), bflo(v.y), bfhi(v.y)}; } };
template <bool XBF>
__device__ __forceinline__ void phase_norm(const Params& p, LAS unsigned char* lds, int l, const void* xin_) {
    int tid_ = threadIdx.x; asm volatile("" : "+v"(tid_));
    const int tid = tid_, lane = tid & 63, wave = tid >> 6, m = lane & 15, q = lane >> 4;
    unsigned char* ws = p.ws;
    constexpr int TRS = 2064;
    LAS unsigned char* tile = lds + wave * (8 * TRS);
    LAS float* wscr = (LAS float*)(lds + 8 * 8 * TRS) + wave * 128;
    f32x4 wa2r[16];
#pragma unroll
    for (int n = 0; n < 16; ++n) wa2r[n] = *(const f32x4*)(p.in[6] + l * 4096 + n * 256 + lane * 4);
    f32x4 nw[4];
#pragma unroll
    for (int j = 0; j < 4; ++j) nw[j] = *(const f32x4*)(p.in[2] + l * D + lane * 4 + 256 * j);
    const f32x4 ba4 = *(const f32x4*)(p.in[7] + l * 256 + lane * 4);
    const float* mod = (const float*)(ws + WS_MOD) + (size_t)l * BATCH * 3072;
    bf16* H = (bf16*)(ws + WS_H); bf16* LA = (bf16*)(ws + WS_LOGA);
    const bf16* wlr = (const bf16*)(ws + WS_WLR) + (size_t)l * 32 * D + m * D + q * 8;
    const LAS unsigned char* arow = tile + (m & 7) * TRS + q * 16;
    const int gw = blockIdx.x * NWAVES + wave, NGW = gridDim.x * NWAVES;
    int bcur = -1;
    typedef typename XRaw<XBF>::T xraw_t;
    f32x4 hm[4], ha[4]; xraw_t xn[2][4];
    if (gw * 8 < T) {
#pragma unroll
        for (int rr = 0; rr < 2; ++rr)
#pragma unroll
            for (int j = 0; j < 4; ++j) xn[rr][j] = ((const xraw_t*)xin_ + (size_t)(gw * 8 + rr) * (D / 4) + lane)[64 * j]; }
#pragma unroll 1
    for (int t = gw; t < T / 8; t += NGW) {
        const int r0 = t * 8, b = r0 / SEQ;
        if (b != bcur) { bcur = b;
#pragma unroll
            for (int j = 0; j < 4; ++j) { ha[j] = *(const f32x4*)(mod + b * 3072 + lane * 4 + 256 * j); const f32x4 sc = *(const f32x4*)(mod + b * 3072 + 1024 + lane * 4 + 256 * j); hm[j] = nw[j] * (1.0f + sc); } }
#pragma unroll 1
        for (int rp = 0; rp < 4; ++rp) {
            f32x4 hv[2][4];
#pragma unroll
            for (int rr = 0; rr < 2; ++rr)
#pragma unroll
                for (int j = 0; j < 4; ++j) hv[rr][j] = XRaw<XBF>::cvt(xn[rr][j]);
            {
                int rn = r0 + 2 * rp + 2;
                if (rp == 3) rn = (t + NGW < T / 8) ? (t + NGW) * 8 : r0;
#pragma unroll
                for (int rr = 0; rr < 2; ++rr)
#pragma unroll
                    for (int j = 0; j < 4; ++j) xn[rr][j] = ((const xraw_t*)xin_ + (size_t)(rn + rr) * (D / 4) + lane)[64 * j];
            }
#pragma unroll
            for (int rr = 0; rr < 2; ++rr) {
                float s = 0.f;
#pragma unroll
                for (int j = 0; j < 4; ++j) s += (hv[rr][j].x * hv[rr][j].x + hv[rr][j].y * hv[rr][j].y) + (hv[rr][j].z * hv[rr][j].z + hv[rr][j].w * hv[rr][j].w);
                const float rstd = __builtin_amdgcn_rsqf(wave_sum(s) * (1.0f / D) + EPS);
                const int row = 2 * rp + rr;
                u32x2* o8 = (u32x2*)(H + (size_t)(r0 + row) * D) + lane;
                LAS u32x2* t8 = (LAS u32x2*)(tile + row * TRS) + lane;
#pragma unroll
                for (int j = 0; j < 4; ++j) { const f32x4 hh = hv[rr][j] * rstd * hm[j] + ha[j];
                    const u32x2 pk = (u32x2){pg8::cvt_pk_bf16(hh.x, hh.y), pg8::cvt_pk_bf16(hh.z, hh.w)};
                    o8[64 * j] = pk; t8[64 * j] = pk; }
            }
        }
        LDS_WAIT();
        f32x4 acc = (f32x4){0.f, 0.f, 0.f, 0.f};
#pragma unroll 8
        for (int ks = 0; ks < 32; ++ks) {
            const bf16x8 af = *(const LAS bf16x8*)(arow + ks * 64);
            const bf16x8 bfr = *(const bf16x8*)(wlr + ks * 32);
            acc = __builtin_amdgcn_mfma_f32_16x16x32_bf16(af, bfr, acc, 0, 0, 0);
        }
        if (q < 2) {
#pragma unroll
            for (int j = 0; j < 4; ++j) wscr[(q * 4 + j) * 16 + m] = acc[j]; }
        LDS_WAIT();
#pragma unroll 2
        for (int row = 0; row < 8; ++row) {
            f32x4 z = ba4;
#pragma unroll
            for (int n4 = 0; n4 < 4; ++n4) { const f32x4 g = *(const LAS f32x4*)(wscr + row * 16 + n4 * 4);
                z += wa2r[n4 * 4 + 0] * g.x; z += wa2r[n4 * 4 + 1] * g.y; z += wa2r[n4 * 4 + 2] * g.z; z += wa2r[n4 * 4 + 3] * g.w; }
            f32x4 lo;
#pragma unroll
            for (int i = 0; i < 4; ++i) lo[i] = -(fmaxf(-z[i], 0.f) + __logf(1.0f + __expf(-fabsf(z[i])))) * 0.0625f;
            *(u32x2*)(LA + (size_t)(r0 + row) * 256 + lane * 4) = (u32x2){pg8::cvt_pk_bf16(lo[0], lo[1]), pg8::cvt_pk_bf16(lo[2], lo[3])};
        }
        LDS_WAIT();
    }
}

constexpr int MX_KD = 0, MX_QS = 16384, MX_OCT = 33792, MX_ADEC = 37888, MX_OT = 38400, MX_RA = 72192, MX_RV = 89600;
constexpr int MX_QS2 = 107008;
constexpr int MX_RSV = 272;

#define TR_READ(dst, addr, OFF) asm volatile("ds_read_b64_tr_b16 %0, %1 offset:%2" : "=&v"(dst) : "v"(addr), "n"(OFF) : "memory")

template <bool HG, bool FIN>
__device__ __forceinline__ void mixer_unit(const Params& p, LAS unsigned char* lds, int l, int b, int h, int jg) {
    constexpr int DK = HG ? 128 : 64, KT = DK / 16, QSTR = DK + 8, RSA = DK * 2 + 16;
    constexpr int KCOL = HG ? C_HF : C_GK, VCOL = HG ? C_HI : C_GV, QCOL = HG ? C_HQ : C_GQ, ZCOL = HG ? C_HZ : C_GZ;
    constexpr int NOCT = HG ? 2 : 1;
    constexpr int PPR = DK / 8, NQ = (64 * PPR) / NTHREADS;
    int tid_ = threadIdx.x; asm volatile("" : "+v"(tid_));
    const int tid = tid_, lane = tid & 63, w = tid >> 6, n = lane & 15, q = lane >> 4, qq = n >> 2, pp = lane & 3;
    unsigned char* ws = p.ws;
    const bf16* P1 = (const bf16*)(ws + WS_P1);
    const bf16* LA = (const bf16*)(ws + WS_LOGA);
    bf16* OB = (bf16*)(ws + WS_H);
    float* SB = (float*)(ws + (HG ? WS_STATE_HG : WS_STATE)) + (size_t)((b * 4 + h) * NG + jg) * (DK * 128);
    float* PD = (float*)(ws + WS_PDEC) + (size_t)(((HG ? 0 : 8) + b * 4 + h) * NG + jg) * 128;
    LAS unsigned char* KD = lds + MX_KD;
    LAS bf16* QS = (LAS bf16*)(lds + MX_QS);
    LAS float* OCT = (LAS float*)(lds + MX_OCT);
    LAS float* ADEC = (LAS float*)(lds + MX_ADEC);
    LAS float* OT = (LAS float*)(lds + MX_OT);
    LAS unsigned char* RA = lds + MX_RA;
    LAS unsigned char* RV = lds + MX_RV;

    const int c = HG ? (tid & 127) : (tid & 63);
    const int o_first = HG ? (tid >> 7) : (tid >> 6);
    const unsigned tra = (unsigned)(size_t)RA + (unsigned)((o_first * 8 + qq) * RSA + ((c & ~15) + 4 * pp) * 2);
    const unsigned trv = (unsigned)(size_t)RV + (unsigned)((8 * q + qq) * MX_RSV + (16 * w + 4 * pp) * 2);
    float lb = 0.f, lbf = 1e-30f, oml = 1.0f;
    if (HG) { if (l > 0) { const float g0 = p.in[9][h * 128 + c], g1 = p.in[9][512 + h * 128 + c]; lb = 1.0f / (1.0f + __expf(g0 - g1)); lb = fminf(fmaxf(lb, 0.f), 1.0f - 1e-6f); }
        lbf = fmaxf(lb, 1e-30f); oml = 1.0f - lb; }
    float nwv[16];
    if (FIN) { const float* nwp = (HG ? p.in[10] : p.in[8]) + l * 128 + (tid & 7) * 16;
#pragma unroll
        for (int i = 0; i < 16; ++i) nwv[i] = nwp[i]; }

    f32x4 S[KT];
    if (FIN) {
#pragma unroll
        for (int kt = 0; kt < KT; ++kt) S[kt] = *(const f32x4*)(SB + (size_t)((w * KT + kt) * 64 + lane) * 4);
    } else {
#pragma unroll
        for (int kt = 0; kt < KT; ++kt) S[kt] = (f32x4){0.f, 0.f, 0.f, 0.f};
    }
    float pprod = 1.0f;

    const int rowg = b * SEQ + jg * G_CH * 64;
    u32x4 araw[NQ], vraw[2], qraw[NQ], zraw[2]; unsigned short laraw[8];
    const bf16* aptr = P1 + (size_t)rowg * NP1 + KCOL + h * DK;
    const bf16* laptr = LA + (size_t)rowg * 256 + h * 64 + c;
    const bf16* vptr = P1 + (size_t)rowg * NP1 + VCOL + h * 128;
    const bf16* qptr = P1 + (size_t)rowg * NP1 + QCOL + h * DK;
    const bf16* zptr = P1 + (size_t)(rowg + (tid >> 3)) * NP1 + ZCOL + h * 128 + (tid & 7) * 16;
#define MX_LOAD_A(cc_) do { const size_t ro_ = (size_t)(cc_) * 64; \
        _Pragma("unroll") for (int pq = 0; pq < NQ; ++pq) { const int pc = tid + pq * NTHREADS; araw[pq] = *(const u32x4*)(aptr + (ro_ + pc / PPR) * NP1 + (pc % PPR) * 8); } \
        if (!HG) { _Pragma("unroll") for (int i = 0; i < 8; ++i) laraw[i] = laptr[(ro_ + o_first * 8 + i) * 256]; } } while (0)
#define MX_LOAD_V(cc_) do { const size_t ro_ = (size_t)(cc_) * 64; \
        _Pragma("unroll") for (int pq = 0; pq < 2; ++pq) { const int pc = tid + pq * NTHREADS; vraw[pq] = *(const u32x4*)(vptr + (ro_ + pc / 16) * NP1 + (pc % 16) * 8); } } while (0)
#define MX_LOAD_Q(cc_) do { const size_t ro_ = (size_t)(cc_) * 64; \
        _Pragma("unroll") for (int pq = 0; pq < NQ; ++pq) { const int pc = tid + pq * NTHREADS; qraw[pq] = *(const u32x4*)(qptr + (ro_ + pc / PPR) * NP1 + (pc % PPR) * 8); } } while (0)
#define MX_LOAD_Z(cc_) do { const size_t ro_ = (size_t)(cc_) * 64; zraw[0] = *(const u32x4*)(zptr + ro_ * NP1); zraw[1] = *(const u32x4*)(zptr + ro_ * NP1 + 8); } while (0)
    MX_LOAD_A(0); MX_LOAD_V(0);
    if (FIN) { MX_LOAD_Q(0); MX_LOAD_Z(0); }
    float lacur[8];
#define MX_RAW_TO_LDS(qb_) do { \
        _Pragma("unroll") for (int pq = 0; pq < NQ; ++pq) { const int pc = tid + pq * NTHREADS; *(LAS u32x4*)(RA + (pc / PPR) * RSA + (pc % PPR) * 16) = araw[pq]; } \
        _Pragma("unroll") for (int pq = 0; pq < 2; ++pq) { const int pc = tid + pq * NTHREADS; *(LAS u32x4*)(RV + (pc / 16) * MX_RSV + (pc % 16) * 16) = vraw[pq]; } \
        if (FIN) { LAS bf16* qd_ = (LAS bf16*)(lds + ((qb_) ? MX_QS2 : MX_QS)); \
            _Pragma("unroll") for (int pq = 0; pq < NQ; ++pq) { const int pc = tid + pq * NTHREADS; *(LAS u32x4*)(qd_ + (pc / PPR) * QSTR + (pc % PPR) * 8) = qraw[pq]; } } \
        if (!HG) { _Pragma("unroll") for (int i = 0; i < 8; ++i) lacur[i] = bf2f(laraw[i]); } } while (0)
    MX_RAW_TO_LDS(0);
    { const int c1 = (1 < G_CH) ? 1 : 0; MX_LOAD_A(c1); MX_LOAD_V(c1); if (FIN) MX_LOAD_Q(c1); }
    LDS_WAIT(); __syncthreads();

#pragma unroll 1
    for (int cc = 0; cc < G_CH; ++cc) {
        const int ccn = (cc + 1 < G_CH) ? cc + 1 : cc;
        const int cc2 = (cc + 2 < G_CH) ? cc + 2 : G_CH - 1;
        const int row0 = rowg + cc * 64;
        const LAS bf16* QSc = (const LAS bf16*)(lds + ((cc & 1) ? MX_QS2 : MX_QS));
        u32x2 art[NOCT][2], vrt[2][2];
        TR_READ(art[0][0], tra, 0); TR_READ(art[0][1], tra, 4 * RSA);
        if (HG) { TR_READ(art[NOCT - 1][0], tra, 32 * RSA); TR_READ(art[NOCT - 1][1], tra, 36 * RSA); }
        TR_READ(vrt[0][0], trv, 0); TR_READ(vrt[0][1], trv, 4 * MX_RSV); TR_READ(vrt[1][0], trv, 32 * MX_RSV); TR_READ(vrt[1][1], trv, 36 * MX_RSV);
        if (HG) asm volatile("s_waitcnt lgkmcnt(0)" : "+v"(art[0][0]), "+v"(art[0][1]), "+v"(art[NOCT - 1][0]), "+v"(art[NOCT - 1][1]), "+v"(vrt[0][0]), "+v"(vrt[0][1]), "+v"(vrt[1][0]), "+v"(vrt[1][1]) :: "memory");
        else asm volatile("s_waitcnt lgkmcnt(0)" : "+v"(art[0][0]), "+v"(art[0][1]), "+v"(vrt[0][0]), "+v"(vrt[0][1]), "+v"(vrt[1][0]), "+v"(vrt[1][1]) :: "memory");
        float fg[NOCT][8], kv[NOCT][8];
#pragma unroll
        for (int oi = 0; oi < NOCT; ++oi) { const int o = o_first + 4 * oi;
#pragma unroll
            for (int i = 0; i < 8; ++i) { const unsigned wv = (i & 2) ? art[oi][i >> 2].y : art[oi][i >> 2].x; const float x = (i & 1) ? bfhi(wv) : bflo(wv);
                if (HG) { const float zf = fminf(fmaxf(x, -80.f), 80.f);
                    const float e = __expf(-zf), s = __builtin_amdgcn_rcpf(1.0f + e);
                    fg[oi][i] = lbf + oml * s; kv[oi][i] = oml * e * s; }
                else { fg[oi][i] = __expf(lacur[i]); kv[oi][i] = x; } }
            float pr = 1.0f;
#pragma unroll
            for (int i = 0; i < 8; ++i) pr *= fg[oi][i];
            OCT[o * 128 + c] = pr; }
        LDS_WAIT(); __syncthreads();
#pragma unroll
        for (int oi = 0; oi < NOCT; ++oi) { const int o = o_first + 4 * oi;
            float suf = 1.0f;
#pragma unroll
            for (int o2 = 1; o2 < 8; ++o2) { const float t = OCT[o2 * 128 + c]; suf *= (o2 > o) ? t : 1.0f; }
            float kd[8];
#pragma unroll
            for (int i = 7; i >= 0; --i) { kd[i] = kv[oi][i] * suf; suf *= fg[oi][i]; }
            u32x4 pk; pk.x = pg8::cvt_pk_bf16(kd[0], kd[1]); pk.y = pg8::cvt_pk_bf16(kd[2], kd[3]); pk.z = pg8::cvt_pk_bf16(kd[4], kd[5]); pk.w = pg8::cvt_pk_bf16(kd[6], kd[7]);
            *(LAS u32x4*)(KD + (size_t)((((c >> 4) * 2 + (o >> 2)) * 64 + (o & 3) * 16 + (c & 15)) * 16)) = pk;
            if (o == 0) { ADEC[c] = suf; pprod *= suf; } }
        MX_RAW_TO_LDS((cc + 1) & 1);
        MX_LOAD_A(cc2); MX_LOAD_V(cc2);
        if (FIN) MX_LOAD_Q(cc2);
        LDS_WAIT(); __syncthreads();
        union { u32x4 u; bf16x8 v; } vf[2];
        vf[0].u = (u32x4){vrt[0][0].x, vrt[0][0].y, vrt[0][1].x, vrt[0][1].y}; vf[1].u = (u32x4){vrt[1][0].x, vrt[1][0].y, vrt[1][1].x, vrt[1][1].y};
#pragma unroll
        for (int kt = 0; kt < KT; ++kt) { const f32x4 a4 = *(const LAS f32x4*)(ADEC + kt * 16 + q * 4); S[kt] = S[kt] * a4;
#pragma unroll
            for (int ks = 0; ks < 2; ++ks) { const bf16x8 af = *(const LAS bf16x8*)(KD + (size_t)(((kt * 2 + ks) * 64 + lane) * 16));
                S[kt] = __builtin_amdgcn_mfma_f32_16x16x32_bf16(af, vf[ks].v, S[kt], 0, 0, 0); } }
        if (FIN) {
            f32x4 oacc[4];
#pragma unroll
            for (int lt = 0; lt < 4; ++lt) oacc[lt] = (f32x4){0.f, 0.f, 0.f, 0.f};
#pragma unroll
            for (int kk = 0; kk < KT / 2; ++kk) {
                union { u32x4 u; bf16x8 v; } bs;
                bs.u.x = pg8::cvt_pk_bf16(S[2 * kk][0], S[2 * kk][1]); bs.u.y = pg8::cvt_pk_bf16(S[2 * kk][2], S[2 * kk][3]); bs.u.z = pg8::cvt_pk_bf16(S[2 * kk + 1][0], S[2 * kk + 1][1]); bs.u.w = pg8::cvt_pk_bf16(S[2 * kk + 1][2], S[2 * kk + 1][3]);
#pragma unroll
                for (int lt = 0; lt < 4; ++lt) {
                    union { u32x4 u; bf16x8 v; } aq;
                    const u32x2 q0 = *(const LAS u32x2*)(QSc + (lt * 16 + n) * QSTR + (2 * kk) * 16 + q * 4), q1 = *(const LAS u32x2*)(QSc + (lt * 16 + n) * QSTR + (2 * kk + 1) * 16 + q * 4);
                    aq.u = (u32x4){q0.x, q0.y, q1.x, q1.y};
                    oacc[lt] = __builtin_amdgcn_mfma_f32_16x16x32_bf16(aq.v, bs.v, oacc[lt], 0, 0, 0); } }
#pragma unroll
            for (int lt = 0; lt < 4; ++lt)
#pragma unroll
                for (int j = 0; j < 4; ++j) OT[(lt * 16 + q * 4 + j) * 132 + w * 16 + n] = oacc[lt][j];
            LDS_WAIT(); __syncthreads();
            { const int fl = tid >> 3, seg = tid & 7;
                f32x4 ov[4]; float ssq = 0.f;
#pragma unroll
                for (int i = 0; i < 4; ++i) { ov[i] = *(const LAS f32x4*)(OT + fl * 132 + seg * 16 + i * 4); ssq += (ov[i].x * ov[i].x + ov[i].y * ov[i].y) + (ov[i].z * ov[i].z + ov[i].w * ov[i].w); }
                ssq += __shfl_xor(ssq, 1); ssq += __shfl_xor(ssq, 2); ssq += __shfl_xor(ssq, 4);
                const float rstd = __builtin_amdgcn_rsqf(ssq * (1.0f / 128.0f) + EPS);
                const u32x4 zg0 = zraw[0], zg1 = zraw[1];
                MX_LOAD_Z(ccn);
                u32x4 w0, w1;
                w0.x = pg8::cvt_pk_bf16(ov[0].x * rstd * nwv[0] * bflo(zg0.x), ov[0].y * rstd * nwv[1] * bfhi(zg0.x)); w0.y = pg8::cvt_pk_bf16(ov[0].z * rstd * nwv[2] * bflo(zg0.y), ov[0].w * rstd * nwv[3] * bfhi(zg0.y));
                w0.z = pg8::cvt_pk_bf16(ov[1].x * rstd * nwv[4] * bflo(zg0.z), ov[1].y * rstd * nwv[5] * bfhi(zg0.z)); w0.w = pg8::cvt_pk_bf16(ov[1].z * rstd * nwv[6] * bflo(zg0.w), ov[1].w * rstd * nwv[7] * bfhi(zg0.w));
                w1.x = pg8::cvt_pk_bf16(ov[2].x * rstd * nwv[8] * bflo(zg1.x), ov[2].y * rstd * nwv[9] * bfhi(zg1.x)); w1.y = pg8::cvt_pk_bf16(ov[2].z * rstd * nwv[10] * bflo(zg1.y), ov[2].w * rstd * nwv[11] * bfhi(zg1.y));
                w1.z = pg8::cvt_pk_bf16(ov[3].x * rstd * nwv[12] * bflo(zg1.z), ov[3].y * rstd * nwv[13] * bfhi(zg1.z)); w1.w = pg8::cvt_pk_bf16(ov[3].z * rstd * nwv[14] * bflo(zg1.w), ov[3].w * rstd * nwv[15] * bfhi(zg1.w));
                bf16* op = OB + (size_t)(row0 + fl) * D + (HG ? 512 : 0) + h * 128 + seg * 16;
                *(u32x4*)op = w0; *(u32x4*)(op + 8) = w1; }
        }
    }
#undef MX_RAW_TO_LDS
#undef MX_LOAD_A
#undef MX_LOAD_V
#undef MX_LOAD_Q
#undef MX_LOAD_Z
    if (!FIN) {
#pragma unroll
        for (int kt = 0; kt < KT; ++kt) *(f32x4*)(SB + (size_t)((w * KT + kt) * 64 + lane) * 4) = S[kt];
        if (o_first == 0) PD[c] = pprod;
    }
    __syncthreads();
}

template <bool FIN>
__device__ __forceinline__ void phase_mixer(const Params& p, LAS unsigned char* lds, int l) {
    for (int u = blockIdx.x; u < 512; u += gridDim.x) {
        const int rem = u & 255, b = rem >> 7, h = (rem >> 5) & 3, jg = rem & 31;
        if (!FIN && jg == NG - 1) continue;
        if (u < 256) mixer_unit<true, FIN>(p, lds, l, b, h, jg); else mixer_unit<false, FIN>(p, lds, l, b, h, jg);
    }
}

__device__ __forceinline__ void phase_scan(const Params& p) {
    unsigned char* ws = p.ws;
    int tid_ = threadIdx.x; asm volatile("" : "+v"(tid_));
    const int gt = blockIdx.x * NTHREADS + tid_, NT = gridDim.x * NTHREADS;
    for (int tt = gt; tt < 8 * 4096 + 8 * 2048; tt += NT) {
        const bool hg = tt < 32768; const int t2 = hg ? tt : tt - 32768, per = hg ? 4096 : 2048, bh = t2 / per, e = t2 % per, KT = hg ? 8 : 4;
        const int kt = (e >> 6) % KT, lane = e & 63, c4 = kt * 16 + (lane >> 4) * 4;
        float* base = (float*)(ws + (hg ? WS_STATE_HG : WS_STATE)) + (size_t)bh * NG * (per * 4) + (size_t)e * 4;
        const float* pd = (const float*)(ws + WS_PDEC) + (size_t)(((hg ? 0 : 8) + bh) * NG) * 128 + c4;
        f32x4 S = (f32x4){0.f, 0.f, 0.f, 0.f};
        for (int j0 = 0; j0 < NG; j0 += 8) {
            f32x4 Lv[8], Pv[8];
#pragma unroll
            for (int j = 0; j < 8; ++j) { if (j0 + j < NG - 1) { Lv[j] = *(const f32x4*)(base + (size_t)(j0 + j) * (per * 4)); Pv[j] = *(const f32x4*)(pd + (size_t)(j0 + j) * 128); } else { Lv[j] = (f32x4){0.f, 0.f, 0.f, 0.f}; Pv[j] = Lv[j]; } }
#pragma unroll
            for (int j = 0; j < 8; ++j) { *(f32x4*)(base + (size_t)(j0 + j) * (per * 4)) = S; S = Pv[j] * S + Lv[j]; }
        }
    }
}

__device__ __forceinline__ void phase_final_norm(const Params& p) {
    int tid_ = threadIdx.x; asm volatile("" : "+v"(tid_));
    const int tid = tid_, lane = tid & 63, wave = tid >> 6;
    const u32x2* xb = (const u32x2*)(p.ws + WS_H);
    f32x4 nw[4];
#pragma unroll
    for (int j = 0; j < 4; ++j) nw[j] = *(const f32x4*)(p.in[15] + lane * 4 + 256 * j);
    const int gw = blockIdx.x * NWAVES + wave, NGW = gridDim.x * NWAVES;
    u32x2 vn[4];
    if (gw < T) {
#pragma unroll
        for (int j = 0; j < 4; ++j) vn[j] = (xb + (size_t)gw * (D / 4) + lane)[64 * j]; }
#pragma unroll 1
    for (int r = gw; r < T; r += NGW) {
        f32x4* xr = (f32x4*)(p.out + (size_t)r * D) + lane;
        f32x4 v[4]; float s = 0.f;
#pragma unroll
        for (int j = 0; j < 4; ++j) v[j] = (f32x4){bflo(vn[j].x), bfhi(vn[j].x), bflo(vn[j].y), bfhi(vn[j].y)};
        { const int rn = (r + NGW < T) ? r + NGW : r;
#pragma unroll
          for (int j = 0; j < 4; ++j) vn[j] = (xb + (size_t)rn * (D / 4) + lane)[64 * j]; }
#pragma unroll
        for (int j = 0; j < 4; ++j) s += (v[j].x * v[j].x + v[j].y * v[j].y) + (v[j].z * v[j].z + v[j].w * v[j].w);
        const float rstd = __builtin_amdgcn_rsqf(wave_sum(s) * (1.0f / D) + EPS);
#pragma unroll
        for (int j = 0; j < 4; ++j) xr[64 * j] = v[j] * rstd * nw[j];
    }
}

#define XB_TMO      128
#define XB_XCNT(j)  (256  + 64 * (j))
#define XB_XSUB(j)  (1280 + 64 * (j))
#define XB_XGEN(j)  (2304 + 64 * (j))
#define XB_TOP      3328
#define XB_TOPGEN   3392
#define XCD_BAR_WORDS 3456
#define XB_SPIN_CAP (1u << 18)

__device__ __forceinline__ unsigned xb_ld(unsigned* p)              { return __hip_atomic_load(p, __ATOMIC_RELAXED, __HIP_MEMORY_SCOPE_AGENT); }
__device__ __forceinline__ unsigned xb_add(unsigned* p, unsigned v) { return __hip_atomic_fetch_add(p, v, __ATOMIC_RELAXED, __HIP_MEMORY_SCOPE_AGENT); }
__device__ __forceinline__ unsigned xb_xcc_id() { return (unsigned)__builtin_amdgcn_s_getreg((3 << 11) | 20) & 0xFu; }
#define XB_SPIN(cond, bar) do { unsigned _sp = 0; while (cond) { __builtin_amdgcn_s_sleep(1); \
    if ((++_sp & 255u) == 0u) { if (xb_ld(&(bar)[XB_TMO])) break; if (_sp > XB_SPIN_CAP) { atomicAdd(&(bar)[XB_TMO], 1u); break; } } } } while (0)

struct XcdBarrier {
    unsigned* bar; unsigned x;
    volatile LAS unsigned* st;
};

__device__ __forceinline__ XcdBarrier xcd_barrier_post(unsigned* bar, volatile LAS unsigned* st) {
    XcdBarrier b; b.bar = bar; b.x = xb_xcc_id(); b.st = st;
    if (threadIdx.x == 0) (void)xb_add(&bar[XB_XCNT(b.x)], 1u);
    return b;
}
__device__ __forceinline__ void xcd_barrier_complete(unsigned* bar, unsigned x, unsigned& nloc, unsigned& nx) {
    const unsigned G = gridDim.x * gridDim.y * gridDim.z;
    unsigned sum, cnt, mine, sp = 0u;
    for (;;) {
        sum = 0u; cnt = 0u; mine = 0u;
#pragma unroll
        for (unsigned j = 0; j < 16; ++j) { const unsigned c = xb_ld(&bar[XB_XCNT(j)]); sum += c; cnt += (c > 0u) ? 1u : 0u; mine = (j == x) ? c : mine; }
        if (sum == G) break;
        __builtin_amdgcn_s_sleep(1);
        if ((++sp & 255u) == 0u) { if (xb_ld(&bar[XB_TMO])) break; if (sp > XB_SPIN_CAP) { atomicAdd(&bar[XB_TMO], 1u); break; } }
    }
    nloc = mine > 0u ? mine : 1u; nx = cnt > 0u ? cnt : 1u;
}

__device__ __forceinline__ void xcd_barrier(const XcdBarrier& b) {
    asm volatile("s_waitcnt vmcnt(0)" ::: "memory");
    __syncthreads();
    if (threadIdx.x == 0) {
        unsigned* bar = b.bar;
        __builtin_amdgcn_s_waitcnt(0);
        unsigned nloc = b.st[0], nx = b.st[1];
        if (nloc == 0u) { xcd_barrier_complete(bar, b.x, nloc, nx); b.st[0] = nloc; b.st[1] = nx; }
        const unsigned old = xb_add(&bar[XB_XSUB(b.x)], 1u);
        const unsigned gen = old / nloc;
        if (old + 1u == (gen + 1u) * nloc) {
            __builtin_amdgcn_fence(__ATOMIC_RELEASE, "agent");
            asm volatile("s_waitcnt vmcnt(0)" ::: "memory");
            const unsigned og = xb_add(&bar[XB_TOP], 1u);
            const unsigned tg = og / nx;
            if (og + 1u == (tg + 1u) * nx) xb_add(&bar[XB_TOPGEN], 1u);
            else XB_SPIN(xb_ld(&bar[XB_TOPGEN]) == tg, bar);
            __builtin_amdgcn_fence(__ATOMIC_ACQUIRE, "agent");
            xb_add(&bar[XB_XGEN(b.x)], 1u);
            asm volatile("s_waitcnt vmcnt(0)" ::: "memory");
        } else {
            XB_SPIN(xb_ld(&bar[XB_XGEN(b.x)]) == gen, bar);
            __builtin_amdgcn_fence(__ATOMIC_ACQUIRE, "agent");
            asm volatile("s_waitcnt vmcnt(0)" ::: "memory");
        }
    }
    __syncthreads();
}


__global__ void __launch_bounds__(NTHREADS, 2) mega_fwd(Params p) {
    extern __shared__ __attribute__((aligned(16))) unsigned char lds_raw[];
    LAS unsigned char* lds = (LAS unsigned char*)lds_raw;
    cg::grid_group grid = cg::this_grid();
    unsigned char* ws = p.ws;
    unsigned* barw = (unsigned*)(ws + WS_BAR);
    volatile LAS unsigned* bst = (volatile LAS unsigned*)(lds + LDS_BYTES - 64);
    if (threadIdx.x < 2) bst[threadIdx.x] = 0u;
    if (blockIdx.x == 0) for (int i = threadIdx.x; i < XCD_BAR_WORDS; i += NTHREADS) barw[i] = 0u;
    phase_prologue(p, lds);
    grid.sync();
    const XcdBarrier xb = xcd_barrier_post(barw, bst);
#pragma unroll 1
    for (int l_ = 0; l_ < DEPTH; ++l_) {
        int l = l_; asm volatile("" : "+s"(l));
        if (l == 0) phase_norm<false>(p, lds, l, p.in[0]); else phase_norm<true>(p, lds, l, p.out);
        xcd_barrier(xb);
        {
            pg8::Gemm g{(const pg8::bf16_t*)(ws + WS_H), (const pg8::bf16_t*)(ws + WS_WIN) + (size_t)l * NP * D, T, NP, D};
            pg8::StaticOrder S; S.init(T, NP, (int)gridDim.x, (int)blockIdx.x);
            pg8::EpiIn E{(pg8::bf16_t*)(ws + WS_P1), (pg8::bf16_t*)(ws + WS_PG), p.in[11] + l * 2048};
            pg8::gemm_phase<pg8::EpiIn, pg8::StaticOrder, true, true>(lds, g, S, E);
        }
        xcd_barrier(xb);
        phase_mixer<false>(p, lds, l);
        xcd_barrier(xb);
        phase_scan(p);
        xcd_barrier(xb);
        phase_mixer<true>(p, lds, l);
        xcd_barrier(xb);
        {
            pg8::Gemm g{(const pg8::bf16_t*)(ws + WS_H), (const pg8::bf16_t*)(ws + WS_WUP) + (size_t)l * D * D, T, D, D};
            pg8::StaticOrder S; S.init(T, D, (int)gridDim.x, (int)blockIdx.x);
            pg8::EpiUp E{(const pg8::bf16_t*)(ws + WS_PG), (pg8::bf16_t*)(ws + WS_P1)};
            pg8::gemm_phase<pg8::EpiUp, pg8::StaticOrder, true, true>(lds, g, S, E);
        }
        xcd_barrier(xb);
        {
            pg8::Gemm g{(const pg8::bf16_t*)(ws + WS_P1), (const pg8::bf16_t*)(ws + WS_WOUT) + (size_t)l * D * D, T, D, D};
            pg8::StaticOrder S; S.init(T, D, (int)gridDim.x, (int)blockIdx.x);
            const float* gate2 = (const float*)(ws + WS_MOD) + (size_t)l * BATCH * 3072 + 2048;
            if (l == 0) { pg8::EpiOut<false> E{(const void*)p.in[0], (pg8::bf16_t*)p.out, gate2}; pg8::gemm_phase<pg8::EpiOut<false>, pg8::StaticOrder, true, true>(lds, g, S, E); }
            else { pg8::EpiOut<true> E{(const void*)p.out, (pg8::bf16_t*)(ws + WS_H), gate2}; pg8::gemm_phase<pg8::EpiOut<true>, pg8::StaticOrder, true, true>(lds, g, S, E); }
        }
        xcd_barrier(xb);
    }
    phase_final_norm(p);
}

extern "C" void kernel_launch(void* const* d_in, const int* in_sizes, int n_in, void* d_out, int out_size, void* d_ws, size_t ws_size, hipStream_t stream) {
    static int grid = 0;
    if (grid == 0) {
        if (n_in != 16 || in_sizes[0] != T * D || out_size != T * D || ws_size < WS_END) { fprintf(stderr, "kernel_launch: unexpected shapes (n_in %d, in0 %d, out %d, ws %zu)\n", n_in, n_in > 0 ? in_sizes[0] : -1, out_size, ws_size); grid = -1; return; }
        int dev = 0, cus = 0, per_cu = 0;
        if (hipGetDevice(&dev) != hipSuccess || hipDeviceGetAttribute(&cus, hipDeviceAttributeMultiprocessorCount, dev) != hipSuccess) { fprintf(stderr, "kernel_launch: device query failed\n"); grid = -1; return; }
        if (hipFuncSetAttribute((const void*)mega_fwd, hipFuncAttributeMaxDynamicSharedMemorySize, LDS_BYTES) != hipSuccess) { fprintf(stderr, "kernel_launch: hipFuncSetAttribute failed\n"); grid = -1; return; }
        if (hipOccupancyMaxActiveBlocksPerMultiprocessor(&per_cu, (const void*)mega_fwd, NTHREADS, LDS_BYTES) != hipSuccess || per_cu < 1) { fprintf(stderr, "kernel_launch: occupancy query failed (%d)\n", per_cu); (void)hipGetLastError(); per_cu = 1; }
        grid = cus * per_cu;
    }
    if (grid < 0) return;
    Params p{};
    for (int i = 0; i < 16; ++i) p.in[i] = (const float*)d_in[i];
    p.out = (float*)d_out; p.ws = (unsigned char*)d_ws;
    void* args[] = {&p};
    const hipError_t e = hipLaunchCooperativeKernel((const void*)mega_fwd, dim3(grid), dim3(NTHREADS), args, LDS_BYTES, stream);
    if (e != hipSuccess) fprintf(stderr, "kernel_launch: cooperative launch failed: %s (grid %d)\n", hipGetErrorString(e), grid);
}
```

```cpp
#include <hip/hip_runtime.h>
#include <hip/hip_cooperative_groups.h>
#include <cstdio>
#include <cstdint>
namespace cg = cooperative_groups;
namespace pg8 {
#define PG8_LAS __attribute__((address_space(3)))
typedef unsigned short bf16_t;
typedef short bf16x8 __attribute__((ext_vector_type(8)));
typedef float f32x4 __attribute__((ext_vector_type(4)));
typedef unsigned u32x4 __attribute__((ext_vector_type(4)));
constexpr int BM = 256, BK = 64, HALF = 128, HTB = HALF * BK * 2  , STAGE_BYTES = 8 * HTB, NXCD = 8, WGM = 8;

__host__ __device__ __forceinline__ int lds_byte(int r, int c) { const int st = (r >> 4) * 2 + (c >> 5), rr = r & 15, cc = c & 31, ob = rr * 64 + cc * 2; return st * 1024 + (ob ^ (((ob >> 9) & 1) << 5)); }
__host__ __device__ __forceinline__ void stage_rc(int b, int& R, int& C) { const int st = b / 1024, sb = b % 1024, swz = sb ^ (((sb >> 9) & 1) << 5); R = (st >> 1) * 16 + swz / 64; C = (st & 1) * 32 + (swz % 64) / 2; }
__host__ __device__ __forceinline__ int perm32(int rho) { const int n = rho >> 4, i = rho & 15; return 8 * (i >> 2) + 4 * n + (i & 3); }

struct Unit { int pm, pn; };
struct Gemm { const bf16_t* A; const bf16_t* Bt; int M, N, K; };

struct StaticOrder {
    int nM, nN, nwg, G, c;
    __host__ __device__ void init(int M, int N, int G_, int c_) { nM = M / BM; nN = N / BM; nwg = nM * nN; G = G_; c = c_; }
    __host__ __device__ bool next(int i, Unit& u) const {
        const long L = (long)i * G + c; if (L >= nwg) return false;
        int wgid = (int)L; { const int q = nwg / NXCD, r = nwg % NXCD, xcd = wgid % NXCD, off = wgid / NXCD; wgid = (xcd < r ? xcd * (q + 1) : r * (q + 1) + (xcd - r) * q) + off; }
        const int nig = WGM * nN, gid = wgid / nig, fm = gid * WGM, gsz = (nM - fm) < WGM ? (nM - fm) : WGM;
        u.pm = fm + ((wgid % nig) % gsz); u.pn = (wgid % nig) / gsz; return true;
    }
    __device__ __forceinline__ void a_ready(const Unit&) const {}
    __device__ __forceinline__ void done(const Unit&) const {}
};
__device__ __forceinline__ unsigned cvt_pk_bf16(float lo, float hi) { unsigned r; asm volatile("v_cvt_pk_bf16_f32 %0, %1, %2" : "=v"(r) : "v"(lo), "v"(hi)); return r; }
template <class Epi, class Sched, bool ALIGN_EPI = false, bool SP2 = false>
__device__ __forceinline__ void gemm_phase(PG8_LAS unsigned char* lds, const Gemm g, const Sched& S, const Epi& E) {
    int tid_ = threadIdx.x; asm volatile("" : "+v"(tid_));
    const int tid = tid_, wid = __builtin_amdgcn_readfirstlane(tid >> 6), lane = tid & 63, wr = wid >> 2, wc = wid & 3, fr = lane & 15, fq = lane >> 4;
    const int K = g.K, nt = K / BK;
    unsigned voffA[2], voffB[2];
#pragma unroll
    for (int i = 0; i < 2; ++i) { int R, C; stage_rc(tid * 16 + i * 8192, R, C); const int Rb = Epi::PERM ? ((R & ~31) + perm32(R & 31)) : R;
        voffA[i] = (unsigned)(R * K + C) * 2u; voffB[i] = (unsigned)(Rb * K + C) * 2u; }
    const size_t kstep = (size_t)(BK * 2);
    const size_t hstep = (size_t)HALF * K * 2;
    const size_t tstep = 2 * hstep;
    const unsigned ldsw = (unsigned)wid * 1024u;
    const int aoff = lds_byte(wr * 64 + fr, fq * 8), boff = lds_byte(wc * 32 + fr, fq * 8);
#define PG8_SA(b, h) (((b) * 2 + (h)) * HTB)
#define PG8_SB(b, h) ((4 + (b) * 2 + (h)) * HTB)
#define PG8_STAGE(bufoff, gbase, voff) do { _Pragma("unroll") for (int _i = 0; _i < 2; ++_i) \
        __builtin_amdgcn_global_load_lds((const unsigned*)((const char*)(gbase) + (voff)[_i]), (PG8_LAS unsigned*)(lds + (bufoff) + ldsw + _i * 8192), 16, 0, 0); } while (0)
#define PG8_LDA(dst, b, h) do { _Pragma("unroll") for (int m = 0; m < 4; ++m) _Pragma("unroll") for (int k = 0; k < 2; ++k) dst[m][k] = *(const PG8_LAS bf16x8*)(lds + PG8_SA(b, h) + aoff + m * 2048 + k * 1024); } while (0)
#define PG8_LDB(dst, b, h) do { _Pragma("unroll") for (int n = 0; n < 2; ++n) _Pragma("unroll") for (int k = 0; k < 2; ++k) dst[n][k] = *(const PG8_LAS bf16x8*)(lds + PG8_SB(b, h) + boff + n * 2048 + k * 1024); } while (0)
#define PG8_MMA(ai, bj, At, Bt) do { __builtin_amdgcn_s_setprio(1); _Pragma("unroll") for (int m = 0; m < 4; ++m) _Pragma("unroll") for (int n = 0; n < 2; ++n) _Pragma("unroll") for (int k = 0; k < 2; ++k) \
        acc[ai][bj][m][n] = __builtin_amdgcn_mfma_f32_16x16x32_bf16(Bt[n][k], At[m][k], acc[ai][bj][m][n], 0, 0, 0); __builtin_amdgcn_s_setprio(0); } while (0)
#define PG8_WAIT_V(n) asm volatile("s_waitcnt vmcnt(" #n ")" ::: "memory")
#define PG8_WAIT_L(n) asm volatile("s_waitcnt lgkmcnt(" #n ")" ::: "memory")
#define PG8_BAR __builtin_amdgcn_s_barrier()
#define PG8_SCHED __builtin_amdgcn_sched_barrier(0)
    Unit cur, nxt; int ui = 0;
    if (!S.next(0, cur)) return;
    f32x4 acc[2][2][4][2];
#pragma unroll
    for (int a = 0; a < 2; ++a)
#pragma unroll
        for (int b = 0; b < 2; ++b)
#pragma unroll
            for (int m = 0; m < 4; ++m)
#pragma unroll
                for (int n = 0; n < 2; ++n) acc[a][b][m][n] = (f32x4){0.f, 0.f, 0.f, 0.f};
    bf16x8 At[4][2], B0[2][2], B1[2][2];
    const char* cA = (const char*)g.A + (size_t)cur.pm * tstep; const char* cB = (const char*)g.Bt + (size_t)cur.pn * tstep;
    S.a_ready(cur);
    if constexpr (SP2) {
        PG8_STAGE(PG8_SB(0, 0), cB, voffB); PG8_STAGE(PG8_SB(0, 1), cB + hstep, voffB); PG8_STAGE(PG8_SA(0, 0), cA, voffA); PG8_STAGE(PG8_SA(0, 1), cA + hstep, voffA);
        if (wr == 1) PG8_BAR;
        PG8_WAIT_V(2); PG8_BAR;
        PG8_STAGE(PG8_SB(1, 0), cB + kstep, voffB); PG8_STAGE(PG8_SA(1, 0), cA + kstep, voffA); PG8_STAGE(PG8_SB(1, 1), cB + hstep + kstep, voffB);
        PG8_WAIT_V(6); PG8_BAR;
    } else {
        PG8_STAGE(PG8_SB(0, 0), cB, voffB); PG8_STAGE(PG8_SA(0, 0), cA, voffA); PG8_STAGE(PG8_SB(0, 1), cB + hstep, voffB); PG8_STAGE(PG8_SA(0, 1), cA + hstep, voffA);
        if (wr == 1) PG8_BAR;
        PG8_WAIT_V(4); PG8_BAR;
        PG8_STAGE(PG8_SB(1, 0), cB + kstep, voffB); PG8_STAGE(PG8_SA(1, 0), cA + kstep, voffA); PG8_STAGE(PG8_SB(1, 1), cB + hstep + kstep, voffB);
        PG8_WAIT_V(6); PG8_BAR;
    }
    for (;;) {
        const bool has_next = S.next(ui + 1, nxt);
        const char* nA = has_next ? (const char*)g.A + (size_t)nxt.pm * tstep : cA; const char* nB = has_next ? (const char*)g.Bt + (size_t)nxt.pn * tstep : cB;
        for (int t = 0; t < nt; t += 2) {
            const bool last = (t == nt - 2);
            const char* a1 = cA + (size_t)(t + 1) * kstep;
            const char* a2 = last ? nA : cA + (size_t)(t + 2) * kstep; const char* b2 = last ? nB : cB + (size_t)(t + 2) * kstep;
            const char* a3 = a2 + kstep; const char* b3 = b2 + kstep;
            if (last && has_next) S.a_ready(nxt);
            if constexpr (Epi::MID) { if (t == nt / 2) E.mid(acc, cur, wr, wc, fr, fq); }
            if constexpr (SP2) {
            PG8_LDB(B0, 0, 0); PG8_LDB(B1, 0, 1); PG8_SCHED; PG8_LDA(At, 0, 0); PG8_STAGE(PG8_SA(1, 1), a1 + hstep, voffA);
            PG8_WAIT_V(8); PG8_WAIT_L(0); PG8_BAR; PG8_MMA(0, 0, At, B0); PG8_MMA(0, 1, At, B1); PG8_BAR; PG8_SCHED;
            PG8_LDA(At, 0, 1); PG8_STAGE(PG8_SB(0, 0), b2, voffB); PG8_STAGE(PG8_SB(0, 1), b2 + hstep, voffB); PG8_STAGE(PG8_SA(0, 0), a2, voffA);
            PG8_WAIT_V(8); PG8_WAIT_L(0); PG8_BAR; PG8_MMA(1, 0, At, B0); PG8_MMA(1, 1, At, B1); PG8_BAR; PG8_SCHED;
            PG8_LDB(B0, 1, 0); PG8_LDB(B1, 1, 1); PG8_SCHED; PG8_LDA(At, 1, 0); PG8_STAGE(PG8_SA(0, 1), a2 + hstep, voffA);
            PG8_WAIT_V(8); PG8_WAIT_L(0); PG8_BAR; PG8_MMA(0, 0, At, B0); PG8_MMA(0, 1, At, B1); PG8_BAR; PG8_SCHED;
            PG8_LDA(At, 1, 1); PG8_STAGE(PG8_SB(1, 0), b3, voffB); PG8_STAGE(PG8_SB(1, 1), b3 + hstep, voffB); PG8_STAGE(PG8_SA(1, 0), a3, voffA);
            PG8_WAIT_V(8); PG8_WAIT_L(0); PG8_BAR; PG8_MMA(1, 0, At, B0); PG8_MMA(1, 1, At, B1); PG8_BAR; PG8_SCHED;
            } else {
            PG8_LDB(B0, 0, 0); PG8_SCHED; PG8_LDA(At, 0, 0); PG8_STAGE(PG8_SA(1, 1), a1 + hstep, voffA);
            PG8_WAIT_L(8); PG8_BAR; PG8_WAIT_L(0); PG8_MMA(0, 0, At, B0); PG8_BAR; PG8_SCHED;
            PG8_LDB(B1, 0, 1); PG8_STAGE(PG8_SB(0, 0), b2, voffB);
            PG8_BAR; PG8_WAIT_L(0); PG8_MMA(0, 1, At, B1); PG8_BAR;
            PG8_LDA(At, 0, 1); PG8_STAGE(PG8_SA(0, 0), a2, voffA);
            PG8_BAR; PG8_WAIT_L(0); PG8_MMA(1, 0, At, B0); PG8_BAR; PG8_SCHED;
            PG8_STAGE(PG8_SB(0, 1), b2 + hstep, voffB);
            PG8_WAIT_V(6); PG8_BAR; PG8_MMA(1, 1, At, B1); PG8_BAR;
            PG8_LDB(B0, 1, 0); PG8_SCHED; PG8_LDA(At, 1, 0); PG8_STAGE(PG8_SA(0, 1), a2 + hstep, voffA);
            PG8_WAIT_L(8); PG8_BAR; PG8_WAIT_L(0); PG8_MMA(0, 0, At, B0); PG8_BAR; PG8_SCHED;
            PG8_LDB(B1, 1, 1); PG8_STAGE(PG8_SB(1, 0), b3, voffB);
            PG8_BAR; PG8_WAIT_L(0); PG8_MMA(0, 1, At, B1); PG8_BAR;
            PG8_LDA(At, 1, 1); PG8_STAGE(PG8_SA(1, 0), a3, voffA);
            PG8_BAR; PG8_WAIT_L(0); PG8_MMA(1, 0, At, B0); PG8_BAR; PG8_SCHED;
            PG8_STAGE(PG8_SB(1, 1), b3 + hstep, voffB);
            PG8_WAIT_V(6); PG8_BAR; PG8_MMA(1, 1, At, B1); PG8_BAR;
            }
        }
        if constexpr (ALIGN_EPI) { if (wr == 0) PG8_BAR; }
        if constexpr (!Epi::AFTER_DRAIN) { E(acc, cur, wr, wc, fr, fq); S.done(cur); }
        if (!has_next) break;
#pragma unroll
        for (int a = 0; a < 2; ++a)
#pragma unroll
            for (int b = 0; b < 2; ++b)
#pragma unroll
                for (int m = 0; m < 4; ++m)
#pragma unroll
                    for (int n = 0; n < 2; ++n) acc[a][b][m][n] = (f32x4){0.f, 0.f, 0.f, 0.f};
        cur = nxt; cA = nA; cB = nB; ++ui;
        if constexpr (ALIGN_EPI) { if (wr == 1) PG8_BAR; }
    }
    PG8_WAIT_V(0);
    if constexpr (!ALIGN_EPI) { if (wr == 0) PG8_BAR; }
    PG8_BAR;
    if constexpr (Epi::AFTER_DRAIN) { E.fused(acc, cur, wr, wc, fr, fq, lds, wid, lane); S.done(cur); }
#undef PG8_SA
#undef PG8_SB
#undef PG8_STAGE
#undef PG8_LDA
#undef PG8_LDB
#undef PG8_MMA
#undef PG8_WAIT_V
#undef PG8_WAIT_L
#undef PG8_BAR
#undef PG8_SCHED
}
}

#define LAS __attribute__((address_space(3)))
typedef unsigned short bf16;
typedef float f32x4 __attribute__((ext_vector_type(4)));
typedef short bf16x8 __attribute__((ext_vector_type(8)));
typedef unsigned u32x4 __attribute__((ext_vector_type(4)));
typedef unsigned u32x2 __attribute__((ext_vector_type(2)));

constexpr int D = 1024, BATCH = 2, SEQ = 16384, T = BATCH * SEQ, DEPTH = 2;
constexpr int IN_TOTAL = 5648, NP = 5632, NP1 = 3584, NPG = 2048;
constexpr int G_CH = 8;
constexpr int NCHUNK = SEQ / 64;
constexpr int NG = NCHUNK / G_CH;
constexpr int NTHREADS = 512, NWAVES = 8;
constexpr int LDS_BYTES = 147456;
constexpr float EPS = 1e-6f;

constexpr int C_GQ = 0, C_GK = 256, C_GV = 512, C_GZ = 1024, C_HQ = 1536, C_HF = 2048, C_HI = 2560, C_HZ = 3072;

constexpr size_t MiB = 1u << 20;
constexpr size_t WS_MOD = 0;
constexpr size_t WS_BAR = 512 * 1024;
constexpr size_t WS_WIN = 1 * MiB;
constexpr size_t WS_WUP = 23 * MiB;
constexpr size_t WS_WOUT = 27 * MiB;
constexpr size_t WS_STATE = 32 * MiB;
constexpr size_t WS_STATE_HG = WS_STATE + 8 * MiB;
constexpr size_t WS_PDEC = 56 * MiB;
constexpr size_t WS_WLR = 57 * MiB;
constexpr size_t WS_LOGA = 64 * MiB;
constexpr size_t WS_H = 96 * MiB;
constexpr size_t WS_P1 = 160 * MiB;
constexpr size_t WS_PG = 384 * MiB;
constexpr size_t WS_END = 512 * MiB;

struct Params { const float* in[16]; float* out; unsigned char* ws; };

__device__ __forceinline__ float bf2f(unsigned short b) { return __builtin_bit_cast(float, (unsigned)b << 16); }
__device__ __forceinline__ float bflo(unsigned w) { return __builtin_bit_cast(float, w << 16); }
__device__ __forceinline__ float bfhi(unsigned w) { return __builtin_bit_cast(float, w & 0xffff0000u); }
__device__ __forceinline__ unsigned f2bf(float f) { unsigned u = __builtin_bit_cast(unsigned, f); return (u + 0x7fffu + ((u >> 16) & 1u)) >> 16; }
__device__ __forceinline__ unsigned pk2(float lo, float hi) { return f2bf(lo) | (f2bf(hi) << 16); }
__device__ __forceinline__ float sigmoidf_(float x) { return 1.0f / (1.0f + __expf(-x)); }
__device__ __forceinline__ float wave_sum(float v) {
#pragma unroll
    for (int o = 1; o < 64; o <<= 1) v += __shfl_xor(v, o);
    return v;
}
#define LDS_WAIT() asm volatile("s_waitcnt lgkmcnt(0)" ::: "memory")

namespace pg8 {
struct EpiIn {
    static constexpr bool PERM = true, AFTER_DRAIN = false, MID = false;
    bf16_t* P1; bf16_t* PG; const float* bias;
    __device__ __forceinline__ void operator()(const f32x4 (&acc)[2][2][4][2], const Unit& u, int wr, int wc, int fr, int fq) const {
        const int pn = u.pn;
        const int row0 = u.pm * BM + wr * 64 + fr;
        if (pn >= 14) {
            const int ch0 = (pn - 14) * 128 + wc * 32 + 8 * fq;
            f32x4 ba[2], bb[2];
#pragma unroll
            for (int n = 0; n < 2; ++n) { ba[n] = *(const f32x4*)(bias + ch0 + 4 * n); bb[n] = *(const f32x4*)(bias + 1024 + ch0 + 4 * n); }
#pragma unroll
            for (int ai = 0; ai < 2; ++ai)
#pragma unroll
                for (int m = 0; m < 4; ++m) { bf16_t* rowp = PG + (size_t)(row0 + ai * HALF + m * 16) * NPG + ch0;
                    f32x4 r[2], g[2];
#pragma unroll
                    for (int n = 0; n < 2; ++n) { const f32x4 a = acc[ai][0][m][n] + ba[n], b = acc[ai][1][m][n] + bb[n];
#pragma unroll
                        for (int j = 0; j < 4; ++j) { const float ea = __expf(-a[j]), eb = __expf(-b[j]); g[n][j] = __builtin_amdgcn_rcpf(1.0f + eb); r[n][j] = (1.0f + eb) * __builtin_amdgcn_rcpf(1.0f + ea); } }
                    u32x4 w; w.x = cvt_pk_bf16(r[0][0], r[0][1]); w.y = cvt_pk_bf16(r[0][2], r[0][3]); w.z = cvt_pk_bf16(r[1][0], r[1][1]); w.w = cvt_pk_bf16(r[1][2], r[1][3]);
                    *(u32x4*)rowp = w;
                    w.x = cvt_pk_bf16(g[0][0], g[0][1]); w.y = cvt_pk_bf16(g[0][2], g[0][3]); w.z = cvt_pk_bf16(g[1][0], g[1][1]); w.w = cvt_pk_bf16(g[1][2], g[1][3]);
                    *(u32x4*)(rowp + 1024) = w; }
            return;
        }
        int mode = 0; float scl = 1.0f;
        if (pn == 0) scl = 0.125f;
        else if (pn == 4 || pn == 5 || pn == 12 || pn == 13) mode = 1;
        else if (pn == 6 || pn == 7) { mode = 1; scl = 0.08838834764831845f; }
        const int col0 = pn * 256 + wc * 32 + 8 * fq;
#pragma unroll
        for (int ai = 0; ai < 2; ++ai)
#pragma unroll
            for (int m = 0; m < 4; ++m) { bf16_t* rowp = P1 + (size_t)(row0 + ai * HALF + m * 16) * NP1 + col0;
#pragma unroll
                for (int bj = 0; bj < 2; ++bj) { f32x4 v0 = acc[ai][bj][m][0], v1 = acc[ai][bj][m][1];
                    if (mode == 0) { v0 = v0 * scl; v1 = v1 * scl; }
                    else {
#pragma unroll
                        for (int j = 0; j < 4; ++j) { v0[j] = v0[j] * scl * __builtin_amdgcn_rcpf(1.0f + __expf(-v0[j])); v1[j] = v1[j] * scl * __builtin_amdgcn_rcpf(1.0f + __expf(-v1[j])); } }
                    u32x4 w; w.x = cvt_pk_bf16(v0[0], v0[1]); w.y = cvt_pk_bf16(v0[2], v0[3]); w.z = cvt_pk_bf16(v1[0], v1[1]); w.w = cvt_pk_bf16(v1[2], v1[3]);
                    *(u32x4*)(rowp + bj * HALF) = w; } }
    }
};
struct EpiUp {
    static constexpr bool PERM = true, AFTER_DRAIN = false, MID = true;
    const bf16_t* PG; bf16_t* Mo;
    __device__ __forceinline__ void mid(f32x4 (&acc)[2][2][4][2], const Unit& u, int wr, int wc, int fr_, int fq) const {
        int fr = fr_; asm volatile("" : "+v"(fr));
        const int row0 = u.pm * BM + wr * 64 + fr, col0 = u.pn * BM + wc * 32 + 8 * fq;
#pragma unroll
        for (int ai = 0; ai < 2; ++ai) {
            u32x4 rv[4][2];
#pragma unroll
            for (int m = 0; m < 4; ++m) { const bf16_t* gp = PG + (size_t)(row0 + ai * HALF + m * 16) * NPG + col0;
#pragma unroll
                for (int bj = 0; bj < 2; ++bj) rv[m][bj] = *(const u32x4*)(gp + bj * HALF); }
#pragma unroll
            for (int m = 0; m < 4; ++m)
#pragma unroll
                for (int bj = 0; bj < 2; ++bj) { const u32x4 ga = rv[m][bj];
                    acc[ai][bj][m][0] = acc[ai][bj][m][0] * (f32x4){bflo(ga.x), bfhi(ga.x), bflo(ga.y), bfhi(ga.y)};
                    acc[ai][bj][m][1] = acc[ai][bj][m][1] * (f32x4){bflo(ga.z), bfhi(ga.z), bflo(ga.w), bfhi(ga.w)}; }
            __builtin_amdgcn_sched_barrier(0);
        }
    }
    __device__ __forceinline__ void operator()(const f32x4 (&acc)[2][2][4][2], const Unit& u, int wr, int wc, int fr, int fq) const {
        const int row0 = u.pm * BM + wr * 64 + fr, col0 = u.pn * BM + wc * 32 + 8 * fq;
#pragma unroll
        for (int ai = 0; ai < 2; ++ai)
#pragma unroll
            for (int m = 0; m < 4; ++m) { const size_t row = (size_t)(row0 + ai * HALF + m * 16); const bf16_t* gp = PG + row * NPG + 1024 + col0; bf16_t* op = Mo + row * D + col0;
#pragma unroll
                for (int bj = 0; bj < 2; ++bj) { const u32x4 gb = *(const u32x4*)(gp + bj * HALF);
                    const f32x4 a0 = acc[ai][bj][m][0], a1 = acc[ai][bj][m][1];
                    u32x4 w; w.x = cvt_pk_bf16(a0[0] * bflo(gb.x), a0[1] * bfhi(gb.x)); w.y = cvt_pk_bf16(a0[2] * bflo(gb.y), a0[3] * bfhi(gb.y));
                    w.z = cvt_pk_bf16(a1[0] * bflo(gb.z), a1[1] * bfhi(gb.z)); w.w = cvt_pk_bf16(a1[2] * bflo(gb.w), a1[3] * bfhi(gb.w));
                    *(u32x4*)(op + bj * HALF) = w; } }
    }
};
template <bool XBF> struct EpiOut {
    static constexpr bool PERM = true, AFTER_DRAIN = false, MID = false;
    const void* xin; bf16_t* out; const float* gate2;
    __device__ __forceinline__ void operator()(const f32x4 (&acc)[2][2][4][2], const Unit& u, int wr, int wc, int fr, int fq) const {
        const int row0 = u.pm * BM + wr * 64 + fr, col0 = u.pn * BM + wc * 32 + 8 * fq;
        const float* gate = gate2 + ((u.pm * BM) / SEQ) * 3072;
        f32x4 gv[2][2];
#pragma unroll
        for (int bj = 0; bj < 2; ++bj)
#pragma unroll
            for (int n = 0; n < 2; ++n) gv[bj][n] = *(const f32x4*)(gate + col0 + bj * HALF + 4 * n);
#pragma unroll
        for (int ai = 0; ai < 2; ++ai)
#pragma unroll
            for (int m = 0; m < 4; ++m) { const size_t off = (size_t)(row0 + ai * HALF + m * 16) * D + col0;
#pragma unroll
                for (int bj = 0; bj < 2; ++bj) { f32x4 x0, x1;
                    if (XBF) { const u32x4 xb = *(const u32x4*)((const bf16_t*)xin + off + bj * HALF);
                        x0 = (f32x4){__builtin_bit_cast(float, xb.x << 16), __builtin_bit_cast(float, xb.x & 0xffff0000u), __builtin_bit_cast(float, xb.y << 16), __builtin_bit_cast(float, xb.y & 0xffff0000u)};
                        x1 = (f32x4){__builtin_bit_cast(float, xb.z << 16), __builtin_bit_cast(float, xb.z & 0xffff0000u), __builtin_bit_cast(float, xb.w << 16), __builtin_bit_cast(float, xb.w & 0xffff0000u)}; }
                    else { x0 = *(const f32x4*)((const float*)xin + off + bj * HALF); x1 = *(const f32x4*)((const float*)xin + off + bj * HALF + 4); }
                    const f32x4 y0 = x0 + gv[bj][0] * acc[ai][bj][m][0], y1 = x1 + gv[bj][1] * acc[ai][bj][m][1];
                    u32x4 w; w.x = cvt_pk_bf16(y0[0], y0[1]); w.y = cvt_pk_bf16(y0[2], y0[3]); w.z = cvt_pk_bf16(y1[0], y1[1]); w.w = cvt_pk_bf16(y1[2], y1[3]);
                    *(u32x4*)(out + off + bj * HALF) = w; } }
    }
};
}

__device__ __forceinline__ void transpose_item(const float* W, int ldw, int src_col0, int k0, bf16* WT, int dst_row0, int dst_k0, LAS float* scr, int lane) {
#pragma unroll
    for (int i = 0; i < 32; ++i) { const int kk = 2 * i + (lane >> 5); scr[kk * 33 + (lane & 31)] = W[(size_t)(k0 + kk) * ldw + src_col0 + (lane & 31)]; }
    LDS_WAIT();
    const int c = lane & 7;
#pragma unroll
    for (int j = 0; j < 4; ++j) { const int n = (lane >> 3) + 8 * j; const LAS float* s = scr + (8 * c) * 33 + n;
        u32x4 o; o.x = pk2(s[0 * 33], s[1 * 33]); o.y = pk2(s[2 * 33], s[3 * 33]); o.z = pk2(s[4 * 33], s[5 * 33]); o.w = pk2(s[6 * 33], s[7 * 33]);
        *(u32x4*)(WT + (size_t)(dst_row0 + n) * D + dst_k0 + 8 * c) = o; }
    LDS_WAIT();
}

__device__ __forceinline__ void phase_prologue(const Params& p, LAS unsigned char* lds) {
    int tid_ = threadIdx.x; asm volatile("" : "+v"(tid_));
    const int tid = tid_, lane = tid & 63, wave = tid >> 6;
    unsigned char* ws = p.ws;
    for (int task = blockIdx.x; task < DEPTH * 96; task += gridDim.x) {
        const int l = task / 96, cgp = task % 96, col = tid & 31, ks = tid >> 5;
        const float* W = p.in[3] + (size_t)l * D * 3072 + cgp * 32 + col;
        const float* c0 = p.in[1], *c1 = p.in[1] + D;
        float s0 = 0.f, s1 = 0.f;
#pragma unroll 16
        for (int k = ks * 64; k < ks * 64 + 64; ++k) { const float w = W[(size_t)k * 3072]; const float a = c0[k], b = c1[k];
            s0 += a * sigmoidf_(a) * w; s1 += b * sigmoidf_(b) * w; }
        LAS float* red = (LAS float*)(lds + 98304);
        red[(ks * 32 + col) * 2 + 0] = s0; red[(ks * 32 + col) * 2 + 1] = s1;
        __syncthreads();
        if (tid < 64) { const int cc = tid & 31, bb = tid >> 5; float s = 0.f;
#pragma unroll
            for (int k = 0; k < 16; ++k) s += red[(k * 32 + cc) * 2 + bb];
            const int cglob = cgp * 32 + cc;
            ((float*)(ws + WS_MOD))[(l * BATCH + bb) * 3072 + cglob] = s + p.in[4][l * 3072 + cglob]; }
        __syncthreads();
    }
    LAS float* scr = (LAS float*)(lds + wave * 8704);
    const int gw = blockIdx.x * NWAVES + wave, NGW = gridDim.x * NWAVES;
    constexpr int I_IN = 16 * 176, I_UP = 8 * 32, I_OUT = 16 * 32, I_LR = 16, I_L = I_IN + 2 * I_UP + I_OUT + I_LR;
    for (int it = gw; it < DEPTH * I_L; it += NGW) {
        const int l = it / I_L; int r = it % I_L;
        if (r < I_IN) { const int kb = r / 176, nb = r % 176, n0 = 32 * nb;
            transpose_item(p.in[5] + (size_t)l * D * IN_TOTAL, IN_TOTAL, n0 < 1536 ? n0 : (n0 < 3584 ? n0 + 16 : 3600 + (((n0 - 3584) >> 7) & 1) * 1024 + ((n0 - 3584) >> 8) * 128 + (n0 & 127)), 64 * kb, (bf16*)(ws + WS_WIN) + (size_t)l * NP * D, n0, 64 * kb, scr, lane); continue; }
        r -= I_IN;
        if (r < I_UP) { const int kb = r / 32, nb = r % 32;
            transpose_item(p.in[12] + (size_t)l * 512 * D, D, 32 * nb, 64 * kb, (bf16*)(ws + WS_WUP) + (size_t)l * D * D, 32 * nb, 64 * kb, scr, lane); continue; }
        r -= I_UP;
        if (r < I_UP) { const int kb = r / 32, nb = r % 32;
            transpose_item(p.in[13] + (size_t)l * 512 * D, D, 32 * nb, 64 * kb, (bf16*)(ws + WS_WUP) + (size_t)l * D * D, 32 * nb, 512 + 64 * kb, scr, lane); continue; }
        r -= I_UP;
        if (r >= I_OUT) { const int kb = r - I_OUT;
            transpose_item(p.in[5] + (size_t)l * D * IN_TOTAL, IN_TOTAL, 1536, 64 * kb, (bf16*)(ws + WS_WLR) + (size_t)l * 32 * D, 0, 64 * kb, scr, lane); continue; }
        { const int kb = r / 32, nb = r % 32;
            transpose_item(p.in[14] + (size_t)l * D * D, D, 32 * nb, 64 * kb, (bf16*)(ws + WS_WOUT) + (size_t)l * D * D, 32 * nb, 64 * kb, scr, lane); }
    }
}

template <bool XBF> struct XRaw;
template <> struct XRaw<false> { typedef f32x4 T; static __device__ __forceinline__ f32x4 cvt(const f32x4& v) { return v; } };
template <> struct XRaw<true> { typedef u32x2 T; static __device__ __forceinline__ f32x4 cvt(const u32x2& v) { return (f32x4){bflo(v.x), bfhi(v.x), bflo(v.y), bfhi(v.y)}; } };
template <bool XBF>
__device__ __forceinline__ void phase_norm(const Params& p, LAS unsigned char* lds, int l, const void* xin_) {
    int tid_ = threadIdx.x; asm volatile("" : "+v"(tid_));
    const int tid = tid_, lane = tid & 63, wave = tid >> 6, m = lane & 15, q = lane >> 4;
    unsigned char* ws = p.ws;
    constexpr int TRS = 2064;
    LAS unsigned char* tile = lds + wave * (8 * TRS);
    LAS float* wscr = (LAS float*)(lds + 8 * 8 * TRS) + wave * 128;
    f32x4 wa2r[16];
#pragma unroll
    for (int n = 0; n < 16; ++n) wa2r[n] = *(const f32x4*)(p.in[6] + l * 4096 + n * 256 + lane * 4);
    f32x4 nw[4];
#pragma unroll
    for (int j = 0; j < 4; ++j) nw[j] = *(const f32x4*)(p.in[2] + l * D + lane * 4 + 256 * j);
    const f32x4 ba4 = *(const f32x4*)(p.in[7] + l * 256 + lane * 4);
    const float* mod = (const float*)(ws + WS_MOD) + (size_t)l * BATCH * 3072;
    bf16* H = (bf16*)(ws + WS_H); bf16* LA = (bf16*)(ws + WS_LOGA);
    const bf16* wlr = (const bf16*)(ws + WS_WLR) + (size_t)l * 32 * D + m * D + q * 8;
    const LAS unsigned char* arow = tile + (m & 7) * TRS + q * 16;
    const int gw = blockIdx.x * NWAVES + wave, NGW = gridDim.x * NWAVES;
    int bcur = -1;
    typedef typename XRaw<XBF>::T xraw_t;
    f32x4 hm[4], ha[4]; xraw_t xn[2][4];
    if (gw * 8 < T) {
#pragma unroll
        for (int rr = 0; rr < 2; ++rr)
#pragma unroll
            for (int j = 0; j < 4; ++j) xn[rr][j] = ((const xraw_t*)xin_ + (size_t)(gw * 8 + rr) * (D / 4) + lane)[64 * j]; }
#pragma unroll 1
    for (int t = gw; t < T / 8; t += NGW) {
        const int r0 = t * 8, b = r0 / SEQ;
        if (b != bcur) { bcur = b;
#pragma unroll
            for (int j = 0; j < 4; ++j) { ha[j] = *(const f32x4*)(mod + b * 3072 + lane * 4 + 256 * j); const f32x4 sc = *(const f32x4*)(mod + b * 3072 + 1024 + lane * 4 + 256 * j); hm[j] = nw[j] * (1.0f + sc); } }
#pragma unroll 1
        for (int rp = 0; rp < 4; ++rp) {
            f32x4 hv[2][4];
#pragma unroll
            for (int rr = 0; rr < 2; ++rr)
#pragma unroll
                for (int j = 0; j < 4; ++j) hv[rr][j] = XRaw<XBF>::cvt(xn[rr][j]);
            {
                int rn = r0 + 2 * rp + 2;
                if (rp == 3) rn = (t + NGW < T / 8) ? (t + NGW) * 8 : r0;
#pragma unroll
                for (int rr = 0; rr < 2; ++rr)
#pragma unroll
                    for (int j = 0; j < 4; ++j) xn[rr][j] = ((const xraw_t*)xin_ + (size_t)(rn + rr) * (D / 4) + lane)[64 * j];
            }
#pragma unroll
            for (int rr = 0; rr < 2; ++rr) {
                float s = 0.f;
#pragma unroll
                for (int j = 0; j < 4; ++j) s += (hv[rr][j].x * hv[rr][j].x + hv[rr][j].y * hv[rr][j].y) + (hv[rr][j].z * hv[rr][j].z + hv[rr][j].w * hv[rr][j].w);
                const float rstd = __builtin_amdgcn_rsqf(wave_sum(s) * (1.0f / D) + EPS);
                const int row = 2 * rp + rr;
                u32x2* o8 = (u32x2*)(H + (size_t)(r0 + row) * D) + lane;
                LAS u32x2* t8 = (LAS u32x2*)(tile + row * TRS) + lane;
#pragma unroll
                for (int j = 0; j < 4; ++j) { const f32x4 hh = hv[rr][j] * rstd * hm[j] + ha[j];
                    const u32x2 pk = (u32x2){pg8::cvt_pk_bf16(hh.x, hh.y), pg8::cvt_pk_bf16(hh.z, hh.w)};
                    o8[64 * j] = pk; t8[64 * j] = pk; }
            }
        }
        LDS_WAIT();
        f32x4 acc = (f32x4){0.f, 0.f, 0.f, 0.f};
#pragma unroll 8
        for (int ks = 0; ks < 32; ++ks) {
            const bf16x8 af = *(const LAS bf16x8*)(arow + ks * 64);
            const bf16x8 bfr = *(const bf16x8*)(wlr + ks * 32);
            acc = __builtin_amdgcn_mfma_f32_16x16x32_bf16(af, bfr, acc, 0, 0, 0);
        }
        if (q < 2) {
#pragma unroll
            for (int j = 0; j < 4; ++j) wscr[(q * 4 + j) * 16 + m] = acc[j]; }
        LDS_WAIT();
#pragma unroll 2
        for (int row = 0; row < 8; ++row) {
            f32x4 z = ba4;
#pragma unroll
            for (int n4 = 0; n4 < 4; ++n4) { const f32x4 g = *(const LAS f32x4*)(wscr + row * 16 + n4 * 4);
                z += wa2r[n4 * 4 + 0] * g.x; z += wa2r[n4 * 4 + 1] * g.y; z += wa2r[n4 * 4 + 2] * g.z; z += wa2r[n4 * 4 + 3] * g.w; }
            f32x4 lo;
#pragma unroll
            for (int i = 0; i < 4; ++i) lo[i] = -(fmaxf(-z[i], 0.f) + __logf(1.0f + __expf(-fabsf(z[i])))) * 0.0625f;
            *(u32x2*)(LA + (size_t)(r0 + row) * 256 + lane * 4) = (u32x2){pg8::cvt_pk_bf16(lo[0], lo[1]), pg8::cvt_pk_bf16(lo[2], lo[3])};
        }
        LDS_WAIT();
    }
}

constexpr int MX_KD = 0, MX_QS = 16384, MX_OCT = 33792, MX_ADEC = 37888, MX_OT = 38400, MX_RA = 72192, MX_RV = 89600;
constexpr int MX_QS2 = 107008;
constexpr int MX_RSV = 272;

#define TR_READ(dst, addr, OFF) asm volatile("ds_read_b64_tr_b16 %0, %1 offset:%2" : "=&v"(dst) : "v"(addr), "n"(OFF) : "memory")

template <bool HG, bool FIN>
__device__ __forceinline__ void mixer_unit(const Params& p, LAS unsigned char* lds, int l, int b, int h, int jg) {
    constexpr int DK = HG ? 128 : 64, KT = DK / 16, QSTR = DK + 8, RSA = DK * 2 + 16;
    constexpr int KCOL = HG ? C_HF : C_GK, VCOL = HG ? C_HI : C_GV, QCOL = HG ? C_HQ : C_GQ, ZCOL = HG ? C_HZ : C_GZ;
    constexpr int NOCT = HG ? 2 : 1;
    constexpr int PPR = DK / 8, NQ = (64 * PPR) / NTHREADS;
    int tid_ = threadIdx.x; asm volatile("" : "+v"(tid_));
    const int tid = tid_, lane = tid & 63, w = tid >> 6, n = lane & 15, q = lane >> 4, qq = n >> 2, pp = lane & 3;
    unsigned char* ws = p.ws;
    const bf16* P1 = (const bf16*)(ws + WS_P1);
    const bf16* LA = (const bf16*)(ws + WS_LOGA);
    bf16* OB = (bf16*)(ws + WS_H);
    bf16* SB = (bf16*)(ws + (HG ? WS_STATE_HG : WS_STATE)) + (size_t)((b * 4 + h) * NG + jg) * (DK * 128);
    float* PD = (float*)(ws + WS_PDEC) + (size_t)(((HG ? 0 : 8) + b * 4 + h) * NG + jg) * 128;
    LAS unsigned char* KD = lds + MX_KD;
    LAS bf16* QS = (LAS bf16*)(lds + MX_QS);
    LAS float* OCT = (LAS float*)(lds + MX_OCT);
    LAS float* ADEC = (LAS float*)(lds + MX_ADEC);
    LAS float* OT = (LAS float*)(lds + MX_OT);
    LAS unsigned char* RA = lds + MX_RA;
    LAS unsigned char* RV = lds + MX_RV;

    const int c = HG ? (tid & 127) : (tid & 63);
    const int o_first = HG ? (tid >> 7) : (tid >> 6);
    const unsigned tra = (unsigned)(size_t)RA + (unsigned)((o_first * 8 + qq) * RSA + ((c & ~15) + 4 * pp) * 2);
    const unsigned trv = (unsigned)(size_t)RV + (unsigned)((8 * q + qq) * MX_RSV + (16 * w + 4 * pp) * 2);
    float lb = 0.f, lbf = 1e-30f, oml = 1.0f;
    if (HG) { if (l > 0) { const float g0 = p.in[9][h * 128 + c], g1 = p.in[9][512 + h * 128 + c]; lb = 1.0f / (1.0f + __expf(g0 - g1)); lb = fminf(fmaxf(lb, 0.f), 1.0f - 1e-6f); }
        lbf = fmaxf(lb, 1e-30f); oml = 1.0f - lb; }
    float nwv[16];
    if (FIN) { const float* nwp = (HG ? p.in[10] : p.in[8]) + l * 128 + (tid & 7) * 16;
#pragma unroll
        for (int i = 0; i < 16; ++i) nwv[i] = nwp[i]; }

    f32x4 S[KT];
    if (FIN) {
#pragma unroll
        for (int kt = 0; kt < KT; ++kt) { const u32x2 sv = *(const u32x2*)(SB + (size_t)((w * KT + kt) * 64 + lane) * 4); S[kt] = (f32x4){bflo(sv.x), bfhi(sv.x), bflo(sv.y), bfhi(sv.y)}; }
    } else {
#pragma unroll
        for (int kt = 0; kt < KT; ++kt) S[kt] = (f32x4){0.f, 0.f, 0.f, 0.f};
    }
    float pprod = 1.0f;

    const int rowg = b * SEQ + jg * G_CH * 64;
    u32x4 araw[NQ], vraw[2], qraw[NQ], zraw[2]; unsigned short laraw[8];
    const bf16* aptr = P1 + (size_t)rowg * NP1 + KCOL + h * DK;
    const bf16* laptr = LA + (size_t)rowg * 256 + h * 64 + c;
    const bf16* vptr = P1 + (size_t)rowg * NP1 + VCOL + h * 128;
    const bf16* qptr = P1 + (size_t)rowg * NP1 + QCOL + h * DK;
    const bf16* zptr = P1 + (size_t)(rowg + (tid >> 3)) * NP1 + ZCOL + h * 128 + (tid & 7) * 16;
#define MX_LOAD_A(cc_) do { const size_t ro_ = (size_t)(cc_) * 64; \
        _Pragma("unroll") for (int pq = 0; pq < NQ; ++pq) { const int pc = tid + pq * NTHREADS; araw[pq] = *(const u32x4*)(aptr + (ro_ + pc / PPR) * NP1 + (pc % PPR) * 8); } \
        if (!HG) { _Pragma("unroll") for (int i = 0; i < 8; ++i) laraw[i] = laptr[(ro_ + o_first * 8 + i) * 256]; } } while (0)
#define MX_LOAD_V(cc_) do { const size_t ro_ = (size_t)(cc_) * 64; \
        _Pragma("unroll") for (int pq = 0; pq < 2; ++pq) { const int pc = tid + pq * NTHREADS; vraw[pq] = *(const u32x4*)(vptr + (ro_ + pc / 16) * NP1 + (pc % 16) * 8); } } while (0)
#define MX_LOAD_Q(cc_) do { const size_t ro_ = (size_t)(cc_) * 64; \
        _Pragma("unroll") for (int pq = 0; pq < NQ; ++pq) { const int pc = tid + pq * NTHREADS; qraw[pq] = *(const u32x4*)(qptr + (ro_ + pc / PPR) * NP1 + (pc % PPR) * 8); } } while (0)
#define MX_LOAD_Z(cc_) do { const size_t ro_ = (size_t)(cc_) * 64; zraw[0] = *(const u32x4*)(zptr + ro_ * NP1); zraw[1] = *(const u32x4*)(zptr + ro_ * NP1 + 8); } while (0)
    MX_LOAD_A(0); MX_LOAD_V(0);
    if (FIN) { MX_LOAD_Q(0); MX_LOAD_Z(0); }
    float lacur[8];
#define MX_RAW_TO_LDS(qb_) do { \
        _Pragma("unroll") for (int pq = 0; pq < NQ; ++pq) { const int pc = tid + pq * NTHREADS; *(LAS u32x4*)(RA + (pc / PPR) * RSA + (pc % PPR) * 16) = araw[pq]; } \
        _Pragma("unroll") for (int pq = 0; pq < 2; ++pq) { const int pc = tid + pq * NTHREADS; *(LAS u32x4*)(RV + (pc / 16) * MX_RSV + (pc % 16) * 16) = vraw[pq]; } \
        if (FIN) { LAS bf16* qd_ = (LAS bf16*)(lds + ((qb_) ? MX_QS2 : MX_QS)); \
            _Pragma("unroll") for (int pq = 0; pq < NQ; ++pq) { const int pc = tid + pq * NTHREADS; *(LAS u32x4*)(qd_ + (pc / PPR) * QSTR + (pc % PPR) * 8) = qraw[pq]; } } \
        if (!HG) { _Pragma("unroll") for (int i = 0; i < 8; ++i) lacur[i] = bf2f(laraw[i]); } } while (0)
    MX_RAW_TO_LDS(0);
    { const int c1 = (1 < G_CH) ? 1 : 0; MX_LOAD_A(c1); MX_LOAD_V(c1); if (FIN) MX_LOAD_Q(c1); }
    LDS_WAIT(); __syncthreads();

#pragma unroll 1
    for (int cc = 0; cc < G_CH; ++cc) {
        const int ccn = (cc + 1 < G_CH) ? cc + 1 : cc;
        const int cc2 = (cc + 2 < G_CH) ? cc + 2 : G_CH - 1;
        const int row0 = rowg + cc * 64;
        const LAS bf16* QSc = (const LAS bf16*)(lds + ((cc & 1) ? MX_QS2 : MX_QS));
        u32x2 art[NOCT][2], vrt[2][2];
        TR_READ(art[0][0], tra, 0); TR_READ(art[0][1], tra, 4 * RSA);
        if (HG) { TR_READ(art[NOCT - 1][0], tra, 32 * RSA); TR_READ(art[NOCT - 1][1], tra, 36 * RSA); }
        TR_READ(vrt[0][0], trv, 0); TR_READ(vrt[0][1], trv, 4 * MX_RSV); TR_READ(vrt[1][0], trv, 32 * MX_RSV); TR_READ(vrt[1][1], trv, 36 * MX_RSV);
        if (HG) asm volatile("s_waitcnt lgkmcnt(0)" : "+v"(art[0][0]), "+v"(art[0][1]), "+v"(art[NOCT - 1][0]), "+v"(art[NOCT - 1][1]), "+v"(vrt[0][0]), "+v"(vrt[0][1]), "+v"(vrt[1][0]), "+v"(vrt[1][1]) :: "memory");
        else asm volatile("s_waitcnt lgkmcnt(0)" : "+v"(art[0][0]), "+v"(art[0][1]), "+v"(vrt[0][0]), "+v"(vrt[0][1]), "+v"(vrt[1][0]), "+v"(vrt[1][1]) :: "memory");
        float fg[NOCT][8], kv[NOCT][8];
#pragma unroll
        for (int oi = 0; oi < NOCT; ++oi) { const int o = o_first + 4 * oi;
#pragma unroll
            for (int i = 0; i < 8; ++i) { const unsigned wv = (i & 2) ? art[oi][i >> 2].y : art[oi][i >> 2].x; const float x = (i & 1) ? bfhi(wv) : bflo(wv);
                if (HG) { const float zf = fminf(fmaxf(x, -80.f), 80.f);
                    const float e = __expf(-zf), s = __builtin_amdgcn_rcpf(1.0f + e);
                    fg[oi][i] = lbf + oml * s; kv[oi][i] = oml * e * s; }
                else { fg[oi][i] = __expf(lacur[i]); kv[oi][i] = x; } }
            float pr = 1.0f;
#pragma unroll
            for (int i = 0; i < 8; ++i) pr *= fg[oi][i];
            OCT[o * 128 + c] = pr; }
        LDS_WAIT(); __syncthreads();
#pragma unroll
        for (int oi = 0; oi < NOCT; ++oi) { const int o = o_first + 4 * oi;
            float suf = 1.0f;
#pragma unroll
            for (int o2 = 1; o2 < 8; ++o2) { const float t = OCT[o2 * 128 + c]; suf *= (o2 > o) ? t : 1.0f; }
            float kd[8];
#pragma unroll
            for (int i = 7; i >= 0; --i) { kd[i] = kv[oi][i] * suf; suf *= fg[oi][i]; }
            u32x4 pk; pk.x = pg8::cvt_pk_bf16(kd[0], kd[1]); pk.y = pg8::cvt_pk_bf16(kd[2], kd[3]); pk.z = pg8::cvt_pk_bf16(kd[4], kd[5]); pk.w = pg8::cvt_pk_bf16(kd[6], kd[7]);
            *(LAS u32x4*)(KD + (size_t)((((c >> 4) * 2 + (o >> 2)) * 64 + (o & 3) * 16 + (c & 15)) * 16)) = pk;
            if (o == 0) { ADEC[c] = suf; pprod *= suf; } }
        MX_RAW_TO_LDS((cc + 1) & 1);
        MX_LOAD_A(cc2); MX_LOAD_V(cc2);
        if (FIN) MX_LOAD_Q(cc2);
        LDS_WAIT(); __syncthreads();
        union { u32x4 u; bf16x8 v; } vf[2];
        vf[0].u = (u32x4){vrt[0][0].x, vrt[0][0].y, vrt[0][1].x, vrt[0][1].y}; vf[1].u = (u32x4){vrt[1][0].x, vrt[1][0].y, vrt[1][1].x, vrt[1][1].y};
#pragma unroll
        for (int kt = 0; kt < KT; ++kt) { const f32x4 a4 = *(const LAS f32x4*)(ADEC + kt * 16 + q * 4); S[kt] = S[kt] * a4;
#pragma unroll
            for (int ks = 0; ks < 2; ++ks) { const bf16x8 af = *(const LAS bf16x8*)(KD + (size_t)(((kt * 2 + ks) * 64 + lane) * 16));
                S[kt] = __builtin_amdgcn_mfma_f32_16x16x32_bf16(af, vf[ks].v, S[kt], 0, 0, 0); } }
        if (FIN) {
            f32x4 oacc[4];
#pragma unroll
            for (int lt = 0; lt < 4; ++lt) oacc[lt] = (f32x4){0.f, 0.f, 0.f, 0.f};
#pragma unroll
            for (int kk = 0; kk < KT / 2; ++kk) {
                union { u32x4 u; bf16x8 v; } bs;
                bs.u.x = pg8::cvt_pk_bf16(S[2 * kk][0], S[2 * kk][1]); bs.u.y = pg8::cvt_pk_bf16(S[2 * kk][2], S[2 * kk][3]); bs.u.z = pg8::cvt_pk_bf16(S[2 * kk + 1][0], S[2 * kk + 1][1]); bs.u.w = pg8::cvt_pk_bf16(S[2 * kk + 1][2], S[2 * kk + 1][3]);
#pragma unroll
                for (int lt = 0; lt < 4; ++lt) {
                    union { u32x4 u; bf16x8 v; } aq;
                    const u32x2 q0 = *(const LAS u32x2*)(QSc + (lt * 16 + n) * QSTR + (2 * kk) * 16 + q * 4), q1 = *(const LAS u32x2*)(QSc + (lt * 16 + n) * QSTR + (2 * kk + 1) * 16 + q * 4);
                    aq.u = (u32x4){q0.x, q0.y, q1.x, q1.y};
                    oacc[lt] = __builtin_amdgcn_mfma_f32_16x16x32_bf16(aq.v, bs.v, oacc[lt], 0, 0, 0); } }
#pragma unroll
            for (int lt = 0; lt < 4; ++lt)
#pragma unroll
                for (int j = 0; j < 4; ++j) OT[(lt * 16 + q * 4 + j) * 132 + w * 16 + n] = oacc[lt][j];
            LDS_WAIT(); __syncthreads();
            { const int fl = tid >> 3, seg = tid & 7;
                f32x4 ov[4]; float ssq = 0.f;
#pragma unroll
                for (int i = 0; i < 4; ++i) { ov[i] = *(const LAS f32x4*)(OT + fl * 132 + seg * 16 + i * 4); ssq += (ov[i].x * ov[i].x + ov[i].y * ov[i].y) + (ov[i].z * ov[i].z + ov[i].w * ov[i].w); }
                ssq += __shfl_xor(ssq, 1); ssq += __shfl_xor(ssq, 2); ssq += __shfl_xor(ssq, 4);
                const float rstd = __builtin_amdgcn_rsqf(ssq * (1.0f / 128.0f) + EPS);
                const u32x4 zg0 = zraw[0], zg1 = zraw[1];
                MX_LOAD_Z(ccn);
                u32x4 w0, w1;
                w0.x = pg8::cvt_pk_bf16(ov[0].x * rstd * nwv[0] * bflo(zg0.x), ov[0].y * rstd * nwv[1] * bfhi(zg0.x)); w0.y = pg8::cvt_pk_bf16(ov[0].z * rstd * nwv[2] * bflo(zg0.y), ov[0].w * rstd * nwv[3] * bfhi(zg0.y));
                w0.z = pg8::cvt_pk_bf16(ov[1].x * rstd * nwv[4] * bflo(zg0.z), ov[1].y * rstd * nwv[5] * bfhi(zg0.z)); w0.w = pg8::cvt_pk_bf16(ov[1].z * rstd * nwv[6] * bflo(zg0.w), ov[1].w * rstd * nwv[7] * bfhi(zg0.w));
                w1.x = pg8::cvt_pk_bf16(ov[2].x * rstd * nwv[8] * bflo(zg1.x), ov[2].y * rstd * nwv[9] * bfhi(zg1.x)); w1.y = pg8::cvt_pk_bf16(ov[2].z * rstd * nwv[10] * bflo(zg1.y), ov[2].w * rstd * nwv[11] * bfhi(zg1.y));
                w1.z = pg8::cvt_pk_bf16(ov[3].x * rstd * nwv[12] * bflo(zg1.z), ov[3].y * rstd * nwv[13] * bfhi(zg1.z)); w1.w = pg8::cvt_pk_bf16(ov[3].z * rstd * nwv[14] * bflo(zg1.w), ov[3].w * rstd * nwv[15] * bfhi(zg1.w));
                bf16* op = OB + (size_t)(row0 + fl) * D + (HG ? 512 : 0) + h * 128 + seg * 16;
                *(u32x4*)op = w0; *(u32x4*)(op + 8) = w1; }
        }
    }
#undef MX_RAW_TO_LDS
#undef MX_LOAD_A
#undef MX_LOAD_V
#undef MX_LOAD_Q
#undef MX_LOAD_Z
    if (!FIN) {
#pragma unroll
        for (int kt = 0; kt < KT; ++kt) *(u32x2*)(SB + (size_t)((w * KT + kt) * 64 + lane) * 4) = (u32x2){pg8::cvt_pk_bf16(S[kt][0], S[kt][1]), pg8::cvt_pk_bf16(S[kt][2], S[kt][3])};
        if (o_first == 0) PD[c] = pprod;
    }
    __syncthreads();
}

template <bool FIN>
__device__ __forceinline__ void phase_mixer(const Params& p, LAS unsigned char* lds, int l) {
    for (int u = blockIdx.x; u < 512; u += gridDim.x) {
        const int rem = u & 255, b = rem >> 7, h = (rem >> 5) & 3, jg = rem & 31;
        if (!FIN && jg == NG - 1) continue;
        if (u < 256) mixer_unit<true, FIN>(p, lds, l, b, h, jg); else mixer_unit<false, FIN>(p, lds, l, b, h, jg);
    }
}

__device__ __forceinline__ void phase_scan(const Params& p) {
    unsigned char* ws = p.ws;
    int tid_ = threadIdx.x; asm volatile("" : "+v"(tid_));
    const int gt = blockIdx.x * NTHREADS + tid_, NT = gridDim.x * NTHREADS;
    for (int tt = gt; tt < 8 * 4096 + 8 * 2048; tt += NT) {
        const bool hg = tt < 32768; const int t2 = hg ? tt : tt - 32768, per = hg ? 4096 : 2048, bh = t2 / per, e = t2 % per, KT = hg ? 8 : 4;
        const int kt = (e >> 6) % KT, lane = e & 63, c4 = kt * 16 + (lane >> 4) * 4;
        bf16* base = (bf16*)(ws + (hg ? WS_STATE_HG : WS_STATE)) + (size_t)bh * NG * (per * 4) + (size_t)e * 4;
        const float* pd = (const float*)(ws + WS_PDEC) + (size_t)(((hg ? 0 : 8) + bh) * NG) * 128 + c4;
        f32x4 S = (f32x4){0.f, 0.f, 0.f, 0.f};
        for (int j0 = 0; j0 < NG; j0 += 8) {
            f32x4 Lv[8], Pv[8];
#pragma unroll
            for (int j = 0; j < 8; ++j) { if (j0 + j < NG - 1) { { const u32x2 lv = *(const u32x2*)(base + (size_t)(j0 + j) * (per * 4)); Lv[j] = (f32x4){bflo(lv.x), bfhi(lv.x), bflo(lv.y), bfhi(lv.y)}; } Pv[j] = *(const f32x4*)(pd + (size_t)(j0 + j) * 128); } else { Lv[j] = (f32x4){0.f, 0.f, 0.f, 0.f}; Pv[j] = Lv[j]; } }
#pragma unroll
            for (int j = 0; j < 8; ++j) { *(u32x2*)(base + (size_t)(j0 + j) * (per * 4)) = (u32x2){pg8::cvt_pk_bf16(S[0], S[1]), pg8::cvt_pk_bf16(S[2], S[3])}; S = Pv[j] * S + Lv[j]; }
        }
    }
}

__device__ __forceinline__ void phase_final_norm(const Params& p) {
    int tid_ = threadIdx.x; asm volatile("" : "+v"(tid_));
    const int tid = tid_, lane = tid & 63, wave = tid >> 6;
    const u32x2* xb = (const u32x2*)(p.ws + WS_H);
    f32x4 nw[4];
#pragma unroll
    for (int j = 0; j < 4; ++j) nw[j] = *(const f32x4*)(p.in[15] + lane * 4 + 256 * j);
    const int gw = blockIdx.x * NWAVES + wave, NGW = gridDim.x * NWAVES;
    u32x2 vn[4];
    if (gw < T) {
#pragma unroll
        for (int j = 0; j < 4; ++j) vn[j] = (xb + (size_t)gw * (D / 4) + lane)[64 * j]; }
#pragma unroll 1
    for (int r = gw; r < T; r += NGW) {
        f32x4* xr = (f32x4*)(p.out + (size_t)r * D) + lane;
        f32x4 v[4]; float s = 0.f;
#pragma unroll
        for (int j = 0; j < 4; ++j) v[j] = (f32x4){bflo(vn[j].x), bfhi(vn[j].x), bflo(vn[j].y), bfhi(vn[j].y)};
        { const int rn = (r + NGW < T) ? r + NGW : r;
#pragma unroll
          for (int j = 0; j < 4; ++j) vn[j] = (xb + (size_t)rn * (D / 4) + lane)[64 * j]; }
#pragma unroll
        for (int j = 0; j < 4; ++j) s += (v[j].x * v[j].x + v[j].y * v[j].y) + (v[j].z * v[j].z + v[j].w * v[j].w);
        const float rstd = __builtin_amdgcn_rsqf(wave_sum(s) * (1.0f / D) + EPS);
#pragma unroll
        for (int j = 0; j < 4; ++j) xr[64 * j] = v[j] * rstd * nw[j];
    }
}

#define XB_TMO      128
#define XB_XCNT(j)  (256  + 64 * (j))
#define XB_XSUB(j)  (1280 + 64 * (j))
#define XB_XGEN(j)  (2304 + 64 * (j))
#define XB_TOP      3328
#define XB_TOPGEN   3392
#define XCD_BAR_WORDS 3456
#define XB_SPIN_CAP (1u << 18)

__device__ __forceinline__ unsigned xb_ld(unsigned* p)              { return __hip_atomic_load(p, __ATOMIC_RELAXED, __HIP_MEMORY_SCOPE_AGENT); }
__device__ __forceinline__ unsigned xb_add(unsigned* p, unsigned v) { return __hip_atomic_fetch_add(p, v, __ATOMIC_RELAXED, __HIP_MEMORY_SCOPE_AGENT); }
__device__ __forceinline__ unsigned xb_xcc_id() { return (unsigned)__builtin_amdgcn_s_getreg((3 << 11) | 20) & 0xFu; }
#define XB_SPIN(cond, bar) do { unsigned _sp = 0; while (cond) { __builtin_amdgcn_s_sleep(1); \
    if ((++_sp & 255u) == 0u) { if (xb_ld(&(bar)[XB_TMO])) break; if (_sp > XB_SPIN_CAP) { atomicAdd(&(bar)[XB_TMO], 1u); break; } } } } while (0)

struct XcdBarrier {
    unsigned* bar; unsigned x;
    volatile LAS unsigned* st;
};

__device__ __forceinline__ XcdBarrier xcd_barrier_post(unsigned* bar, volatile LAS unsigned* st) {
    XcdBarrier b; b.bar = bar; b.x = xb_xcc_id(); b.st = st;
    if (threadIdx.x == 0) (void)xb_add(&bar[XB_XCNT(b.x)], 1u);
    return b;
}
__device__ __forceinline__ void xcd_barrier_complete(unsigned* bar, unsigned x, unsigned& nloc, unsigned& nx) {
    const unsigned G = gridDim.x * gridDim.y * gridDim.z;
    unsigned sum, cnt, mine, sp = 0u;
    for (;;) {
        sum = 0u; cnt = 0u; mine = 0u;
#pragma unroll
        for (unsigned j = 0; j < 16; ++j) { const unsigned c = xb_ld(&bar[XB_XCNT(j)]); sum += c; cnt += (c > 0u) ? 1u : 0u; mine = (j == x) ? c : mine; }
        if (sum == G) break;
        __builtin_amdgcn_s_sleep(1);
        if ((++sp & 255u) == 0u) { if (xb_ld(&bar[XB_TMO])) break; if (sp > XB_SPIN_CAP) { atomicAdd(&bar[XB_TMO], 1u); break; } }
    }
    nloc = mine > 0u ? mine : 1u; nx = cnt > 0u ? cnt : 1u;
}

__device__ __forceinline__ void xcd_barrier(const XcdBarrier& b) {
    asm volatile("s_waitcnt vmcnt(0)" ::: "memory");
    __syncthreads();
    if (threadIdx.x == 0) {
        unsigned* bar = b.bar;
        __builtin_amdgcn_s_waitcnt(0);
        unsigned nloc = b.st[0], nx = b.st[1];
        if (nloc == 0u) { xcd_barrier_complete(bar, b.x, nloc, nx); b.st[0] = nloc; b.st[1] = nx; }
        const unsigned old = xb_add(&bar[XB_XSUB(b.x)], 1u);
        const unsigned gen = old / nloc;
        if (old + 1u == (gen + 1u) * nloc) {
            __builtin_amdgcn_fence(__ATOMIC_RELEASE, "agent");
            asm volatile("s_waitcnt vmcnt(0)" ::: "memory");
            const unsigned og = xb_add(&bar[XB_TOP], 1u);
            const unsigned tg = og / nx;
            if (og + 1u == (tg + 1u) * nx) xb_add(&bar[XB_TOPGEN], 1u);
            else XB_SPIN(xb_ld(&bar[XB_TOPGEN]) == tg, bar);
            __builtin_amdgcn_fence(__ATOMIC_ACQUIRE, "agent");
            xb_add(&bar[XB_XGEN(b.x)], 1u);
            asm volatile("s_waitcnt vmcnt(0)" ::: "memory");
        } else {
            XB_SPIN(xb_ld(&bar[XB_XGEN(b.x)]) == gen, bar);
            __builtin_amdgcn_fence(__ATOMIC_ACQUIRE, "agent");
            asm volatile("s_waitcnt vmcnt(0)" ::: "memory");
        }
    }
    __syncthreads();
}


__global__ void __launch_bounds__(NTHREADS, 2) mega_fwd(Params p) {
    extern __shared__ __attribute__((aligned(16))) unsigned char lds_raw[];
    LAS unsigned char* lds = (LAS unsigned char*)lds_raw;
    cg::grid_group grid = cg::this_grid();
    unsigned char* ws = p.ws;
    unsigned* barw = (unsigned*)(ws + WS_BAR);
    volatile LAS unsigned* bst = (volatile LAS unsigned*)(lds + LDS_BYTES - 64);
    if (threadIdx.x < 2) bst[threadIdx.x] = 0u;
    if (blockIdx.x == 0) for (int i = threadIdx.x; i < XCD_BAR_WORDS; i += NTHREADS) barw[i] = 0u;
    phase_prologue(p, lds);
    grid.sync();
    const XcdBarrier xb = xcd_barrier_post(barw, bst);
#pragma unroll 1
    for (int l_ = 0; l_ < DEPTH; ++l_) {
        int l = l_; asm volatile("" : "+s"(l));
        if (l == 0) phase_norm<false>(p, lds, l, p.in[0]); else phase_norm<true>(p, lds, l, p.out);
        xcd_barrier(xb);
        {
            pg8::Gemm g{(const pg8::bf16_t*)(ws + WS_H), (const pg8::bf16_t*)(ws + WS_WIN) + (size_t)l * NP * D, T, NP, D};
            pg8::StaticOrder S; S.init(T, NP, (int)gridDim.x, (int)blockIdx.x);
            pg8::EpiIn E{(pg8::bf16_t*)(ws + WS_P1), (pg8::bf16_t*)(ws + WS_PG), p.in[11] + l * 2048};
            pg8::gemm_phase<pg8::EpiIn, pg8::StaticOrder, true, true>(lds, g, S, E);
        }
        xcd_barrier(xb);
        phase_mixer<false>(p, lds, l);
        xcd_barrier(xb);
        phase_scan(p);
        xcd_barrier(xb);
        phase_mixer<true>(p, lds, l);
        xcd_barrier(xb);
        {
            pg8::Gemm g{(const pg8::bf16_t*)(ws + WS_H), (const pg8::bf16_t*)(ws + WS_WUP) + (size_t)l * D * D, T, D, D};
            pg8::StaticOrder S; S.init(T, D, (int)gridDim.x, (int)blockIdx.x);
            pg8::EpiUp E{(const pg8::bf16_t*)(ws + WS_PG), (pg8::bf16_t*)(ws + WS_P1)};
            pg8::gemm_phase<pg8::EpiUp, pg8::StaticOrder, true, true>(lds, g, S, E);
        }
        xcd_barrier(xb);
        {
            pg8::Gemm g{(const pg8::bf16_t*)(ws + WS_P1), (const pg8::bf16_t*)(ws + WS_WOUT) + (size_t)l * D * D, T, D, D};
            pg8::StaticOrder S; S.init(T, D, (int)gridDim.x, (int)blockIdx.x);
            const float* gate2 = (const float*)(ws + WS_MOD) + (size_t)l * BATCH * 3072 + 2048;
            if (l == 0) { pg8::EpiOut<false> E{(const void*)p.in[0], (pg8::bf16_t*)p.out, gate2}; pg8::gemm_phase<pg8::EpiOut<false>, pg8::StaticOrder, true, true>(lds, g, S, E); }
            else { pg8::EpiOut<true> E{(const void*)p.out, (pg8::bf16_t*)(ws + WS_H), gate2}; pg8::gemm_phase<pg8::EpiOut<true>, pg8::StaticOrder, true, true>(lds, g, S, E); }
        }
        xcd_barrier(xb);
    }
    phase_final_norm(p);
}

extern "C" void kernel_launch(void* const* d_in, const int* in_sizes, int n_in, void* d_out, int out_size, void* d_ws, size_t ws_size, hipStream_t stream) {
    static int grid = 0;
    if (grid == 0) {
        if (n_in != 16 || in_sizes[0] != T * D || out_size != T * D || ws_size < WS_END) { fprintf(stderr, "kernel_launch: unexpected shapes (n_in %d, in0 %d, out %d, ws %zu)\n", n_in, n_in > 0 ? in_sizes[0] : -1, out_size, ws_size); grid = -1; return; }
        int dev = 0, cus = 0, per_cu = 0;
        if (hipGetDevice(&dev) != hipSuccess || hipDeviceGetAttribute(&cus, hipDeviceAttributeMultiprocessorCount, dev) != hipSuccess) { fprintf(stderr, "kernel_launch: device query failed\n"); grid = -1; return; }
        if (hipFuncSetAttribute((const void*)mega_fwd, hipFuncAttributeMaxDynamicSharedMemorySize, LDS_BYTES) != hipSuccess) { fprintf(stderr, "kernel_launch: hipFuncSetAttribute failed\n"); grid = -1; return; }
        if (hipOccupancyMaxActiveBlocksPerMultiprocessor(&per_cu, (const void*)mega_fwd, NTHREADS, LDS_BYTES) != hipSuccess || per_cu < 1) { fprintf(stderr, "kernel_launch: occupancy query failed (%d)\n", per_cu); (void)hipGetLastError(); per_cu = 1; }
        grid = cus * per_cu;
    }
    if (grid < 0) return;
    Params p{};
    for (int i = 0; i < 16; ++i) p.in[i] = (const float*)d_in[i];
    p.out = (float*)d_out; p.ws = (unsigned char*)d_ws;
    void* args[] = {&p};
    const hipError_t e = hipLaunchCooperativeKernel((const void*)mega_fwd, dim3(grid), dim3(NTHREADS), args, LDS_BYTES, stream);
    if (e != hipSuccess) fprintf(stderr, "kernel_launch: cooperative launch failed: %s (grid %d)\n", hipGetErrorString(e), grid);
}
```

```cpp
#include <hip/hip_runtime.h>
#include <hip/hip_cooperative_groups.h>
#include <cstdio>
#include <cstdint>
namespace cg = cooperative_groups;
namespace pg8 {
#define PG8_LAS __attribute__((address_space(3)))
typedef unsigned short bf16_t;
typedef short bf16x8 __attribute__((ext_vector_type(8)));
typedef float f32x4 __attribute__((ext_vector_type(4)));
typedef unsigned u32x4 __attribute__((ext_vector_type(4)));
constexpr int BM = 256, BK = 64, HALF = 128, HTB = HALF * BK * 2  , STAGE_BYTES = 8 * HTB, NXCD = 8, WGM = 8;

__host__ __device__ __forceinline__ int lds_byte(int r, int c) { const int st = (r >> 4) * 2 + (c >> 5), rr = r & 15, cc = c & 31, ob = rr * 64 + cc * 2; return st * 1024 + (ob ^ (((ob >> 9) & 1) << 5)); }
__host__ __device__ __forceinline__ void stage_rc(int b, int& R, int& C) { const int st = b / 1024, sb = b % 1024, swz = sb ^ (((sb >> 9) & 1) << 5); R = (st >> 1) * 16 + swz / 64; C = (st & 1) * 32 + (swz % 64) / 2; }
__host__ __device__ __forceinline__ int perm32(int rho) { const int n = rho >> 4, i = rho & 15; return 8 * (i >> 2) + 4 * n + (i & 3); }

struct Unit { int pm, pn; };
struct Gemm { const bf16_t* A; const bf16_t* Bt; int M, N, K; };

struct StaticOrder {
    int nM, nN, nwg, G, c;
    __host__ __device__ void init(int M, int N, int G_, int c_) { nM = M / BM; nN = N / BM; nwg = nM * nN; G = G_; c = c_; }
    __host__ __device__ bool next(int i, Unit& u) const {
        const long L = (long)i * G + c; if (L >= nwg) return false;
        int wgid = (int)L; { const int q = nwg / NXCD, r = nwg % NXCD, xcd = wgid % NXCD, off = wgid / NXCD; wgid = (xcd < r ? xcd * (q + 1) : r * (q + 1) + (xcd - r) * q) + off; }
        const int nig = WGM * nN, gid = wgid / nig, fm = gid * WGM, gsz = (nM - fm) < WGM ? (nM - fm) : WGM;
        u.pm = fm + ((wgid % nig) % gsz); u.pn = (wgid % nig) / gsz; return true;
    }
    __device__ __forceinline__ void a_ready(const Unit&) const {}
    __device__ __forceinline__ void done(const Unit&) const {}
};
__device__ __forceinline__ unsigned cvt_pk_bf16(float lo, float hi) { unsigned r; asm volatile("v_cvt_pk_bf16_f32 %0, %1, %2" : "=v"(r) : "v"(lo), "v"(hi)); return r; }
template <class Epi, class Sched, bool ALIGN_EPI = false, bool SP2 = false>
__device__ __forceinline__ void gemm_phase(PG8_LAS unsigned char* lds, const Gemm g, const Sched& S, const Epi& E) {
    int tid_ = threadIdx.x; asm volatile("" : "+v"(tid_));
    const int tid = tid_, wid = __builtin_amdgcn_readfirstlane(tid >> 6), lane = tid & 63, wr = wid >> 2, wc = wid & 3, fr = lane & 15, fq = lane >> 4;
    const int K = g.K, nt = K / BK;
    unsigned voffA[2], voffB[2];
#pragma unroll
    for (int i = 0; i < 2; ++i) { int R, C; stage_rc(tid * 16 + i * 8192, R, C); const int Rb = Epi::PERM ? ((R & ~31) + perm32(R & 31)) : R;
        voffA[i] = (unsigned)(R * K + C) * 2u; voffB[i] = (unsigned)(Rb * K + C) * 2u; }
    const size_t kstep = (size_t)(BK * 2);
    const size_t hstep = (size_t)HALF * K * 2;
    const size_t tstep = 2 * hstep;
    const unsigned ldsw = (unsigned)wid * 1024u;
    const int aoff = lds_byte(wr * 64 + fr, fq * 8), boff = lds_byte(wc * 32 + fr, fq * 8);
#define PG8_SA(b, h) (((b) * 2 + (h)) * HTB)
#define PG8_SB(b, h) ((4 + (b) * 2 + (h)) * HTB)
#define PG8_STAGE(bufoff, gbase, voff) do { _Pragma("unroll") for (int _i = 0; _i < 2; ++_i) \
        __builtin_amdgcn_global_load_lds((const unsigned*)((const char*)(gbase) + (voff)[_i]), (PG8_LAS unsigned*)(lds + (bufoff) + ldsw + _i * 8192), 16, 0, 0); } while (0)
#define PG8_LDA(dst, b, h) do { _Pragma("unroll") for (int m = 0; m < 4; ++m) _Pragma("unroll") for (int k = 0; k < 2; ++k) dst[m][k] = *(const PG8_LAS bf16x8*)(lds + PG8_SA(b, h) + aoff + m * 2048 + k * 1024); } while (0)
#define PG8_LDB(dst, b, h) do { _Pragma("unroll") for (int n = 0; n < 2; ++n) _Pragma("unroll") for (int k = 0; k < 2; ++k) dst[n][k] = *(const PG8_LAS bf16x8*)(lds + PG8_SB(b, h) + boff + n * 2048 + k * 1024); } while (0)
#define PG8_MMA(ai, bj, At, Bt) do { __builtin_amdgcn_s_setprio(1); _Pragma("unroll") for (int m = 0; m < 4; ++m) _Pragma("unroll") for (int n = 0; n < 2; ++n) _Pragma("unroll") for (int k = 0; k < 2; ++k) \
        acc[ai][bj][m][n] = __builtin_amdgcn_mfma_f32_16x16x32_bf16(Bt[n][k], At[m][k], acc[ai][bj][m][n], 0, 0, 0); __builtin_amdgcn_s_setprio(0); } while (0)
#define PG8_WAIT_V(n) asm volatile("s_waitcnt vmcnt(" #n ")" ::: "memory")
#define PG8_WAIT_L(n) asm volatile("s_waitcnt lgkmcnt(" #n ")" ::: "memory")
#define PG8_BAR __builtin_amdgcn_s_barrier()
#define PG8_SCHED __builtin_amdgcn_sched_barrier(0)
    Unit cur, nxt; int ui = 0;
    if (!S.next(0, cur)) return;
    f32x4 acc[2][2][4][2];
#pragma unroll
    for (int a = 0; a < 2; ++a)
#pragma unroll
        for (int b = 0; b < 2; ++b)
#pragma unroll
            for (int m = 0; m < 4; ++m)
#pragma unroll
                for (int n = 0; n < 2; ++n) acc[a][b][m][n] = (f32x4){0.f, 0.f, 0.f, 0.f};
    bf16x8 At[4][2], B0[2][2], B1[2][2];
    const char* cA = (const char*)g.A + (size_t)cur.pm * tstep; const char* cB = (const char*)g.Bt + (size_t)cur.pn * tstep;
    S.a_ready(cur);
    if constexpr (SP2) {
        PG8_STAGE(PG8_SB(0, 0), cB, voffB); PG8_STAGE(PG8_SB(0, 1), cB + hstep, voffB); PG8_STAGE(PG8_SA(0, 0), cA, voffA); PG8_STAGE(PG8_SA(0, 1), cA + hstep, voffA);
        if (wr == 1) PG8_BAR;
        PG8_WAIT_V(2); PG8_BAR;
        PG8_STAGE(PG8_SB(1, 0), cB + kstep, voffB); PG8_STAGE(PG8_SA(1, 0), cA + kstep, voffA); PG8_STAGE(PG8_SB(1, 1), cB + hstep + kstep, voffB);
        PG8_WAIT_V(6); PG8_BAR;
    } else {
        PG8_STAGE(PG8_SB(0, 0), cB, voffB); PG8_STAGE(PG8_SA(0, 0), cA, voffA); PG8_STAGE(PG8_SB(0, 1), cB + hstep, voffB); PG8_STAGE(PG8_SA(0, 1), cA + hstep, voffA);
        if (wr == 1) PG8_BAR;
        PG8_WAIT_V(4); PG8_BAR;
        PG8_STAGE(PG8_SB(1, 0), cB + kstep, voffB); PG8_STAGE(PG8_SA(1, 0), cA + kstep, voffA); PG8_STAGE(PG8_SB(1, 1), cB + hstep + kstep, voffB);
        PG8_WAIT_V(6); PG8_BAR;
    }
    for (;;) {
        const bool has_next = S.next(ui + 1, nxt);
        const char* nA = has_next ? (const char*)g.A + (size_t)nxt.pm * tstep : cA; const char* nB = has_next ? (const char*)g.Bt + (size_t)nxt.pn * tstep : cB;
        for (int t = 0; t < nt; t += 2) {
            const bool last = (t == nt - 2);
            const char* a1 = cA + (size_t)(t + 1) * kstep;
            const char* a2 = last ? nA : cA + (size_t)(t + 2) * kstep; const char* b2 = last ? nB : cB + (size_t)(t + 2) * kstep;
            const char* a3 = a2 + kstep; const char* b3 = b2 + kstep;
            if (last && has_next) S.a_ready(nxt);
            if constexpr (Epi::MID) { if (t == nt / 2) E.mid(acc, cur, wr, wc, fr, fq); }
            if constexpr (SP2) {
            PG8_LDB(B0, 0, 0); PG8_LDB(B1, 0, 1); PG8_SCHED; PG8_LDA(At, 0, 0); PG8_STAGE(PG8_SA(1, 1), a1 + hstep, voffA);
            PG8_WAIT_V(8); PG8_WAIT_L(0); PG8_BAR; PG8_MMA(0, 0, At, B0); PG8_MMA(0, 1, At, B1); PG8_BAR; PG8_SCHED;
            PG8_LDA(At, 0, 1); PG8_STAGE(PG8_SB(0, 0), b2, voffB); PG8_STAGE(PG8_SB(0, 1), b2 + hstep, voffB); PG8_STAGE(PG8_SA(0, 0), a2, voffA);
            PG8_WAIT_V(8); PG8_WAIT_L(0); PG8_BAR; PG8_MMA(1, 0, At, B0); PG8_MMA(1, 1, At, B1); PG8_BAR; PG8_SCHED;
            PG8_LDB(B0, 1, 0); PG8_LDB(B1, 1, 1); PG8_SCHED; PG8_LDA(At, 1, 0); PG8_STAGE(PG8_SA(0, 1), a2 + hstep, voffA);
            PG8_WAIT_V(8); PG8_WAIT_L(0); PG8_BAR; PG8_MMA(0, 0, At, B0); PG8_MMA(0, 1, At, B1); PG8_BAR; PG8_SCHED;
            PG8_LDA(At, 1, 1); PG8_STAGE(PG8_SB(1, 0), b3, voffB); PG8_STAGE(PG8_SB(1, 1), b3 + hstep, voffB); PG8_STAGE(PG8_SA(1, 0), a3, voffA);
            PG8_WAIT_V(8); PG8_WAIT_L(0); PG8_BAR; PG8_MMA(1, 0, At, B0); PG8_MMA(1, 1, At, B1); PG8_BAR; PG8_SCHED;
            } else {
            PG8_LDB(B0, 0, 0); PG8_SCHED; PG8_LDA(At, 0, 0); PG8_STAGE(PG8_SA(1, 1), a1 + hstep, voffA);
            PG8_WAIT_L(8); PG8_BAR; PG8_WAIT_L(0); PG8_MMA(0, 0, At, B0); PG8_BAR; PG8_SCHED;
            PG8_LDB(B1, 0, 1); PG8_STAGE(PG8_SB(0, 0), b2, voffB);
            PG8_BAR; PG8_WAIT_L(0); PG8_MMA(0, 1, At, B1); PG8_BAR;
            PG8_LDA(At, 0, 1); PG8_STAGE(PG8_SA(0, 0), a2, voffA);
            PG8_BAR; PG8_WAIT_L(0); PG8_MMA(1, 0, At, B0); PG8_BAR; PG8_SCHED;
            PG8_STAGE(PG8_SB(0, 1), b2 + hstep, voffB);
            PG8_WAIT_V(6); PG8_BAR; PG8_MMA(1, 1, At, B1); PG8_BAR;
            PG8_LDB(B0, 1, 0); PG8_SCHED; PG8_LDA(At, 1, 0); PG8_STAGE(PG8_SA(0, 1), a2 + hstep, voffA);
            PG8_WAIT_L(8); PG8_BAR; PG8_WAIT_L(0); PG8_MMA(0, 0, At, B0); PG8_BAR; PG8_SCHED;
            PG8_LDB(B1, 1, 1); PG8_STAGE(PG8_SB(1, 0), b3, voffB);
            PG8_BAR; PG8_WAIT_L(0); PG8_MMA(0, 1, At, B1); PG8_BAR;
            PG8_LDA(At, 1, 1); PG8_STAGE(PG8_SA(1, 0), a3, voffA);
            PG8_BAR; PG8_WAIT_L(0); PG8_MMA(1, 0, At, B0); PG8_BAR; PG8_SCHED;
            PG8_STAGE(PG8_SB(1, 1), b3 + hstep, voffB);
            PG8_WAIT_V(6); PG8_BAR; PG8_MMA(1, 1, At, B1); PG8_BAR;
            }
        }
        if constexpr (ALIGN_EPI) { if (wr == 0) PG8_BAR; }
        if constexpr (!Epi::AFTER_DRAIN) { E(acc, cur, wr, wc, fr, fq); S.done(cur); }
        if (!has_next) break;
#pragma unroll
        for (int a = 0; a < 2; ++a)
#pragma unroll
            for (int b = 0; b < 2; ++b)
#pragma unroll
                for (int m = 0; m < 4; ++m)
#pragma unroll
                    for (int n = 0; n < 2; ++n) acc[a][b][m][n] = (f32x4){0.f, 0.f, 0.f, 0.f};
        cur = nxt; cA = nA; cB = nB; ++ui;
        if constexpr (ALIGN_EPI) { if (wr == 1) PG8_BAR; }
    }
    PG8_WAIT_V(0);
    if constexpr (!ALIGN_EPI) { if (wr == 0) PG8_BAR; }
    PG8_BAR;
    if constexpr (Epi::AFTER_DRAIN) { E.fused(acc, cur, wr, wc, fr, fq, lds, wid, lane); S.done(cur); }
#undef PG8_SA
#undef PG8_SB
#undef PG8_STAGE
#undef PG8_LDA
#undef PG8_LDB
#undef PG8_MMA
#undef PG8_WAIT_V
#undef PG8_WAIT_L
#undef PG8_BAR
#undef PG8_SCHED
}
}

#define LAS __attribute__((address_space(3)))
typedef unsigned short bf16;
typedef float f32x4 __attribute__((ext_vector_type(4)));
typedef short bf16x8 __attribute__((ext_vector_type(8)));
typedef unsigned u32x4 __attribute__((ext_vector_type(4)));
typedef unsigned u32x2 __attribute__((ext_vector_type(2)));

constexpr int D = 1024, BATCH = 2, SEQ = 16384, T = BATCH * SEQ, DEPTH = 2;
constexpr int IN_TOTAL = 5648, NP = 5632, NP1 = 3584, NPG = 2048;
constexpr int TW = 256;
__host__ __device__ constexpr size_t tile_off(int col) { return (size_t)(col >> 8) * ((size_t)32768 * 256) + (size_t)(col & 255); }
constexpr int G_CH = 8;
constexpr int NCHUNK = SEQ / 64;
constexpr int NG = NCHUNK / G_CH;
constexpr int NTHREADS = 512, NWAVES = 8;
constexpr int LDS_BYTES = 147456;
constexpr float EPS = 1e-6f;

constexpr int C_GQ = 0, C_GK = 256, C_GV = 512, C_GZ = 1024, C_HQ = 1536, C_HF = 2048, C_HI = 2560, C_HZ = 3072;

constexpr size_t MiB = 1u << 20;
constexpr size_t WS_MOD = 0;
constexpr size_t WS_BAR = 512 * 1024;
constexpr size_t WS_WIN = 1 * MiB;
constexpr size_t WS_WUP = 23 * MiB;
constexpr size_t WS_WOUT = 27 * MiB;
constexpr size_t WS_STATE = 32 * MiB;
constexpr size_t WS_STATE_HG = WS_STATE + 8 * MiB;
constexpr size_t WS_PDEC = 56 * MiB;
constexpr size_t WS_WLR = 57 * MiB;
constexpr size_t WS_LOGA = 64 * MiB;
constexpr size_t WS_H = 96 * MiB;
constexpr size_t WS_P1 = 160 * MiB;
constexpr size_t WS_PG = 384 * MiB;
constexpr size_t WS_END = 512 * MiB;

struct Params { const float* in[16]; float* out; unsigned char* ws; };

__device__ __forceinline__ float bf2f(unsigned short b) { return __builtin_bit_cast(float, (unsigned)b << 16); }
__device__ __forceinline__ float bflo(unsigned w) { return __builtin_bit_cast(float, w << 16); }
__device__ __forceinline__ float bfhi(unsigned w) { return __builtin_bit_cast(float, w & 0xffff0000u); }
__device__ __forceinline__ unsigned f2bf(float f) { unsigned u = __builtin_bit_cast(unsigned, f); return (u + 0x7fffu + ((u >> 16) & 1u)) >> 16; }
__device__ __forceinline__ unsigned pk2(float lo, float hi) { return f2bf(lo) | (f2bf(hi) << 16); }
__device__ __forceinline__ float sigmoidf_(float x) { return 1.0f / (1.0f + __expf(-x)); }
__device__ __forceinline__ float wave_sum(float v) {
#pragma unroll
    for (int o = 1; o < 64; o <<= 1) v += __shfl_xor(v, o);
    return v;
}
#define LDS_WAIT() asm volatile("s_waitcnt lgkmcnt(0)" ::: "memory")

namespace pg8 {
struct EpiIn {
    static constexpr bool PERM = true, AFTER_DRAIN = false, MID = false;
    bf16_t* P1; bf16_t* PG; const float* bias;
    __device__ __forceinline__ void operator()(const f32x4 (&acc)[2][2][4][2], const Unit& u, int wr, int wc, int fr, int fq) const {
        const int pn = u.pn;
        const int row0 = u.pm * BM + wr * 64 + fr;
        if (pn >= 14) {
            const int ch0 = (pn - 14) * 128 + wc * 32 + 8 * fq;
            f32x4 ba[2], bb[2];
#pragma unroll
            for (int n = 0; n < 2; ++n) { ba[n] = *(const f32x4*)(bias + ch0 + 4 * n); bb[n] = *(const f32x4*)(bias + 1024 + ch0 + 4 * n); }
#pragma unroll
            for (int ai = 0; ai < 2; ++ai)
#pragma unroll
                for (int m = 0; m < 4; ++m) { bf16_t* rowp = PG + tile_off(ch0 & ~31) + (size_t)(row0 + ai * HALF + m * 16) * TW + (ch0 & 31);
                    f32x4 r[2], g[2];
#pragma unroll
                    for (int n = 0; n < 2; ++n) { const f32x4 a = acc[ai][0][m][n] + ba[n], b = acc[ai][1][m][n] + bb[n];
#pragma unroll
                        for (int j = 0; j < 4; ++j) { const float ea = __expf(-a[j]), eb = __expf(-b[j]); g[n][j] = __builtin_amdgcn_rcpf(1.0f + eb); r[n][j] = (1.0f + eb) * __builtin_amdgcn_rcpf(1.0f + ea); } }
                    u32x4 w; w.x = cvt_pk_bf16(r[0][0], r[0][1]); w.y = cvt_pk_bf16(r[0][2], r[0][3]); w.z = cvt_pk_bf16(r[1][0], r[1][1]); w.w = cvt_pk_bf16(r[1][2], r[1][3]);
                    *(u32x4*)rowp = w;
                    w.x = cvt_pk_bf16(g[0][0], g[0][1]); w.y = cvt_pk_bf16(g[0][2], g[0][3]); w.z = cvt_pk_bf16(g[1][0], g[1][1]); w.w = cvt_pk_bf16(g[1][2], g[1][3]);
                    *(u32x4*)(rowp + tile_off(1024)) = w; }
            return;
        }
        int mode = 0; float scl = 1.0f;
        if (pn == 0) scl = 0.125f;
        else if (pn == 4 || pn == 5 || pn == 12 || pn == 13) mode = 1;
        else if (pn == 6 || pn == 7) { mode = 1; scl = 0.08838834764831845f; }
        const int col0 = pn * 256 + wc * 32 + 8 * fq;
#pragma unroll
        for (int ai = 0; ai < 2; ++ai)
#pragma unroll
            for (int m = 0; m < 4; ++m) { bf16_t* rowp = P1 + tile_off(pn * 256) + (size_t)(row0 + ai * HALF + m * 16) * TW + (col0 & 255);
#pragma unroll
                for (int bj = 0; bj < 2; ++bj) { f32x4 v0 = acc[ai][bj][m][0], v1 = acc[ai][bj][m][1];
                    if (mode == 0) { v0 = v0 * scl; v1 = v1 * scl; }
                    else {
#pragma unroll
                        for (int j = 0; j < 4; ++j) { v0[j] = v0[j] * scl * __builtin_amdgcn_rcpf(1.0f + __expf(-v0[j])); v1[j] = v1[j] * scl * __builtin_amdgcn_rcpf(1.0f + __expf(-v1[j])); } }
                    u32x4 w; w.x = cvt_pk_bf16(v0[0], v0[1]); w.y = cvt_pk_bf16(v0[2], v0[3]); w.z = cvt_pk_bf16(v1[0], v1[1]); w.w = cvt_pk_bf16(v1[2], v1[3]);
                    *(u32x4*)(rowp + bj * HALF) = w; } }
    }
};
struct EpiUp {
    static constexpr bool PERM = true, AFTER_DRAIN = false, MID = true;
    const bf16_t* PG; bf16_t* Mo;
    __device__ __forceinline__ void mid(f32x4 (&acc)[2][2][4][2], const Unit& u, int wr, int wc, int fr_, int fq) const {
        int fr = fr_; asm volatile("" : "+v"(fr));
        const int row0 = u.pm * BM + wr * 64 + fr, col0 = u.pn * BM + wc * 32 + 8 * fq;
#pragma unroll
        for (int ai = 0; ai < 2; ++ai) {
            u32x4 rv[4][2];
#pragma unroll
            for (int m = 0; m < 4; ++m) { const bf16_t* gp = PG + tile_off(u.pn * 256) + (size_t)(row0 + ai * HALF + m * 16) * TW + (col0 & 255);
#pragma unroll
                for (int bj = 0; bj < 2; ++bj) rv[m][bj] = *(const u32x4*)(gp + bj * HALF); }
#pragma unroll
            for (int m = 0; m < 4; ++m)
#pragma unroll
                for (int bj = 0; bj < 2; ++bj) { const u32x4 ga = rv[m][bj];
                    acc[ai][bj][m][0] = acc[ai][bj][m][0] * (f32x4){bflo(ga.x), bfhi(ga.x), bflo(ga.y), bfhi(ga.y)};
                    acc[ai][bj][m][1] = acc[ai][bj][m][1] * (f32x4){bflo(ga.z), bfhi(ga.z), bflo(ga.w), bfhi(ga.w)}; }
            __builtin_amdgcn_sched_barrier(0);
        }
    }
    __device__ __forceinline__ void operator()(const f32x4 (&acc)[2][2][4][2], const Unit& u, int wr, int wc, int fr, int fq) const {
        const int row0 = u.pm * BM + wr * 64 + fr, col0 = u.pn * BM + wc * 32 + 8 * fq;
#pragma unroll
        for (int ai = 0; ai < 2; ++ai)
#pragma unroll
            for (int m = 0; m < 4; ++m) { const size_t row = (size_t)(row0 + ai * HALF + m * 16); const bf16_t* gp = PG + tile_off(1024 + u.pn * 256) + row * TW + (col0 & 255); bf16_t* op = Mo + row * D + col0;
#pragma unroll
                for (int bj = 0; bj < 2; ++bj) { const u32x4 gb = *(const u32x4*)(gp + bj * HALF);
                    const f32x4 a0 = acc[ai][bj][m][0], a1 = acc[ai][bj][m][1];
                    u32x4 w; w.x = cvt_pk_bf16(a0[0] * bflo(gb.x), a0[1] * bfhi(gb.x)); w.y = cvt_pk_bf16(a0[2] * bflo(gb.y), a0[3] * bfhi(gb.y));
                    w.z = cvt_pk_bf16(a1[0] * bflo(gb.z), a1[1] * bfhi(gb.z)); w.w = cvt_pk_bf16(a1[2] * bflo(gb.w), a1[3] * bfhi(gb.w));
                    *(u32x4*)(op + bj * HALF) = w; } }
    }
};
template <bool XBF> struct EpiOut {
    static constexpr bool PERM = true, AFTER_DRAIN = false, MID = false;
    const void* xin; bf16_t* out; const float* gate2;
    __device__ __forceinline__ void operator()(const f32x4 (&acc)[2][2][4][2], const Unit& u, int wr, int wc, int fr, int fq) const {
        const int row0 = u.pm * BM + wr * 64 + fr, col0 = u.pn * BM + wc * 32 + 8 * fq;
        const float* gate = gate2 + ((u.pm * BM) / SEQ) * 3072;
        f32x4 gv[2][2];
#pragma unroll
        for (int bj = 0; bj < 2; ++bj)
#pragma unroll
            for (int n = 0; n < 2; ++n) gv[bj][n] = *(const f32x4*)(gate + col0 + bj * HALF + 4 * n);
#pragma unroll
        for (int ai = 0; ai < 2; ++ai)
#pragma unroll
            for (int m = 0; m < 4; ++m) { const size_t off = (size_t)(row0 + ai * HALF + m * 16) * D + col0;
#pragma unroll
                for (int bj = 0; bj < 2; ++bj) { f32x4 x0, x1;
                    if (XBF) { const u32x4 xb = *(const u32x4*)((const bf16_t*)xin + off + bj * HALF);
                        x0 = (f32x4){__builtin_bit_cast(float, xb.x << 16), __builtin_bit_cast(float, xb.x & 0xffff0000u), __builtin_bit_cast(float, xb.y << 16), __builtin_bit_cast(float, xb.y & 0xffff0000u)};
                        x1 = (f32x4){__builtin_bit_cast(float, xb.z << 16), __builtin_bit_cast(float, xb.z & 0xffff0000u), __builtin_bit_cast(float, xb.w << 16), __builtin_bit_cast(float, xb.w & 0xffff0000u)}; }
                    else { x0 = *(const f32x4*)((const float*)xin + off + bj * HALF); x1 = *(const f32x4*)((const float*)xin + off + bj * HALF + 4); }
                    const f32x4 y0 = x0 + gv[bj][0] * acc[ai][bj][m][0], y1 = x1 + gv[bj][1] * acc[ai][bj][m][1];
                    u32x4 w; w.x = cvt_pk_bf16(y0[0], y0[1]); w.y = cvt_pk_bf16(y0[2], y0[3]); w.z = cvt_pk_bf16(y1[0], y1[1]); w.w = cvt_pk_bf16(y1[2], y1[3]);
                    *(u32x4*)(out + off + bj * HALF) = w; } }
    }
};
}

__device__ __forceinline__ void transpose_item(const float* W, int ldw, int src_col0, int k0, bf16* WT, int dst_row0, int dst_k0, LAS float* scr, int lane) {
#pragma unroll
    for (int i = 0; i < 32; ++i) { const int kk = 2 * i + (lane >> 5); scr[kk * 33 + (lane & 31)] = W[(size_t)(k0 + kk) * ldw + src_col0 + (lane & 31)]; }
    LDS_WAIT();
    const int c = lane & 7;
#pragma unroll
    for (int j = 0; j < 4; ++j) { const int n = (lane >> 3) + 8 * j; const LAS float* s = scr + (8 * c) * 33 + n;
        u32x4 o; o.x = pk2(s[0 * 33], s[1 * 33]); o.y = pk2(s[2 * 33], s[3 * 33]); o.z = pk2(s[4 * 33], s[5 * 33]); o.w = pk2(s[6 * 33], s[7 * 33]);
        *(u32x4*)(WT + (size_t)(dst_row0 + n) * D + dst_k0 + 8 * c) = o; }
    LDS_WAIT();
}

__device__ __forceinline__ void phase_prologue(const Params& p, LAS unsigned char* lds) {
    int tid_ = threadIdx.x; asm volatile("" : "+v"(tid_));
    const int tid = tid_, lane = tid & 63, wave = tid >> 6;
    unsigned char* ws = p.ws;
    for (int task = blockIdx.x; task < DEPTH * 96; task += gridDim.x) {
        const int l = task / 96, cgp = task % 96, col = tid & 31, ks = tid >> 5;
        const float* W = p.in[3] + (size_t)l * D * 3072 + cgp * 32 + col;
        const float* c0 = p.in[1], *c1 = p.in[1] + D;
        float s0 = 0.f, s1 = 0.f;
#pragma unroll 16
        for (int k = ks * 64; k < ks * 64 + 64; ++k) { const float w = W[(size_t)k * 3072]; const float a = c0[k], b = c1[k];
            s0 += a * sigmoidf_(a) * w; s1 += b * sigmoidf_(b) * w; }
        LAS float* red = (LAS float*)(lds + 98304);
        red[(ks * 32 + col) * 2 + 0] = s0; red[(ks * 32 + col) * 2 + 1] = s1;
        __syncthreads();
        if (tid < 64) { const int cc = tid & 31, bb = tid >> 5; float s = 0.f;
#pragma unroll
            for (int k = 0; k < 16; ++k) s += red[(k * 32 + cc) * 2 + bb];
            const int cglob = cgp * 32 + cc;
            ((float*)(ws + WS_MOD))[(l * BATCH + bb) * 3072 + cglob] = s + p.in[4][l * 3072 + cglob]; }
        __syncthreads();
    }
    LAS float* scr = (LAS float*)(lds + wave * 8704);
    const int gw = blockIdx.x * NWAVES + wave, NGW = gridDim.x * NWAVES;
    constexpr int I_IN = 16 * 176, I_UP = 8 * 32, I_OUT = 16 * 32, I_LR = 16, I_L = I_IN + 2 * I_UP + I_OUT + I_LR;
    for (int it = gw; it < DEPTH * I_L; it += NGW) {
        const int l = it / I_L; int r = it % I_L;
        if (r < I_IN) { const int kb = r / 176, nb = r % 176, n0 = 32 * nb;
            transpose_item(p.in[5] + (size_t)l * D * IN_TOTAL, IN_TOTAL, n0 < 1536 ? n0 : (n0 < 3584 ? n0 + 16 : 3600 + (((n0 - 3584) >> 7) & 1) * 1024 + ((n0 - 3584) >> 8) * 128 + (n0 & 127)), 64 * kb, (bf16*)(ws + WS_WIN) + (size_t)l * NP * D, n0, 64 * kb, scr, lane); continue; }
        r -= I_IN;
        if (r < I_UP) { const int kb = r / 32, nb = r % 32;
            transpose_item(p.in[12] + (size_t)l * 512 * D, D, 32 * nb, 64 * kb, (bf16*)(ws + WS_WUP) + (size_t)l * D * D, 32 * nb, 64 * kb, scr, lane); continue; }
        r -= I_UP;
        if (r < I_UP) { const int kb = r / 32, nb = r % 32;
            transpose_item(p.in[13] + (size_t)l * 512 * D, D, 32 * nb, 64 * kb, (bf16*)(ws + WS_WUP) + (size_t)l * D * D, 32 * nb, 512 + 64 * kb, scr, lane); continue; }
        r -= I_UP;
        if (r >= I_OUT) { const int kb = r - I_OUT;
            transpose_item(p.in[5] + (size_t)l * D * IN_TOTAL, IN_TOTAL, 1536, 64 * kb, (bf16*)(ws + WS_WLR) + (size_t)l * 32 * D, 0, 64 * kb, scr, lane); continue; }
        { const int kb = r / 32, nb = r % 32;
            transpose_item(p.in[14] + (size_t)l * D * D, D, 32 * nb, 64 * kb, (bf16*)(ws + WS_WOUT) + (size_t)l * D * D, 32 * nb, 64 * kb, scr, lane); }
    }
}

template <bool XBF> struct XRaw;
template <> struct XRaw<false> { typedef f32x4 T; static __device__ __forceinline__ f32x4 cvt(const f32x4& v) { return v; } };
template <> struct XRaw<true> { typedef u32x2 T; static __device__ __forceinline__ f32x4 cvt(const u32x2& v) { return (f32x4){bflo(v.x), bfhi(v.x), bflo(v.y), bfhi(v.y)}; } };
template <bool XBF>
__device__ __forceinline__ void phase_norm(const Params& p, LAS unsigned char* lds, int l, const void* xin_) {
    int tid_ = threadIdx.x; asm volatile("" : "+v"(tid_));
    const int tid = tid_, lane = tid & 63, wave = tid >> 6, m = lane & 15, q = lane >> 4;
    unsigned char* ws = p.ws;
    constexpr int TRS = 2064;
    LAS unsigned char* tile = lds + wave * (8 * TRS);
    LAS float* wscr = (LAS float*)(lds + 8 * 8 * TRS) + wave * 128;
    f32x4 wa2r[16];
#pragma unroll
    for (int n = 0; n < 16; ++n) wa2r[n] = *(const f32x4*)(p.in[6] + l * 4096 + n * 256 + lane * 4);
    f32x4 nw[4];
#pragma unroll
    for (int j = 0; j < 4; ++j) nw[j] = *(const f32x4*)(p.in[2] + l * D + lane * 4 + 256 * j);
    const f32x4 ba4 = *(const f32x4*)(p.in[7] + l * 256 + lane * 4);
    const float* mod = (const float*)(ws + WS_MOD) + (size_t)l * BATCH * 3072;
    bf16* H = (bf16*)(ws + WS_H); bf16* LA = (bf16*)(ws + WS_LOGA);
    const bf16* wlr = (const bf16*)(ws + WS_WLR) + (size_t)l * 32 * D + m * D + q * 8;
    const LAS unsigned char* arow = tile + (m & 7) * TRS + q * 16;
    const int gw = blockIdx.x * NWAVES + wave, NGW = gridDim.x * NWAVES;
    int bcur = -1;
    typedef typename XRaw<XBF>::T xraw_t;
    f32x4 hm[4], ha[4]; xraw_t xn[2][4];
    if (gw * 8 < T) {
#pragma unroll
        for (int rr = 0; rr < 2; ++rr)
#pragma unroll
            for (int j = 0; j < 4; ++j) xn[rr][j] = ((const xraw_t*)xin_ + (size_t)(gw * 8 + rr) * (D / 4) + lane)[64 * j]; }
#pragma unroll 1
    for (int t = gw; t < T / 8; t += NGW) {
        const int r0 = t * 8, b = r0 / SEQ;
        if (b != bcur) { bcur = b;
#pragma unroll
            for (int j = 0; j < 4; ++j) { ha[j] = *(const f32x4*)(mod + b * 3072 + lane * 4 + 256 * j); const f32x4 sc = *(const f32x4*)(mod + b * 3072 + 1024 + lane * 4 + 256 * j); hm[j] = nw[j] * (1.0f + sc); } }
#pragma unroll 1
        for (int rp = 0; rp < 4; ++rp) {
            f32x4 hv[2][4];
#pragma unroll
            for (int rr = 0; rr < 2; ++rr)
#pragma unroll
                for (int j = 0; j < 4; ++j) hv[rr][j] = XRaw<XBF>::cvt(xn[rr][j]);
            {
                int rn = r0 + 2 * rp + 2;
                if (rp == 3) rn = (t + NGW < T / 8) ? (t + NGW) * 8 : r0;
#pragma unroll
                for (int rr = 0; rr < 2; ++rr)
#pragma unroll
                    for (int j = 0; j < 4; ++j) xn[rr][j] = ((const xraw_t*)xin_ + (size_t)(rn + rr) * (D / 4) + lane)[64 * j];
            }
#pragma unroll
            for (int rr = 0; rr < 2; ++rr) {
                float s = 0.f;
#pragma unroll
                for (int j = 0; j < 4; ++j) s += (hv[rr][j].x * hv[rr][j].x + hv[rr][j].y * hv[rr][j].y) + (hv[rr][j].z * hv[rr][j].z + hv[rr][j].w * hv[rr][j].w);
                const float rstd = __builtin_amdgcn_rsqf(wave_sum(s) * (1.0f / D) + EPS);
                const int row = 2 * rp + rr;
                u32x2* o8 = (u32x2*)(H + (size_t)(r0 + row) * D) + lane;
                LAS u32x2* t8 = (LAS u32x2*)(tile + row * TRS) + lane;
#pragma unroll
                for (int j = 0; j < 4; ++j) { const f32x4 hh = hv[rr][j] * rstd * hm[j] + ha[j];
                    const u32x2 pk = (u32x2){pg8::cvt_pk_bf16(hh.x, hh.y), pg8::cvt_pk_bf16(hh.z, hh.w)};
                    o8[64 * j] = pk; t8[64 * j] = pk; }
            }
        }
        LDS_WAIT();
        f32x4 acc = (f32x4){0.f, 0.f, 0.f, 0.f};
#pragma unroll 8
        for (int ks = 0; ks < 32; ++ks) {
            const bf16x8 af = *(const LAS bf16x8*)(arow + ks * 64);
            const bf16x8 bfr = *(const bf16x8*)(wlr + ks * 32);
            acc = __builtin_amdgcn_mfma_f32_16x16x32_bf16(af, bfr, acc, 0, 0, 0);
        }
        if (q < 2) {
#pragma unroll
            for (int j = 0; j < 4; ++j) wscr[(q * 4 + j) * 16 + m] = acc[j]; }
        LDS_WAIT();
#pragma unroll 2
        for (int row = 0; row < 8; ++row) {
            f32x4 z = ba4;
#pragma unroll
            for (int n4 = 0; n4 < 4; ++n4) { const f32x4 g = *(const LAS f32x4*)(wscr + row * 16 + n4 * 4);
                z += wa2r[n4 * 4 + 0] * g.x; z += wa2r[n4 * 4 + 1] * g.y; z += wa2r[n4 * 4 + 2] * g.z; z += wa2r[n4 * 4 + 3] * g.w; }
            f32x4 lo;
#pragma unroll
            for (int i = 0; i < 4; ++i) lo[i] = -(fmaxf(-z[i], 0.f) + __logf(1.0f + __expf(-fabsf(z[i])))) * 0.0625f;
            *(u32x2*)(LA + (size_t)(r0 + row) * 256 + lane * 4) = (u32x2){pg8::cvt_pk_bf16(lo[0], lo[1]), pg8::cvt_pk_bf16(lo[2], lo[3])};
        }
        LDS_WAIT();
    }
}

constexpr int MX_KD = 0, MX_QS = 16384, MX_OCT = 33792, MX_ADEC = 37888, MX_OT = 38400, MX_RA = 72192, MX_RV = 89600;
constexpr int MX_QS2 = 107008;
constexpr int MX_RSV = 272;

#define TR_READ(dst, addr, OFF) asm volatile("ds_read_b64_tr_b16 %0, %1 offset:%2" : "=&v"(dst) : "v"(addr), "n"(OFF) : "memory")

template <bool HG, bool FIN>
__device__ __forceinline__ void mixer_unit(const Params& p, LAS unsigned char* lds, int l, int b, int h, int jg) {
    constexpr int DK = HG ? 128 : 64, KT = DK / 16, QSTR = DK + 8, RSA = DK * 2 + 16;
    constexpr int KCOL = HG ? C_HF : C_GK, VCOL = HG ? C_HI : C_GV, QCOL = HG ? C_HQ : C_GQ, ZCOL = HG ? C_HZ : C_GZ;
    constexpr int NOCT = HG ? 2 : 1;
    constexpr int PPR = DK / 8, NQ = (64 * PPR) / NTHREADS;
    int tid_ = threadIdx.x; asm volatile("" : "+v"(tid_));
    const int tid = tid_, lane = tid & 63, w = tid >> 6, n = lane & 15, q = lane >> 4, qq = n >> 2, pp = lane & 3;
    unsigned char* ws = p.ws;
    const bf16* P1 = (const bf16*)(ws + WS_P1);
    const bf16* LA = (const bf16*)(ws + WS_LOGA);
    bf16* OB = (bf16*)(ws + WS_H);
    bf16* SB = (bf16*)(ws + (HG ? WS_STATE_HG : WS_STATE)) + (size_t)((b * 4 + h) * NG + jg) * (DK * 128);
    float* PD = (float*)(ws + WS_PDEC) + (size_t)(((HG ? 0 : 8) + b * 4 + h) * NG + jg) * 128;
    LAS unsigned char* KD = lds + MX_KD;
    LAS bf16* QS = (LAS bf16*)(lds + MX_QS);
    LAS float* OCT = (LAS float*)(lds + MX_OCT);
    LAS float* ADEC = (LAS float*)(lds + MX_ADEC);
    LAS float* OT = (LAS float*)(lds + MX_OT);
    LAS unsigned char* RA = lds + MX_RA;
    LAS unsigned char* RV = lds + MX_RV;

    const int c = HG ? (tid & 127) : (tid & 63);
    const int o_first = HG ? (tid >> 7) : (tid >> 6);
    const unsigned tra = (unsigned)(size_t)RA + (unsigned)((o_first * 8 + qq) * RSA + ((c & ~15) + 4 * pp) * 2);
    const unsigned trv = (unsigned)(size_t)RV + (unsigned)((8 * q + qq) * MX_RSV + (16 * w + 4 * pp) * 2);
    float lb = 0.f, lbf = 1e-30f, oml = 1.0f;
    if (HG) { if (l > 0) { const float g0 = p.in[9][h * 128 + c], g1 = p.in[9][512 + h * 128 + c]; lb = 1.0f / (1.0f + __expf(g0 - g1)); lb = fminf(fmaxf(lb, 0.f), 1.0f - 1e-6f); }
        lbf = fmaxf(lb, 1e-30f); oml = 1.0f - lb; }
    float nwv[16];
    if (FIN) { const float* nwp = (HG ? p.in[10] : p.in[8]) + l * 128 + (tid & 7) * 16;
#pragma unroll
        for (int i = 0; i < 16; ++i) nwv[i] = nwp[i]; }

    f32x4 S[KT];
    if (FIN) {
#pragma unroll
        for (int kt = 0; kt < KT; ++kt) { const u32x2 sv = *(const u32x2*)(SB + (size_t)((w * KT + kt) * 64 + lane) * 4); S[kt] = (f32x4){bflo(sv.x), bfhi(sv.x), bflo(sv.y), bfhi(sv.y)}; }
    } else {
#pragma unroll
        for (int kt = 0; kt < KT; ++kt) S[kt] = (f32x4){0.f, 0.f, 0.f, 0.f};
    }
    float pprod = 1.0f;

    const int rowg = b * SEQ + jg * G_CH * 64;
    u32x4 araw[NQ], vraw[2], qraw[NQ], zraw[2]; unsigned short laraw[8];
    const bf16* aptr = P1 + tile_off(KCOL + h * DK) + (size_t)rowg * TW;
    const bf16* laptr = LA + (size_t)rowg * 256 + h * 64 + c;
    const bf16* vptr = P1 + tile_off(VCOL + h * 128) + (size_t)rowg * TW;
    const bf16* qptr = P1 + tile_off(QCOL + h * DK) + (size_t)rowg * TW;
    const bf16* zptr = P1 + tile_off(ZCOL + h * 128) + (size_t)(rowg + (tid >> 3)) * TW + (tid & 7) * 16;
#define MX_LOAD_A(cc_) do { const size_t ro_ = (size_t)(cc_) * 64; \
        _Pragma("unroll") for (int pq = 0; pq < NQ; ++pq) { const int pc = tid + pq * NTHREADS; araw[pq] = *(const u32x4*)(aptr + (ro_ + pc / PPR) * TW + (pc % PPR) * 8); } \
        if (!HG) { _Pragma("unroll") for (int i = 0; i < 8; ++i) laraw[i] = laptr[(ro_ + o_first * 8 + i) * 256]; } } while (0)
#define MX_LOAD_V(cc_) do { const size_t ro_ = (size_t)(cc_) * 64; \
        _Pragma("unroll") for (int pq = 0; pq < 2; ++pq) { const int pc = tid + pq * NTHREADS; vraw[pq] = *(const u32x4*)(vptr + (ro_ + pc / 16) * TW + (pc % 16) * 8); } } while (0)
#define MX_LOAD_Q(cc_) do { const size_t ro_ = (size_t)(cc_) * 64; \
        _Pragma("unroll") for (int pq = 0; pq < NQ; ++pq) { const int pc = tid + pq * NTHREADS; qraw[pq] = *(const u32x4*)(qptr + (ro_ + pc / PPR) * TW + (pc % PPR) * 8); } } while (0)
#define MX_LOAD_Z(cc_) do { const size_t ro_ = (size_t)(cc_) * 64; zraw[0] = *(const u32x4*)(zptr + ro_ * TW); zraw[1] = *(const u32x4*)(zptr + ro_ * TW + 8); } while (0)
    MX_LOAD_A(0); MX_LOAD_V(0);
    if (FIN) { MX_LOAD_Q(0); MX_LOAD_Z(0); }
    float lacur[8];
#define MX_RAW_TO_LDS(qb_) do { \
        _Pragma("unroll") for (int pq = 0; pq < NQ; ++pq) { const int pc = tid + pq * NTHREADS; *(LAS u32x4*)(RA + (pc / PPR) * RSA + (pc % PPR) * 16) = araw[pq]; } \
        _Pragma("unroll") for (int pq = 0; pq < 2; ++pq) { const int pc = tid + pq * NTHREADS; *(LAS u32x4*)(RV + (pc / 16) * MX_RSV + (pc % 16) * 16) = vraw[pq]; } \
        if (FIN) { LAS bf16* qd_ = (LAS bf16*)(lds + ((qb_) ? MX_QS2 : MX_QS)); \
            _Pragma("unroll") for (int pq = 0; pq < NQ; ++pq) { const int pc = tid + pq * NTHREADS; *(LAS u32x4*)(qd_ + (pc / PPR) * QSTR + (pc % PPR) * 8) = qraw[pq]; } } \
        if (!HG) { _Pragma("unroll") for (int i = 0; i < 8; ++i) lacur[i] = bf2f(laraw[i]); } } while (0)
    MX_RAW_TO_LDS(0);
    { const int c1 = (1 < G_CH) ? 1 : 0; MX_LOAD_A(c1); MX_LOAD_V(c1); if (FIN) MX_LOAD_Q(c1); }
    LDS_WAIT(); __syncthreads();

#pragma unroll 1
    for (int cc = 0; cc < G_CH; ++cc) {
        const int ccn = (cc + 1 < G_CH) ? cc + 1 : cc;
        const int cc2 = (cc + 2 < G_CH) ? cc + 2 : G_CH - 1;
        const int row0 = rowg + cc * 64;
        const LAS bf16* QSc = (const LAS bf16*)(lds + ((cc & 1) ? MX_QS2 : MX_QS));
        u32x2 art[NOCT][2], vrt[2][2];
        TR_READ(art[0][0], tra, 0); TR_READ(art[0][1], tra, 4 * RSA);
        if (HG) { TR_READ(art[NOCT - 1][0], tra, 32 * RSA); TR_READ(art[NOCT - 1][1], tra, 36 * RSA); }
        TR_READ(vrt[0][0], trv, 0); TR_READ(vrt[0][1], trv, 4 * MX_RSV); TR_READ(vrt[1][0], trv, 32 * MX_RSV); TR_READ(vrt[1][1], trv, 36 * MX_RSV);
        if (HG) asm volatile("s_waitcnt lgkmcnt(0)" : "+v"(art[0][0]), "+v"(art[0][1]), "+v"(art[NOCT - 1][0]), "+v"(art[NOCT - 1][1]), "+v"(vrt[0][0]), "+v"(vrt[0][1]), "+v"(vrt[1][0]), "+v"(vrt[1][1]) :: "memory");
        else asm volatile("s_waitcnt lgkmcnt(0)" : "+v"(art[0][0]), "+v"(art[0][1]), "+v"(vrt[0][0]), "+v"(vrt[0][1]), "+v"(vrt[1][0]), "+v"(vrt[1][1]) :: "memory");
        float fg[NOCT][8], kv[NOCT][8];
#pragma unroll
        for (int oi = 0; oi < NOCT; ++oi) { const int o = o_first + 4 * oi;
#pragma unroll
            for (int i = 0; i < 8; ++i) { const unsigned wv = (i & 2) ? art[oi][i >> 2].y : art[oi][i >> 2].x; const float x = (i & 1) ? bfhi(wv) : bflo(wv);
                if (HG) { const float zf = fminf(fmaxf(x, -80.f), 80.f);
                    const float e = __expf(-zf), s = __builtin_amdgcn_rcpf(1.0f + e);
                    fg[oi][i] = lbf + oml * s; kv[oi][i] = oml * e * s; }
                else { fg[oi][i] = __expf(lacur[i]); kv[oi][i] = x; } }
            float pr = 1.0f;
#pragma unroll
            for (int i = 0; i < 8; ++i) pr *= fg[oi][i];
            OCT[o * 128 + c] = pr; }
        LDS_WAIT(); __syncthreads();
#pragma unroll
        for (int oi = 0; oi < NOCT; ++oi) { const int o = o_first + 4 * oi;
            float suf = 1.0f;
#pragma unroll
            for (int o2 = 1; o2 < 8; ++o2) { const float t = OCT[o2 * 128 + c]; suf *= (o2 > o) ? t : 1.0f; }
            float kd[8];
#pragma unroll
            for (int i = 7; i >= 0; --i) { kd[i] = kv[oi][i] * suf; suf *= fg[oi][i]; }
            u32x4 pk; pk.x = pg8::cvt_pk_bf16(kd[0], kd[1]); pk.y = pg8::cvt_pk_bf16(kd[2], kd[3]); pk.z = pg8::cvt_pk_bf16(kd[4], kd[5]); pk.w = pg8::cvt_pk_bf16(kd[6], kd[7]);
            *(LAS u32x4*)(KD + (size_t)((((c >> 4) * 2 + (o >> 2)) * 64 + (o & 3) * 16 + (c & 15)) * 16)) = pk;
            if (o == 0) { ADEC[c] = suf; pprod *= suf; } }
        MX_RAW_TO_LDS((cc + 1) & 1);
        MX_LOAD_A(cc2); MX_LOAD_V(cc2);
        if (FIN) MX_LOAD_Q(cc2);
        LDS_WAIT(); __syncthreads();
        union { u32x4 u; bf16x8 v; } vf[2];
        vf[0].u = (u32x4){vrt[0][0].x, vrt[0][0].y, vrt[0][1].x, vrt[0][1].y}; vf[1].u = (u32x4){vrt[1][0].x, vrt[1][0].y, vrt[1][1].x, vrt[1][1].y};
#pragma unroll
        for (int kt = 0; kt < KT; ++kt) { const f32x4 a4 = *(const LAS f32x4*)(ADEC + kt * 16 + q * 4); S[kt] = S[kt] * a4;
#pragma unroll
            for (int ks = 0; ks < 2; ++ks) { const bf16x8 af = *(const LAS bf16x8*)(KD + (size_t)(((kt * 2 + ks) * 64 + lane) * 16));
                S[kt] = __builtin_amdgcn_mfma_f32_16x16x32_bf16(af, vf[ks].v, S[kt], 0, 0, 0); } }
        if (FIN) {
            f32x4 oacc[4];
#pragma unroll
            for (int lt = 0; lt < 4; ++lt) oacc[lt] = (f32x4){0.f, 0.f, 0.f, 0.f};
#pragma unroll
            for (int kk = 0; kk < KT / 2; ++kk) {
                union { u32x4 u; bf16x8 v; } bs;
                bs.u.x = pg8::cvt_pk_bf16(S[2 * kk][0], S[2 * kk][1]); bs.u.y = pg8::cvt_pk_bf16(S[2 * kk][2], S[2 * kk][3]); bs.u.z = pg8::cvt_pk_bf16(S[2 * kk + 1][0], S[2 * kk + 1][1]); bs.u.w = pg8::cvt_pk_bf16(S[2 * kk + 1][2], S[2 * kk + 1][3]);
#pragma unroll
                for (int lt = 0; lt < 4; ++lt) {
                    union { u32x4 u; bf16x8 v; } aq;
                    const u32x2 q0 = *(const LAS u32x2*)(QSc + (lt * 16 + n) * QSTR + (2 * kk) * 16 + q * 4), q1 = *(const LAS u32x2*)(QSc + (lt * 16 + n) * QSTR + (2 * kk + 1) * 16 + q * 4);
                    aq.u = (u32x4){q0.x, q0.y, q1.x, q1.y};
                    oacc[lt] = __builtin_amdgcn_mfma_f32_16x16x32_bf16(aq.v, bs.v, oacc[lt], 0, 0, 0); } }
#pragma unroll
            for (int lt = 0; lt < 4; ++lt)
#pragma unroll
                for (int j = 0; j < 4; ++j) OT[(lt * 16 + q * 4 + j) * 132 + w * 16 + n] = oacc[lt][j];
            LDS_WAIT(); __syncthreads();
            { const int fl = tid >> 3, seg = tid & 7;
                f32x4 ov[4]; float ssq = 0.f;
#pragma unroll
                for (int i = 0; i < 4; ++i) { ov[i] = *(const LAS f32x4*)(OT + fl * 132 + seg * 16 + i * 4); ssq += (ov[i].x * ov[i].x + ov[i].y * ov[i].y) + (ov[i].z * ov[i].z + ov[i].w * ov[i].w); }
                ssq += __shfl_xor(ssq, 1); ssq += __shfl_xor(ssq, 2); ssq += __shfl_xor(ssq, 4);
                const float rstd = __builtin_amdgcn_rsqf(ssq * (1.0f / 128.0f) + EPS);
                const u32x4 zg0 = zraw[0], zg1 = zraw[1];
                MX_LOAD_Z(ccn);
                u32x4 w0, w1;
                w0.x = pg8::cvt_pk_bf16(ov[0].x * rstd * nwv[0] * bflo(zg0.x), ov[0].y * rstd * nwv[1] * bfhi(zg0.x)); w0.y = pg8::cvt_pk_bf16(ov[0].z * rstd * nwv[2] * bflo(zg0.y), ov[0].w * rstd * nwv[3] * bfhi(zg0.y));
                w0.z = pg8::cvt_pk_bf16(ov[1].x * rstd * nwv[4] * bflo(zg0.z), ov[1].y * rstd * nwv[5] * bfhi(zg0.z)); w0.w = pg8::cvt_pk_bf16(ov[1].z * rstd * nwv[6] * bflo(zg0.w), ov[1].w * rstd * nwv[7] * bfhi(zg0.w));
                w1.x = pg8::cvt_pk_bf16(ov[2].x * rstd * nwv[8] * bflo(zg1.x), ov[2].y * rstd * nwv[9] * bfhi(zg1.x)); w1.y = pg8::cvt_pk_bf16(ov[2].z * rstd * nwv[10] * bflo(zg1.y), ov[2].w * rstd * nwv[11] * bfhi(zg1.y));
                w1.z = pg8::cvt_pk_bf16(ov[3].x * rstd * nwv[12] * bflo(zg1.z), ov[3].y * rstd * nwv[13] * bfhi(zg1.z)); w1.w = pg8::cvt_pk_bf16(ov[3].z * rstd * nwv[14] * bflo(zg1.w), ov[3].w * rstd * nwv[15] * bfhi(zg1.w));
                bf16* op = OB + (size_t)(row0 + fl) * D + (HG ? 512 : 0) + h * 128 + seg * 16;
                *(u32x4*)op = w0; *(u32x4*)(op + 8) = w1; }
        }
    }
#undef MX_RAW_TO_LDS
#undef MX_LOAD_A
#undef MX_LOAD_V
#undef MX_LOAD_Q
#undef MX_LOAD_Z
    if (!FIN) {
#pragma unroll
        for (int kt = 0; kt < KT; ++kt) *(u32x2*)(SB + (size_t)((w * KT + kt) * 64 + lane) * 4) = (u32x2){pg8::cvt_pk_bf16(S[kt][0], S[kt][1]), pg8::cvt_pk_bf16(S[kt][2], S[kt][3])};
        if (o_first == 0) PD[c] = pprod;
    }
    __syncthreads();
}

template <bool FIN>
__device__ __forceinline__ void phase_mixer(const Params& p, LAS unsigned char* lds, int l) {
    for (int u = blockIdx.x; u < 512; u += gridDim.x) {
        const int rem = u & 255, b = rem >> 7, h = (rem >> 5) & 3, jg = rem & 31;
        if (!FIN && jg == NG - 1) continue;
        if (u < 256) mixer_unit<true, FIN>(p, lds, l, b, h, jg); else mixer_unit<false, FIN>(p, lds, l, b, h, jg);
    }
}

__device__ __forceinline__ void phase_scan(const Params& p) {
    unsigned char* ws = p.ws;
    int tid_ = threadIdx.x; asm volatile("" : "+v"(tid_));
    const int gt = blockIdx.x * NTHREADS + tid_, NT = gridDim.x * NTHREADS;
    for (int tt = gt; tt < 8 * 4096 + 8 * 2048; tt += NT) {
        const bool hg = tt < 32768; const int t2 = hg ? tt : tt - 32768, per = hg ? 4096 : 2048, bh = t2 / per, e = t2 % per, KT = hg ? 8 : 4;
        const int kt = (e >> 6) % KT, lane = e & 63, c4 = kt * 16 + (lane >> 4) * 4;
        bf16* base = (bf16*)(ws + (hg ? WS_STATE_HG : WS_STATE)) + (size_t)bh * NG * (per * 4) + (size_t)e * 4;
        const float* pd = (const float*)(ws + WS_PDEC) + (size_t)(((hg ? 0 : 8) + bh) * NG) * 128 + c4;
        f32x4 S = (f32x4){0.f, 0.f, 0.f, 0.f};
        for (int j0 = 0; j0 < NG; j0 += 8) {
            f32x4 Lv[8], Pv[8];
#pragma unroll
            for (int j = 0; j < 8; ++j) { if (j0 + j < NG - 1) { { const u32x2 lv = *(const u32x2*)(base + (size_t)(j0 + j) * (per * 4)); Lv[j] = (f32x4){bflo(lv.x), bfhi(lv.x), bflo(lv.y), bfhi(lv.y)}; } Pv[j] = *(const f32x4*)(pd + (size_t)(j0 + j) * 128); } else { Lv[j] = (f32x4){0.f, 0.f, 0.f, 0.f}; Pv[j] = Lv[j]; } }
#pragma unroll
            for (int j = 0; j < 8; ++j) { *(u32x2*)(base + (size_t)(j0 + j) * (per * 4)) = (u32x2){pg8::cvt_pk_bf16(S[0], S[1]), pg8::cvt_pk_bf16(S[2], S[3])}; S = Pv[j] * S + Lv[j]; }
        }
    }
}

__device__ __forceinline__ void phase_final_norm(const Params& p) {
    int tid_ = threadIdx.x; asm volatile("" : "+v"(tid_));
    const int tid = tid_, lane = tid & 63, wave = tid >> 6;
    const u32x2* xb = (const u32x2*)(p.ws + WS_H);
    f32x4 nw[4];
#pragma unroll
    for (int j = 0; j < 4; ++j) nw[j] = *(const f32x4*)(p.in[15] + lane * 4 + 256 * j);
    const int gw = blockIdx.x * NWAVES + wave, NGW = gridDim.x * NWAVES;
    u32x2 vn[4];
    if (gw < T) {
#pragma unroll
        for (int j = 0; j < 4; ++j) vn[j] = (xb + (size_t)gw * (D / 4) + lane)[64 * j]; }
#pragma unroll 1
    for (int r = gw; r < T; r += NGW) {
        f32x4* xr = (f32x4*)(p.out + (size_t)r * D) + lane;
        f32x4 v[4]; float s = 0.f;
#pragma unroll
        for (int j = 0; j < 4; ++j) v[j] = (f32x4){bflo(vn[j].x), bfhi(vn[j].x), bflo(vn[j].y), bfhi(vn[j].y)};
        { const int rn = (r + NGW < T) ? r + NGW : r;
#pragma unroll
          for (int j = 0; j < 4; ++j) vn[j] = (xb + (size_t)rn * (D / 4) + lane)[64 * j]; }
#pragma unroll
        for (int j = 0; j < 4; ++j) s += (v[j].x * v[j].x + v[j].y * v[j].y) + (v[j].z * v[j].z + v[j].w * v[j].w);
        const float rstd = __builtin_amdgcn_rsqf(wave_sum(s) * (1.0f / D) + EPS);
#pragma unroll
        for (int j = 0; j < 4; ++j) xr[64 * j] = v[j] * rstd * nw[j];
    }
}

#define XB_TMO      128
#define XB_XCNT(j)  (256  + 64 * (j))
#define XB_XSUB(j)  (1280 + 64 * (j))
#define XB_XGEN(j)  (2304 + 64 * (j))
#define XB_TOP      3328
#define XB_TOPGEN   3392
#define XCD_BAR_WORDS 3456
#define XB_SPIN_CAP (1u << 18)

__device__ __forceinline__ unsigned xb_ld(unsigned* p)              { return __hip_atomic_load(p, __ATOMIC_RELAXED, __HIP_MEMORY_SCOPE_AGENT); }
__device__ __forceinline__ unsigned xb_add(unsigned* p, unsigned v) { return __hip_atomic_fetch_add(p, v, __ATOMIC_RELAXED, __HIP_MEMORY_SCOPE_AGENT); }
__device__ __forceinline__ unsigned xb_xcc_id() { return (unsigned)__builtin_amdgcn_s_getreg((3 << 11) | 20) & 0xFu; }
#define XB_SPIN(cond, bar) do { unsigned _sp = 0; while (cond) { __builtin_amdgcn_s_sleep(1); \
    if ((++_sp & 255u) == 0u) { if (xb_ld(&(bar)[XB_TMO])) break; if (_sp > XB_SPIN_CAP) { atomicAdd(&(bar)[XB_TMO], 1u); break; } } } } while (0)

struct XcdBarrier {
    unsigned* bar; unsigned x;
    volatile LAS unsigned* st;
};

__device__ __forceinline__ XcdBarrier xcd_barrier_post(unsigned* bar, volatile LAS unsigned* st) {
    XcdBarrier b; b.bar = bar; b.x = xb_xcc_id(); b.st = st;
    if (threadIdx.x == 0) (void)xb_add(&bar[XB_XCNT(b.x)], 1u);
    return b;
}
__device__ __forceinline__ void xcd_barrier_complete(unsigned* bar, unsigned x, unsigned& nloc, unsigned& nx) {
    const unsigned G = gridDim.x * gridDim.y * gridDim.z;
    unsigned sum, cnt, mine, sp = 0u;
    for (;;) {
        sum = 0u; cnt = 0u; mine = 0u;
#pragma unroll
        for (unsigned j = 0; j < 16; ++j) { const unsigned c = xb_ld(&bar[XB_XCNT(j)]); sum += c; cnt += (c > 0u) ? 1u : 0u; mine = (j == x) ? c : mine; }
        if (sum == G) break;
        __builtin_amdgcn_s_sleep(1);
        if ((++sp & 255u) == 0u) { if (xb_ld(&bar[XB_TMO])) break; if (sp > XB_SPIN_CAP) { atomicAdd(&bar[XB_TMO], 1u); break; } }
    }
    nloc = mine > 0u ? mine : 1u; nx = cnt > 0u ? cnt : 1u;
}

__device__ __forceinline__ void xcd_barrier(const XcdBarrier& b) {
    asm volatile("s_waitcnt vmcnt(0)" ::: "memory");
    __syncthreads();
    if (threadIdx.x == 0) {
        unsigned* bar = b.bar;
        __builtin_amdgcn_s_waitcnt(0);
        unsigned nloc = b.st[0], nx = b.st[1];
        if (nloc == 0u) { xcd_barrier_complete(bar, b.x, nloc, nx); b.st[0] = nloc; b.st[1] = nx; }
        const unsigned old = xb_add(&bar[XB_XSUB(b.x)], 1u);
        const unsigned gen = old / nloc;
        if (old + 1u == (gen + 1u) * nloc) {
            __builtin_amdgcn_fence(__ATOMIC_RELEASE, "agent");
            asm volatile("s_waitcnt vmcnt(0)" ::: "memory");
            const unsigned og = xb_add(&bar[XB_TOP], 1u);
            const unsigned tg = og / nx;
            if (og + 1u == (tg + 1u) * nx) xb_add(&bar[XB_TOPGEN], 1u);
            else XB_SPIN(xb_ld(&bar[XB_TOPGEN]) == tg, bar);
            __builtin_amdgcn_fence(__ATOMIC_ACQUIRE, "agent");
            xb_add(&bar[XB_XGEN(b.x)], 1u);
            asm volatile("s_waitcnt vmcnt(0)" ::: "memory");
        } else {
            XB_SPIN(xb_ld(&bar[XB_XGEN(b.x)]) == gen, bar);
            __builtin_amdgcn_fence(__ATOMIC_ACQUIRE, "agent");
            asm volatile("s_waitcnt vmcnt(0)" ::: "memory");
        }
    }
    __syncthreads();
}


__global__ void __launch_bounds__(NTHREADS, 2) mega_fwd(Params p) {
    extern __shared__ __attribute__((aligned(16))) unsigned char lds_raw[];
    LAS unsigned char* lds = (LAS unsigned char*)lds_raw;
    cg::grid_group grid = cg::this_grid();
    unsigned char* ws = p.ws;
    unsigned* barw = (unsigned*)(ws + WS_BAR);
    volatile LAS unsigned* bst = (volatile LAS unsigned*)(lds + LDS_BYTES - 64);
    if (threadIdx.x < 2) bst[threadIdx.x] = 0u;
    if (blockIdx.x == 0) for (int i = threadIdx.x; i < XCD_BAR_WORDS; i += NTHREADS) barw[i] = 0u;
    phase_prologue(p, lds);
    grid.sync();
    const XcdBarrier xb = xcd_barrier_post(barw, bst);
#pragma unroll 1
    for (int l_ = 0; l_ < DEPTH; ++l_) {
        int l = l_; asm volatile("" : "+s"(l));
        if (l == 0) phase_norm<false>(p, lds, l, p.in[0]); else phase_norm<true>(p, lds, l, p.out);
        xcd_barrier(xb);
        {
            pg8::Gemm g{(const pg8::bf16_t*)(ws + WS_H), (const pg8::bf16_t*)(ws + WS_WIN) + (size_t)l * NP * D, T, NP, D};
            pg8::StaticOrder S; S.init(T, NP, (int)gridDim.x, (int)blockIdx.x);
            pg8::EpiIn E{(pg8::bf16_t*)(ws + WS_P1), (pg8::bf16_t*)(ws + WS_PG), p.in[11] + l * 2048};
            pg8::gemm_phase<pg8::EpiIn, pg8::StaticOrder, true, true>(lds, g, S, E);
        }
        xcd_barrier(xb);
        phase_mixer<false>(p, lds, l);
        xcd_barrier(xb);
        phase_scan(p);
        xcd_barrier(xb);
        phase_mixer<true>(p, lds, l);
        xcd_barrier(xb);
        {
            pg8::Gemm g{(const pg8::bf16_t*)(ws + WS_H), (const pg8::bf16_t*)(ws + WS_WUP) + (size_t)l * D * D, T, D, D};
            pg8::StaticOrder S; S.init(T, D, (int)gridDim.x, (int)blockIdx.x);
            pg8::EpiUp E{(const pg8::bf16_t*)(ws + WS_PG), (pg8::bf16_t*)(ws + WS_P1)};
            pg8::gemm_phase<pg8::EpiUp, pg8::StaticOrder, true, true>(lds, g, S, E);
        }
        xcd_barrier(xb);
        {
            pg8::Gemm g{(const pg8::bf16_t*)(ws + WS_P1), (const pg8::bf16_t*)(ws + WS_WOUT) + (size_t)l * D * D, T, D, D};
            pg8::StaticOrder S; S.init(T, D, (int)gridDim.x, (int)blockIdx.x);
            const float* gate2 = (const float*)(ws + WS_MOD) + (size_t)l * BATCH * 3072 + 2048;
            if (l == 0) { pg8::EpiOut<false> E{(const void*)p.in[0], (pg8::bf16_t*)p.out, gate2}; pg8::gemm_phase<pg8::EpiOut<false>, pg8::StaticOrder, true, true>(lds, g, S, E); }
            else { pg8::EpiOut<true> E{(const void*)p.out, (pg8::bf16_t*)(ws + WS_H), gate2}; pg8::gemm_phase<pg8::EpiOut<true>, pg8::StaticOrder, true, true>(lds, g, S, E); }
        }
        xcd_barrier(xb);
    }
    phase_final_norm(p);
}

extern "C" void kernel_launch(void* const* d_in, const int* in_sizes, int n_in, void* d_out, int out_size, void* d_ws, size_t ws_size, hipStream_t stream) {
    static int grid = 0;
    if (grid == 0) {
        if (n_in != 16 || in_sizes[0] != T * D || out_size != T * D || ws_size < WS_END) { fprintf(stderr, "kernel_launch: unexpected shapes (n_in %d, in0 %d, out %d, ws %zu)\n", n_in, n_in > 0 ? in_sizes[0] : -1, out_size, ws_size); grid = -1; return; }
        int dev = 0, cus = 0, per_cu = 0;
        if (hipGetDevice(&dev) != hipSuccess || hipDeviceGetAttribute(&cus, hipDeviceAttributeMultiprocessorCount, dev) != hipSuccess) { fprintf(stderr, "kernel_launch: device query failed\n"); grid = -1; return; }
        if (hipFuncSetAttribute((const void*)mega_fwd, hipFuncAttributeMaxDynamicSharedMemorySize, LDS_BYTES) != hipSuccess) { fprintf(stderr, "kernel_launch: hipFuncSetAttribute failed\n"); grid = -1; return; }
        if (hipOccupancyMaxActiveBlocksPerMultiprocessor(&per_cu, (const void*)mega_fwd, NTHREADS, LDS_BYTES) != hipSuccess || per_cu < 1) { fprintf(stderr, "kernel_launch: occupancy query failed (%d)\n", per_cu); (void)hipGetLastError(); per_cu = 1; }
        grid = cus * per_cu;
    }
    if (grid < 0) return;
    Params p{};
    for (int i = 0; i < 16; ++i) p.in[i] = (const float*)d_in[i];
    p.out = (float*)d_out; p.ws = (unsigned char*)d_ws;
    void* args[] = {&p};
    const hipError_t e = hipLaunchCooperativeKernel((const void*)mega_fwd, dim3(grid), dim3(NTHREADS), args, LDS_BYTES, stream);
    if (e != hipSuccess) fprintf(stderr, "kernel_launch: cooperative launch failed: %s (grid %d)\n", hipGetErrorString(e), grid);
}
```

```cpp
#include <hip/hip_runtime.h>
#include <hip/hip_cooperative_groups.h>
#include <cstdio>
#include <cstdint>
namespace cg = cooperative_groups;
namespace pg8 {
#define PG8_LAS __attribute__((address_space(3)))
typedef unsigned short bf16_t;
typedef short bf16x8 __attribute__((ext_vector_type(8)));
typedef float f32x4 __attribute__((ext_vector_type(4)));
typedef unsigned u32x4 __attribute__((ext_vector_type(4)));
constexpr int BM = 256, BK = 64, HALF = 128, HTB = HALF * BK * 2  , STAGE_BYTES = 8 * HTB, NXCD = 8, WGM = 8;

__host__ __device__ __forceinline__ int lds_byte(int r, int c) { const int st = (r >> 4) * 2 + (c >> 5), rr = r & 15, cc = c & 31, ob = rr * 64 + cc * 2; return st * 1024 + (ob ^ (((ob >> 9) & 1) << 5)); }
__host__ __device__ __forceinline__ void stage_rc(int b, int& R, int& C) { const int st = b / 1024, sb = b % 1024, swz = sb ^ (((sb >> 9) & 1) << 5); R = (st >> 1) * 16 + swz / 64; C = (st & 1) * 32 + (swz % 64) / 2; }
__host__ __device__ __forceinline__ int perm32(int rho) { const int n = rho >> 4, i = rho & 15; return 8 * (i >> 2) + 4 * n + (i & 3); }

struct Unit { int pm, pn; };
struct Gemm { const bf16_t* A; const bf16_t* Bt; int M, N, K; };

struct StaticOrder {
    int nM, nN, nwg, G, c, wgm;
    __host__ __device__ void init(int M, int N, int G_, int c_, int wgm_ = WGM) { nM = M / BM; nN = N / BM; nwg = nM * nN; G = G_; c = c_; wgm = wgm_; }
    __host__ __device__ bool next(int i, Unit& u) const {
        const long L = (long)i * G + c; if (L >= nwg) return false;
        int wgid = (int)L; { const int q = nwg / NXCD, r = nwg % NXCD, xcd = wgid % NXCD, off = wgid / NXCD; wgid = (xcd < r ? xcd * (q + 1) : r * (q + 1) + (xcd - r) * q) + off; }
        const int nig = wgm * nN, gid = wgid / nig, fm = gid * wgm, gsz = (nM - fm) < wgm ? (nM - fm) : wgm;
        u.pm = fm + ((wgid % nig) % gsz); u.pn = (wgid % nig) / gsz; return true;
    }
    __device__ __forceinline__ void a_ready(const Unit&) const {}
    __device__ __forceinline__ void done(const Unit&) const {}
};
__device__ __forceinline__ unsigned cvt_pk_bf16(float lo, float hi) { unsigned r; asm volatile("v_cvt_pk_bf16_f32 %0, %1, %2" : "=v"(r) : "v"(lo), "v"(hi)); return r; }
template <class Epi, class Sched, bool ALIGN_EPI = false, bool SP2 = false>
__device__ __forceinline__ void gemm_phase(PG8_LAS unsigned char* lds, const Gemm g, const Sched& S, const Epi& E) {
    int tid_ = threadIdx.x; asm volatile("" : "+v"(tid_));
    const int tid = tid_, wid = __builtin_amdgcn_readfirstlane(tid >> 6), lane = tid & 63, wr = wid >> 2, wc = wid & 3, fr = lane & 15, fq = lane >> 4;
    const int K = g.K, nt = K / BK;
    unsigned voffA[2], voffB[2];
#pragma unroll
    for (int i = 0; i < 2; ++i) { int R, C; stage_rc(tid * 16 + i * 8192, R, C); const int Rb = Epi::PERM ? ((R & ~31) + perm32(R & 31)) : R;
        voffA[i] = (unsigned)(R * K + C) * 2u; voffB[i] = (unsigned)(Rb * K + C) * 2u; }
    const size_t kstep = (size_t)(BK * 2);
    const size_t hstep = (size_t)HALF * K * 2;
    const size_t tstep = 2 * hstep;
    const unsigned ldsw = (unsigned)wid * 1024u;
    const int aoff = lds_byte(wr * 64 + fr, fq * 8), boff = lds_byte(wc * 32 + fr, fq * 8);
#define PG8_SA(b, h) (((b) * 2 + (h)) * HTB)
#define PG8_SB(b, h) ((4 + (b) * 2 + (h)) * HTB)
#define PG8_STAGE(bufoff, gbase, voff) do { _Pragma("unroll") for (int _i = 0; _i < 2; ++_i) \
        __builtin_amdgcn_global_load_lds((const unsigned*)((const char*)(gbase) + (voff)[_i]), (PG8_LAS unsigned*)(lds + (bufoff) + ldsw + _i * 8192), 16, 0, 0); } while (0)
#define PG8_LDA(dst, b, h) do { _Pragma("unroll") for (int m = 0; m < 4; ++m) _Pragma("unroll") for (int k = 0; k < 2; ++k) dst[m][k] = *(const PG8_LAS bf16x8*)(lds + PG8_SA(b, h) + aoff + m * 2048 + k * 1024); } while (0)
#define PG8_LDB(dst, b, h) do { _Pragma("unroll") for (int n = 0; n < 2; ++n) _Pragma("unroll") for (int k = 0; k < 2; ++k) dst[n][k] = *(const PG8_LAS bf16x8*)(lds + PG8_SB(b, h) + boff + n * 2048 + k * 1024); } while (0)
#define PG8_MMA(ai, bj, At, Bt) do { __builtin_amdgcn_s_setprio(1); _Pragma("unroll") for (int m = 0; m < 4; ++m) _Pragma("unroll") for (int n = 0; n < 2; ++n) _Pragma("unroll") for (int k = 0; k < 2; ++k) \
        acc[ai][bj][m][n] = __builtin_amdgcn_mfma_f32_16x16x32_bf16(Bt[n][k], At[m][k], acc[ai][bj][m][n], 0, 0, 0); __builtin_amdgcn_s_setprio(0); } while (0)
#define PG8_WAIT_V(n) asm volatile("s_waitcnt vmcnt(" #n ")" ::: "memory")
#define PG8_WAIT_L(n) asm volatile("s_waitcnt lgkmcnt(" #n ")" ::: "memory")
#define PG8_BAR __builtin_amdgcn_s_barrier()
#define PG8_SCHED __builtin_amdgcn_sched_barrier(0)
    Unit cur, nxt; int ui = 0;
    if (!S.next(0, cur)) return;
    f32x4 acc[2][2][4][2];
#pragma unroll
    for (int a = 0; a < 2; ++a)
#pragma unroll
        for (int b = 0; b < 2; ++b)
#pragma unroll
            for (int m = 0; m < 4; ++m)
#pragma unroll
                for (int n = 0; n < 2; ++n) acc[a][b][m][n] = (f32x4){0.f, 0.f, 0.f, 0.f};
    bf16x8 At[4][2], B0[2][2], B1[2][2];
    const char* cA = (const char*)g.A + (size_t)cur.pm * tstep; const char* cB = (const char*)g.Bt + (size_t)cur.pn * tstep;
    S.a_ready(cur);
    if constexpr (SP2) {
        PG8_STAGE(PG8_SB(0, 0), cB, voffB); PG8_STAGE(PG8_SB(0, 1), cB + hstep, voffB); PG8_STAGE(PG8_SA(0, 0), cA, voffA); PG8_STAGE(PG8_SA(0, 1), cA + hstep, voffA);
        if (wr == 1) PG8_BAR;
        PG8_WAIT_V(2); PG8_BAR;
        PG8_STAGE(PG8_SB(1, 0), cB + kstep, voffB); PG8_STAGE(PG8_SA(1, 0), cA + kstep, voffA); PG8_STAGE(PG8_SB(1, 1), cB + hstep + kstep, voffB);
        PG8_WAIT_V(6); PG8_BAR;
    } else {
        PG8_STAGE(PG8_SB(0, 0), cB, voffB); PG8_STAGE(PG8_SA(0, 0), cA, voffA); PG8_STAGE(PG8_SB(0, 1), cB + hstep, voffB); PG8_STAGE(PG8_SA(0, 1), cA + hstep, voffA);
        if (wr == 1) PG8_BAR;
        PG8_WAIT_V(4); PG8_BAR;
        PG8_STAGE(PG8_SB(1, 0), cB + kstep, voffB); PG8_STAGE(PG8_SA(1, 0), cA + kstep, voffA); PG8_STAGE(PG8_SB(1, 1), cB + hstep + kstep, voffB);
        PG8_WAIT_V(6); PG8_BAR;
    }
    for (;;) {
        const bool has_next = S.next(ui + 1, nxt);
        const char* nA = has_next ? (const char*)g.A + (size_t)nxt.pm * tstep : cA; const char* nB = has_next ? (const char*)g.Bt + (size_t)nxt.pn * tstep : cB;
        for (int t = 0; t < nt; t += 2) {
            const bool last = (t == nt - 2);
            const char* a1 = cA + (size_t)(t + 1) * kstep;
            const char* a2 = last ? nA : cA + (size_t)(t + 2) * kstep; const char* b2 = last ? nB : cB + (size_t)(t + 2) * kstep;
            const char* a3 = a2 + kstep; const char* b3 = b2 + kstep;
            if (last && has_next) S.a_ready(nxt);
            if constexpr (Epi::MID) { if (t == nt / 2) E.mid(acc, cur, wr, wc, fr, fq); }
            if constexpr (SP2) {
            PG8_LDB(B0, 0, 0); PG8_LDB(B1, 0, 1); PG8_SCHED; PG8_LDA(At, 0, 0); PG8_STAGE(PG8_SA(1, 1), a1 + hstep, voffA);
            PG8_WAIT_V(8); PG8_WAIT_L(0); PG8_BAR; PG8_MMA(0, 0, At, B0); PG8_MMA(0, 1, At, B1); PG8_BAR; PG8_SCHED;
            PG8_LDA(At, 0, 1); PG8_STAGE(PG8_SB(0, 0), b2, voffB); PG8_STAGE(PG8_SB(0, 1), b2 + hstep, voffB); PG8_STAGE(PG8_SA(0, 0), a2, voffA);
            PG8_WAIT_V(8); PG8_WAIT_L(0); PG8_BAR; PG8_MMA(1, 0, At, B0); PG8_MMA(1, 1, At, B1); PG8_BAR; PG8_SCHED;
            PG8_LDB(B0, 1, 0); PG8_LDB(B1, 1, 1); PG8_SCHED; PG8_LDA(At, 1, 0); PG8_STAGE(PG8_SA(0, 1), a2 + hstep, voffA);
            PG8_WAIT_V(8); PG8_WAIT_L(0); PG8_BAR; PG8_MMA(0, 0, At, B0); PG8_MMA(0, 1, At, B1); PG8_BAR; PG8_SCHED;
            PG8_LDA(At, 1, 1); PG8_STAGE(PG8_SB(1, 0), b3, voffB); PG8_STAGE(PG8_SB(1, 1), b3 + hstep, voffB); PG8_STAGE(PG8_SA(1, 0), a3, voffA);
            PG8_WAIT_V(8); PG8_WAIT_L(0); PG8_BAR; PG8_MMA(1, 0, At, B0); PG8_MMA(1, 1, At, B1); PG8_BAR; PG8_SCHED;
            } else {
            PG8_LDB(B0, 0, 0); PG8_SCHED; PG8_LDA(At, 0, 0); PG8_STAGE(PG8_SA(1, 1), a1 + hstep, voffA);
            PG8_WAIT_L(8); PG8_BAR; PG8_WAIT_L(0); PG8_MMA(0, 0, At, B0); PG8_BAR; PG8_SCHED;
            PG8_LDB(B1, 0, 1); PG8_STAGE(PG8_SB(0, 0), b2, voffB);
            PG8_BAR; PG8_WAIT_L(0); PG8_MMA(0, 1, At, B1); PG8_BAR;
            PG8_LDA(At, 0, 1); PG8_STAGE(PG8_SA(0, 0), a2, voffA);
            PG8_BAR; PG8_WAIT_L(0); PG8_MMA(1, 0, At, B0); PG8_BAR; PG8_SCHED;
            PG8_STAGE(PG8_SB(0, 1), b2 + hstep, voffB);
            PG8_WAIT_V(6); PG8_BAR; PG8_MMA(1, 1, At, B1); PG8_BAR;
            PG8_LDB(B0, 1, 0); PG8_SCHED; PG8_LDA(At, 1, 0); PG8_STAGE(PG8_SA(0, 1), a2 + hstep, voffA);
            PG8_WAIT_L(8); PG8_BAR; PG8_WAIT_L(0); PG8_MMA(0, 0, At, B0); PG8_BAR; PG8_SCHED;
            PG8_LDB(B1, 1, 1); PG8_STAGE(PG8_SB(1, 0), b3, voffB);
            PG8_BAR; PG8_WAIT_L(0); PG8_MMA(0, 1, At, B1); PG8_BAR;
            PG8_LDA(At, 1, 1); PG8_STAGE(PG8_SA(1, 0), a3, voffA);
            PG8_BAR; PG8_WAIT_L(0); PG8_MMA(1, 0, At, B0); PG8_BAR; PG8_SCHED;
            PG8_STAGE(PG8_SB(1, 1), b3 + hstep, voffB);
            PG8_WAIT_V(6); PG8_BAR; PG8_MMA(1, 1, At, B1); PG8_BAR;
            }
        }
        if constexpr (ALIGN_EPI) { if (wr == 0) PG8_BAR; }
        if constexpr (!Epi::AFTER_DRAIN) { E(acc, cur, wr, wc, fr, fq); S.done(cur); }
        if (!has_next) break;
#pragma unroll
        for (int a = 0; a < 2; ++a)
#pragma unroll
            for (int b = 0; b < 2; ++b)
#pragma unroll
                for (int m = 0; m < 4; ++m)
#pragma unroll
                    for (int n = 0; n < 2; ++n) acc[a][b][m][n] = (f32x4){0.f, 0.f, 0.f, 0.f};
        cur = nxt; cA = nA; cB = nB; ++ui;
        if constexpr (ALIGN_EPI) { if (wr == 1) PG8_BAR; }
    }
    PG8_WAIT_V(0);
    if constexpr (!ALIGN_EPI) { if (wr == 0) PG8_BAR; }
    PG8_BAR;
    if constexpr (Epi::AFTER_DRAIN) { E.fused(acc, cur, wr, wc, fr, fq, lds, wid, lane); S.done(cur); }
#undef PG8_SA
#undef PG8_SB
#undef PG8_STAGE
#undef PG8_LDA
#undef PG8_LDB
#undef PG8_MMA
#undef PG8_WAIT_V
#undef PG8_WAIT_L
#undef PG8_BAR
#undef PG8_SCHED
}
}

#define LAS __attribute__((address_space(3)))
typedef unsigned short bf16;
typedef float f32x4 __attribute__((ext_vector_type(4)));
typedef short bf16x8 __attribute__((ext_vector_type(8)));
typedef unsigned u32x4 __attribute__((ext_vector_type(4)));
typedef unsigned u32x2 __attribute__((ext_vector_type(2)));

constexpr int D = 1024, BATCH = 2, SEQ = 16384, T = BATCH * SEQ, DEPTH = 2;
constexpr int IN_TOTAL = 5648, NP = 5632, NP1 = 3584, NPG = 2048;
constexpr int TW = 256;
__host__ __device__ constexpr size_t tile_off(int col) { return (size_t)(col >> 8) * ((size_t)32768 * 256) + (size_t)(col & 255); }
constexpr int G_CH = 8;
constexpr int NCHUNK = SEQ / 64;
constexpr int NG = NCHUNK / G_CH;
constexpr int NTHREADS = 512, NWAVES = 8;
constexpr int LDS_BYTES = 147456;
constexpr float EPS = 1e-6f;

constexpr int C_GQ = 0, C_GK = 256, C_GV = 512, C_GZ = 1024, C_HQ = 1536, C_HF = 2048, C_HI = 2560, C_HZ = 3072;

constexpr size_t MiB = 1u << 20;
constexpr size_t WS_MOD = 0;
constexpr size_t WS_BAR = 512 * 1024;
constexpr size_t WS_WIN = 1 * MiB;
constexpr size_t WS_WUP = 23 * MiB;
constexpr size_t WS_WOUT = 27 * MiB;
constexpr size_t WS_STATE = 32 * MiB;
constexpr size_t WS_STATE_HG = WS_STATE + 8 * MiB;
constexpr size_t WS_PDEC = 56 * MiB;
constexpr size_t WS_WLR = 57 * MiB;
constexpr size_t WS_LOGA = 64 * MiB;
constexpr size_t WS_H = 96 * MiB;
constexpr size_t WS_P1 = 160 * MiB;
constexpr size_t WS_PG = 384 * MiB;
constexpr size_t WS_END = 512 * MiB;

struct Params { const float* in[16]; float* out; unsigned char* ws; };

__device__ __forceinline__ float bf2f(unsigned short b) { return __builtin_bit_cast(float, (unsigned)b << 16); }
__device__ __forceinline__ float bflo(unsigned w) { return __builtin_bit_cast(float, w << 16); }
__device__ __forceinline__ float bfhi(unsigned w) { return __builtin_bit_cast(float, w & 0xffff0000u); }
__device__ __forceinline__ unsigned f2bf(float f) { unsigned u = __builtin_bit_cast(unsigned, f); return (u + 0x7fffu + ((u >> 16) & 1u)) >> 16; }
__device__ __forceinline__ unsigned pk2(float lo, float hi) { return f2bf(lo) | (f2bf(hi) << 16); }
__device__ __forceinline__ float sigmoidf_(float x) { return 1.0f / (1.0f + __expf(-x)); }
__device__ __forceinline__ float wave_sum(float v) {
#pragma unroll
    for (int o = 1; o < 64; o <<= 1) v += __shfl_xor(v, o);
    return v;
}
#define LDS_WAIT() asm volatile("s_waitcnt lgkmcnt(0)" ::: "memory")

namespace pg8 {
struct EpiIn {
    static constexpr bool PERM = true, AFTER_DRAIN = false, MID = false;
    bf16_t* P1; bf16_t* PG; const float* bias;
    __device__ __forceinline__ void operator()(const f32x4 (&acc)[2][2][4][2], const Unit& u, int wr, int wc, int fr, int fq) const {
        const int pn = u.pn;
        const int row0 = u.pm * BM + wr * 64 + fr;
        if (pn >= 14) {
            const int ch0 = (pn - 14) * 128 + wc * 32 + 8 * fq;
            f32x4 ba[2], bb[2];
#pragma unroll
            for (int n = 0; n < 2; ++n) { ba[n] = *(const f32x4*)(bias + ch0 + 4 * n); bb[n] = *(const f32x4*)(bias + 1024 + ch0 + 4 * n); }
#pragma unroll
            for (int ai = 0; ai < 2; ++ai)
#pragma unroll
                for (int m = 0; m < 4; ++m) { bf16_t* rowp = PG + tile_off(ch0 & ~31) + (size_t)(row0 + ai * HALF + m * 16) * TW + (ch0 & 31);
                    f32x4 r[2], g[2];
#pragma unroll
                    for (int n = 0; n < 2; ++n) { const f32x4 a = acc[ai][0][m][n] + ba[n], b = acc[ai][1][m][n] + bb[n];
#pragma unroll
                        for (int j = 0; j < 4; ++j) { const float ea = __expf(-a[j]), eb = __expf(-b[j]); g[n][j] = __builtin_amdgcn_rcpf(1.0f + eb); r[n][j] = (1.0f + eb) * __builtin_amdgcn_rcpf(1.0f + ea); } }
                    u32x4 w; w.x = cvt_pk_bf16(r[0][0], r[0][1]); w.y = cvt_pk_bf16(r[0][2], r[0][3]); w.z = cvt_pk_bf16(r[1][0], r[1][1]); w.w = cvt_pk_bf16(r[1][2], r[1][3]);
                    *(u32x4*)rowp = w;
                    w.x = cvt_pk_bf16(g[0][0], g[0][1]); w.y = cvt_pk_bf16(g[0][2], g[0][3]); w.z = cvt_pk_bf16(g[1][0], g[1][1]); w.w = cvt_pk_bf16(g[1][2], g[1][3]);
                    *(u32x4*)(rowp + tile_off(1024)) = w; }
            return;
        }
        int mode = 0; float scl = 1.0f;
        if (pn == 0) scl = 0.125f;
        else if (pn == 4 || pn == 5 || pn == 12 || pn == 13) mode = 1;
        else if (pn == 6 || pn == 7) { mode = 1; scl = 0.08838834764831845f; }
        const int col0 = pn * 256 + wc * 32 + 8 * fq;
#pragma unroll
        for (int ai = 0; ai < 2; ++ai)
#pragma unroll
            for (int m = 0; m < 4; ++m) { bf16_t* rowp = P1 + tile_off(pn * 256) + (size_t)(row0 + ai * HALF + m * 16) * TW + (col0 & 255);
#pragma unroll
                for (int bj = 0; bj < 2; ++bj) { f32x4 v0 = acc[ai][bj][m][0], v1 = acc[ai][bj][m][1];
                    if (mode == 0) { v0 = v0 * scl; v1 = v1 * scl; }
                    else {
#pragma unroll
                        for (int j = 0; j < 4; ++j) { v0[j] = v0[j] * scl * __builtin_amdgcn_rcpf(1.0f + __expf(-v0[j])); v1[j] = v1[j] * scl * __builtin_amdgcn_rcpf(1.0f + __expf(-v1[j])); } }
                    u32x4 w; w.x = cvt_pk_bf16(v0[0], v0[1]); w.y = cvt_pk_bf16(v0[2], v0[3]); w.z = cvt_pk_bf16(v1[0], v1[1]); w.w = cvt_pk_bf16(v1[2], v1[3]);
                    *(u32x4*)(rowp + bj * HALF) = w; } }
    }
};
struct EpiUp {
    static constexpr bool PERM = true, AFTER_DRAIN = false, MID = true;
    const bf16_t* PG; bf16_t* Mo;
    __device__ __forceinline__ void mid(f32x4 (&acc)[2][2][4][2], const Unit& u, int wr, int wc, int fr_, int fq) const {
        int fr = fr_; asm volatile("" : "+v"(fr));
        const int row0 = u.pm * BM + wr * 64 + fr, col0 = u.pn * BM + wc * 32 + 8 * fq;
#pragma unroll
        for (int ai = 0; ai < 2; ++ai) {
            u32x4 rv[4][2];
#pragma unroll
            for (int m = 0; m < 4; ++m) { const bf16_t* gp = PG + tile_off(u.pn * 256) + (size_t)(row0 + ai * HALF + m * 16) * TW + (col0 & 255);
#pragma unroll
                for (int bj = 0; bj < 2; ++bj) rv[m][bj] = *(const u32x4*)(gp + bj * HALF); }
#pragma unroll
            for (int m = 0; m < 4; ++m)
#pragma unroll
                for (int bj = 0; bj < 2; ++bj) { const u32x4 ga = rv[m][bj];
                    acc[ai][bj][m][0] = acc[ai][bj][m][0] * (f32x4){bflo(ga.x), bfhi(ga.x), bflo(ga.y), bfhi(ga.y)};
                    acc[ai][bj][m][1] = acc[ai][bj][m][1] * (f32x4){bflo(ga.z), bfhi(ga.z), bflo(ga.w), bfhi(ga.w)}; }
            __builtin_amdgcn_sched_barrier(0);
        }
    }
    __device__ __forceinline__ void operator()(const f32x4 (&acc)[2][2][4][2], const Unit& u, int wr, int wc, int fr, int fq) const {
        const int row0 = u.pm * BM + wr * 64 + fr, col0 = u.pn * BM + wc * 32 + 8 * fq;
#pragma unroll
        for (int ai = 0; ai < 2; ++ai)
#pragma unroll
            for (int m = 0; m < 4; ++m) { const size_t row = (size_t)(row0 + ai * HALF + m * 16); const bf16_t* gp = PG + tile_off(1024 + u.pn * 256) + row * TW + (col0 & 255); bf16_t* op = Mo + row * D + col0;
#pragma unroll
                for (int bj = 0; bj < 2; ++bj) { const u32x4 gb = *(const u32x4*)(gp + bj * HALF);
                    const f32x4 a0 = acc[ai][bj][m][0], a1 = acc[ai][bj][m][1];
                    u32x4 w; w.x = cvt_pk_bf16(a0[0] * bflo(gb.x), a0[1] * bfhi(gb.x)); w.y = cvt_pk_bf16(a0[2] * bflo(gb.y), a0[3] * bfhi(gb.y));
                    w.z = cvt_pk_bf16(a1[0] * bflo(gb.z), a1[1] * bfhi(gb.z)); w.w = cvt_pk_bf16(a1[2] * bflo(gb.w), a1[3] * bfhi(gb.w));
                    *(u32x4*)(op + bj * HALF) = w; } }
    }
};
template <bool XBF> struct EpiOut {
    static constexpr bool PERM = true, AFTER_DRAIN = false, MID = false;
    const void* xin; bf16_t* out; const float* gate2;
    __device__ __forceinline__ void operator()(const f32x4 (&acc)[2][2][4][2], const Unit& u, int wr, int wc, int fr, int fq) const {
        const int row0 = u.pm * BM + wr * 64 + fr, col0 = u.pn * BM + wc * 32 + 8 * fq;
        const float* gate = gate2 + ((u.pm * BM) / SEQ) * 3072;
        f32x4 gv[2][2];
#pragma unroll
        for (int bj = 0; bj < 2; ++bj)
#pragma unroll
            for (int n = 0; n < 2; ++n) gv[bj][n] = *(const f32x4*)(gate + col0 + bj * HALF + 4 * n);
#pragma unroll
        for (int ai = 0; ai < 2; ++ai)
#pragma unroll
            for (int m = 0; m < 4; ++m) { const size_t off = (size_t)(row0 + ai * HALF + m * 16) * D + col0;
#pragma unroll
                for (int bj = 0; bj < 2; ++bj) { f32x4 x0, x1;
                    if (XBF) { const u32x4 xb = *(const u32x4*)((const bf16_t*)xin + off + bj * HALF);
                        x0 = (f32x4){__builtin_bit_cast(float, xb.x << 16), __builtin_bit_cast(float, xb.x & 0xffff0000u), __builtin_bit_cast(float, xb.y << 16), __builtin_bit_cast(float, xb.y & 0xffff0000u)};
                        x1 = (f32x4){__builtin_bit_cast(float, xb.z << 16), __builtin_bit_cast(float, xb.z & 0xffff0000u), __builtin_bit_cast(float, xb.w << 16), __builtin_bit_cast(float, xb.w & 0xffff0000u)}; }
                    else { x0 = *(const f32x4*)((const float*)xin + off + bj * HALF); x1 = *(const f32x4*)((const float*)xin + off + bj * HALF + 4); }
                    const f32x4 y0 = x0 + gv[bj][0] * acc[ai][bj][m][0], y1 = x1 + gv[bj][1] * acc[ai][bj][m][1];
                    u32x4 w; w.x = cvt_pk_bf16(y0[0], y0[1]); w.y = cvt_pk_bf16(y0[2], y0[3]); w.z = cvt_pk_bf16(y1[0], y1[1]); w.w = cvt_pk_bf16(y1[2], y1[3]);
                    *(u32x4*)(out + off + bj * HALF) = w; } }
    }
};
}

__device__ __forceinline__ void transpose_item(const float* W, int ldw, int src_col0, int k0, bf16* WT, int dst_row0, int dst_k0, LAS float* scr, int lane) {
#pragma unroll
    for (int i = 0; i < 32; ++i) { const int kk = 2 * i + (lane >> 5); scr[kk * 33 + (lane & 31)] = W[(size_t)(k0 + kk) * ldw + src_col0 + (lane & 31)]; }
    LDS_WAIT();
    const int c = lane & 7;
#pragma unroll
    for (int j = 0; j < 4; ++j) { const int n = (lane >> 3) + 8 * j; const LAS float* s = scr + (8 * c) * 33 + n;
        u32x4 o; o.x = pk2(s[0 * 33], s[1 * 33]); o.y = pk2(s[2 * 33], s[3 * 33]); o.z = pk2(s[4 * 33], s[5 * 33]); o.w = pk2(s[6 * 33], s[7 * 33]);
        *(u32x4*)(WT + (size_t)(dst_row0 + n) * D + dst_k0 + 8 * c) = o; }
    LDS_WAIT();
}

__device__ __forceinline__ void phase_prologue(const Params& p, LAS unsigned char* lds) {
    int tid_ = threadIdx.x; asm volatile("" : "+v"(tid_));
    const int tid = tid_, lane = tid & 63, wave = tid >> 6;
    unsigned char* ws = p.ws;
    for (int task = blockIdx.x; task < DEPTH * 96; task += gridDim.x) {
        const int l = task / 96, cgp = task % 96, col = tid & 31, ks = tid >> 5;
        const float* W = p.in[3] + (size_t)l * D * 3072 + cgp * 32 + col;
        const float* c0 = p.in[1], *c1 = p.in[1] + D;
        float s0 = 0.f, s1 = 0.f;
#pragma unroll 16
        for (int k = ks * 64; k < ks * 64 + 64; ++k) { const float w = W[(size_t)k * 3072]; const float a = c0[k], b = c1[k];
            s0 += a * sigmoidf_(a) * w; s1 += b * sigmoidf_(b) * w; }
        LAS float* red = (LAS float*)(lds + 98304);
        red[(ks * 32 + col) * 2 + 0] = s0; red[(ks * 32 + col) * 2 + 1] = s1;
        __syncthreads();
        if (tid < 64) { const int cc = tid & 31, bb = tid >> 5; float s = 0.f;
#pragma unroll
            for (int k = 0; k < 16; ++k) s += red[(k * 32 + cc) * 2 + bb];
            const int cglob = cgp * 32 + cc;
            ((float*)(ws + WS_MOD))[(l * BATCH + bb) * 3072 + cglob] = s + p.in[4][l * 3072 + cglob]; }
        __syncthreads();
    }
    LAS float* scr = (LAS float*)(lds + wave * 8704);
    const int gw = blockIdx.x * NWAVES + wave, NGW = gridDim.x * NWAVES;
    constexpr int I_IN = 16 * 176, I_UP = 8 * 32, I_OUT = 16 * 32, I_LR = 16, I_L = I_IN + 2 * I_UP + I_OUT + I_LR;
    for (int it = gw; it < DEPTH * I_L; it += NGW) {
        const int l = it / I_L; int r = it % I_L;
        if (r < I_IN) { const int kb = r / 176, nb = r % 176, n0 = 32 * nb;
            transpose_item(p.in[5] + (size_t)l * D * IN_TOTAL, IN_TOTAL, n0 < 1536 ? n0 : (n0 < 3584 ? n0 + 16 : 3600 + (((n0 - 3584) >> 7) & 1) * 1024 + ((n0 - 3584) >> 8) * 128 + (n0 & 127)), 64 * kb, (bf16*)(ws + WS_WIN) + (size_t)l * NP * D, n0, 64 * kb, scr, lane); continue; }
        r -= I_IN;
        if (r < I_UP) { const int kb = r / 32, nb = r % 32;
            transpose_item(p.in[12] + (size_t)l * 512 * D, D, 32 * nb, 64 * kb, (bf16*)(ws + WS_WUP) + (size_t)l * D * D, 32 * nb, 64 * kb, scr, lane); continue; }
        r -= I_UP;
        if (r < I_UP) { const int kb = r / 32, nb = r % 32;
            transpose_item(p.in[13] + (size_t)l * 512 * D, D, 32 * nb, 64 * kb, (bf16*)(ws + WS_WUP) + (size_t)l * D * D, 32 * nb, 512 + 64 * kb, scr, lane); continue; }
        r -= I_UP;
        if (r >= I_OUT) { const int kb = r - I_OUT;
            transpose_item(p.in[5] + (size_t)l * D * IN_TOTAL, IN_TOTAL, 1536, 64 * kb, (bf16*)(ws + WS_WLR) + (size_t)l * 32 * D, 0, 64 * kb, scr, lane); continue; }
        { const int kb = r / 32, nb = r % 32;
            transpose_item(p.in[14] + (size_t)l * D * D, D, 32 * nb, 64 * kb, (bf16*)(ws + WS_WOUT) + (size_t)l * D * D, 32 * nb, 64 * kb, scr, lane); }
    }
}

template <bool XBF> struct XRaw;
template <> struct XRaw<false> { typedef f32x4 T; static __device__ __forceinline__ f32x4 cvt(const f32x4& v) { return v; } };
template <> struct XRaw<true> { typedef u32x2 T; static __device__ __forceinline__ f32x4 cvt(const u32x2& v) { return (f32x4){bflo(v.x), bfhi(v.x), bflo(v.y), bfhi(v.y)}; } };
template <bool XBF>
__device__ __forceinline__ void phase_norm(const Params& p, LAS unsigned char* lds, int l, const void* xin_) {
    int tid_ = threadIdx.x; asm volatile("" : "+v"(tid_));
    const int tid = tid_, lane = tid & 63, wave = tid >> 6, m = lane & 15, q = lane >> 4;
    unsigned char* ws = p.ws;
    constexpr int TRS = 2064;
    LAS unsigned char* tile = lds + wave * (8 * TRS);
    LAS float* wscr = (LAS float*)(lds + 8 * 8 * TRS) + wave * 128;
    f32x4 wa2r[16];
#pragma unroll
    for (int n = 0; n < 16; ++n) wa2r[n] = *(const f32x4*)(p.in[6] + l * 4096 + n * 256 + lane * 4);
    f32x4 nw[4];
#pragma unroll
    for (int j = 0; j < 4; ++j) nw[j] = *(const f32x4*)(p.in[2] + l * D + lane * 4 + 256 * j);
    const f32x4 ba4 = *(const f32x4*)(p.in[7] + l * 256 + lane * 4);
    const float* mod = (const float*)(ws + WS_MOD) + (size_t)l * BATCH * 3072;
    bf16* H = (bf16*)(ws + WS_H); bf16* LA = (bf16*)(ws + WS_LOGA);
    const bf16* wlr = (const bf16*)(ws + WS_WLR) + (size_t)l * 32 * D + m * D + q * 8;
    const LAS unsigned char* arow = tile + (m & 7) * TRS + q * 16;
    const int gw = blockIdx.x * NWAVES + wave, NGW = gridDim.x * NWAVES;
    int bcur = -1;
    typedef typename XRaw<XBF>::T xraw_t;
    f32x4 hm[4], ha[4]; xraw_t xn[2][4];
    if (gw * 8 < T) {
#pragma unroll
        for (int rr = 0; rr < 2; ++rr)
#pragma unroll
            for (int j = 0; j < 4; ++j) xn[rr][j] = ((const xraw_t*)xin_ + (size_t)(gw * 8 + rr) * (D / 4) + lane)[64 * j]; }
#pragma unroll 1
    for (int t = gw; t < T / 8; t += NGW) {
        const int r0 = t * 8, b = r0 / SEQ;
        if (b != bcur) { bcur = b;
#pragma unroll
            for (int j = 0; j < 4; ++j) { ha[j] = *(const f32x4*)(mod + b * 3072 + lane * 4 + 256 * j); const f32x4 sc = *(const f32x4*)(mod + b * 3072 + 1024 + lane * 4 + 256 * j); hm[j] = nw[j] * (1.0f + sc); } }
#pragma unroll 1
        for (int rp = 0; rp < 4; ++rp) {
            f32x4 hv[2][4];
#pragma unroll
            for (int rr = 0; rr < 2; ++rr)
#pragma unroll
                for (int j = 0; j < 4; ++j) hv[rr][j] = XRaw<XBF>::cvt(xn[rr][j]);
            {
                int rn = r0 + 2 * rp + 2;
                if (rp == 3) rn = (t + NGW < T / 8) ? (t + NGW) * 8 : r0;
#pragma unroll
                for (int rr = 0; rr < 2; ++rr)
#pragma unroll
                    for (int j = 0; j < 4; ++j) xn[rr][j] = ((const xraw_t*)xin_ + (size_t)(rn + rr) * (D / 4) + lane)[64 * j];
            }
#pragma unroll
            for (int rr = 0; rr < 2; ++rr) {
                float s = 0.f;
#pragma unroll
                for (int j = 0; j < 4; ++j) s += (hv[rr][j].x * hv[rr][j].x + hv[rr][j].y * hv[rr][j].y) + (hv[rr][j].z * hv[rr][j].z + hv[rr][j].w * hv[rr][j].w);
                const float rstd = __builtin_amdgcn_rsqf(wave_sum(s) * (1.0f / D) + EPS);
                const int row = 2 * rp + rr;
                u32x2* o8 = (u32x2*)(H + (size_t)(r0 + row) * D) + lane;
                LAS u32x2* t8 = (LAS u32x2*)(tile + row * TRS) + lane;
#pragma unroll
                for (int j = 0; j < 4; ++j) { const f32x4 hh = hv[rr][j] * rstd * hm[j] + ha[j];
                    const u32x2 pk = (u32x2){pg8::cvt_pk_bf16(hh.x, hh.y), pg8::cvt_pk_bf16(hh.z, hh.w)};
                    o8[64 * j] = pk; t8[64 * j] = pk; }
            }
        }
        LDS_WAIT();
        f32x4 acc = (f32x4){0.f, 0.f, 0.f, 0.f};
#pragma unroll 8
        for (int ks = 0; ks < 32; ++ks) {
            const bf16x8 af = *(const LAS bf16x8*)(arow + ks * 64);
            const bf16x8 bfr = *(const bf16x8*)(wlr + ks * 32);
            acc = __builtin_amdgcn_mfma_f32_16x16x32_bf16(af, bfr, acc, 0, 0, 0);
        }
        if (q < 2) {
#pragma unroll
            for (int j = 0; j < 4; ++j) wscr[(q * 4 + j) * 16 + m] = acc[j]; }
        LDS_WAIT();
#pragma unroll 2
        for (int row = 0; row < 8; ++row) {
            f32x4 z = ba4;
#pragma unroll
            for (int n4 = 0; n4 < 4; ++n4) { const f32x4 g = *(const LAS f32x4*)(wscr + row * 16 + n4 * 4);
                z += wa2r[n4 * 4 + 0] * g.x; z += wa2r[n4 * 4 + 1] * g.y; z += wa2r[n4 * 4 + 2] * g.z; z += wa2r[n4 * 4 + 3] * g.w; }
            f32x4 lo;
#pragma unroll
            for (int i = 0; i < 4; ++i) lo[i] = -(fmaxf(-z[i], 0.f) + __logf(1.0f + __expf(-fabsf(z[i])))) * 0.0625f;
            *(u32x2*)(LA + (size_t)(r0 + row) * 256 + lane * 4) = (u32x2){pg8::cvt_pk_bf16(lo[0], lo[1]), pg8::cvt_pk_bf16(lo[2], lo[3])};
        }
        LDS_WAIT();
    }
}

constexpr int MX_KD = 0, MX_QS = 16384, MX_OCT = 33792, MX_ADEC = 37888, MX_OT = 38400, MX_RA = 72192, MX_RV = 89600;
constexpr int MX_QS2 = 107008;
constexpr int MX_RSV = 272;

#define TR_READ(dst, addr, OFF) asm volatile("ds_read_b64_tr_b16 %0, %1 offset:%2" : "=&v"(dst) : "v"(addr), "n"(OFF) : "memory")

template <bool HG, bool FIN>
__device__ __forceinline__ void mixer_unit(const Params& p, LAS unsigned char* lds, int l, int b, int h, int jg) {
    constexpr int DK = HG ? 128 : 64, KT = DK / 16, QSTR = DK + 8, RSA = DK * 2 + 16;
    constexpr int KCOL = HG ? C_HF : C_GK, VCOL = HG ? C_HI : C_GV, QCOL = HG ? C_HQ : C_GQ, ZCOL = HG ? C_HZ : C_GZ;
    constexpr int NOCT = HG ? 2 : 1;
    constexpr int PPR = DK / 8, NQ = (64 * PPR) / NTHREADS;
    int tid_ = threadIdx.x; asm volatile("" : "+v"(tid_));
    const int tid = tid_, lane = tid & 63, w = tid >> 6, n = lane & 15, q = lane >> 4, qq = n >> 2, pp = lane & 3;
    unsigned char* ws = p.ws;
    const bf16* P1 = (const bf16*)(ws + WS_P1);
    const bf16* LA = (const bf16*)(ws + WS_LOGA);
    bf16* OB = (bf16*)(ws + WS_H);
    bf16* SB = (bf16*)(ws + (HG ? WS_STATE_HG : WS_STATE)) + (size_t)((b * 4 + h) * NG + jg) * (DK * 128);
    float* PD = (float*)(ws + WS_PDEC) + (size_t)(((HG ? 0 : 8) + b * 4 + h) * NG + jg) * 128;
    LAS unsigned char* KD = lds + MX_KD;
    LAS bf16* QS = (LAS bf16*)(lds + MX_QS);
    LAS float* OCT = (LAS float*)(lds + MX_OCT);
    LAS float* ADEC = (LAS float*)(lds + MX_ADEC);
    LAS float* OT = (LAS float*)(lds + MX_OT);
    LAS unsigned char* RA = lds + MX_RA;
    LAS unsigned char* RV = lds + MX_RV;

    const int c = HG ? (tid & 127) : (tid & 63);
    const int o_first = HG ? (tid >> 7) : (tid >> 6);
    const unsigned tra = (unsigned)(size_t)RA + (unsigned)((o_first * 8 + qq) * RSA + ((c & ~15) + 4 * pp) * 2);
    const unsigned trv = (unsigned)(size_t)RV + (unsigned)((8 * q + qq) * MX_RSV + (16 * w + 4 * pp) * 2);
    float lb = 0.f, lbf = 1e-30f, oml = 1.0f;
    if (HG) { if (l > 0) { const float g0 = p.in[9][h * 128 + c], g1 = p.in[9][512 + h * 128 + c]; lb = 1.0f / (1.0f + __expf(g0 - g1)); lb = fminf(fmaxf(lb, 0.f), 1.0f - 1e-6f); }
        lbf = fmaxf(lb, 1e-30f); oml = 1.0f - lb; }
    float nwv[16];
    if (FIN) { const float* nwp = (HG ? p.in[10] : p.in[8]) + l * 128 + (tid & 7) * 16;
#pragma unroll
        for (int i = 0; i < 16; ++i) nwv[i] = nwp[i]; }

    f32x4 S[KT];
    if (FIN) {
#pragma unroll
        for (int kt = 0; kt < KT; ++kt) { const u32x2 sv = *(const u32x2*)(SB + (size_t)((w * KT + kt) * 64 + lane) * 4); S[kt] = (f32x4){bflo(sv.x), bfhi(sv.x), bflo(sv.y), bfhi(sv.y)}; }
    } else {
#pragma unroll
        for (int kt = 0; kt < KT; ++kt) S[kt] = (f32x4){0.f, 0.f, 0.f, 0.f};
    }
    float pprod = 1.0f;

    const int rowg = b * SEQ + jg * G_CH * 64;
    u32x4 araw[NQ], vraw[2], qraw[NQ], zraw[2]; unsigned short laraw[8];
    const bf16* aptr = P1 + tile_off(KCOL + h * DK) + (size_t)rowg * TW;
    const bf16* laptr = LA + (size_t)rowg * 256 + h * 64 + c;
    const bf16* vptr = P1 + tile_off(VCOL + h * 128) + (size_t)rowg * TW;
    const bf16* qptr = P1 + tile_off(QCOL + h * DK) + (size_t)rowg * TW;
    const bf16* zptr = P1 + tile_off(ZCOL + h * 128) + (size_t)(rowg + (tid >> 3)) * TW + (tid & 7) * 16;
#define MX_LOAD_A(cc_) do { const size_t ro_ = (size_t)(cc_) * 64; \
        _Pragma("unroll") for (int pq = 0; pq < NQ; ++pq) { const int pc = tid + pq * NTHREADS; araw[pq] = *(const u32x4*)(aptr + (ro_ + pc / PPR) * TW + (pc % PPR) * 8); } \
        if (!HG) { _Pragma("unroll") for (int i = 0; i < 8; ++i) laraw[i] = laptr[(ro_ + o_first * 8 + i) * 256]; } } while (0)
#define MX_LOAD_V(cc_) do { const size_t ro_ = (size_t)(cc_) * 64; \
        _Pragma("unroll") for (int pq = 0; pq < 2; ++pq) { const int pc = tid + pq * NTHREADS; vraw[pq] = *(const u32x4*)(vptr + (ro_ + pc / 16) * TW + (pc % 16) * 8); } } while (0)
#define MX_LOAD_Q(cc_) do { const size_t ro_ = (size_t)(cc_) * 64; \
        _Pragma("unroll") for (int pq = 0; pq < NQ; ++pq) { const int pc = tid + pq * NTHREADS; qraw[pq] = *(const u32x4*)(qptr + (ro_ + pc / PPR) * TW + (pc % PPR) * 8); } } while (0)
#define MX_LOAD_Z(cc_) do { const size_t ro_ = (size_t)(cc_) * 64; zraw[0] = *(const u32x4*)(zptr + ro_ * TW); zraw[1] = *(const u32x4*)(zptr + ro_ * TW + 8); } while (0)
    MX_LOAD_A(0); MX_LOAD_V(0);
    if (FIN) { MX_LOAD_Q(0); MX_LOAD_Z(0); }
    float lacur[8];
#define MX_RAW_TO_LDS(qb_) do { \
        _Pragma("unroll") for (int pq = 0; pq < NQ; ++pq) { const int pc = tid + pq * NTHREADS; *(LAS u32x4*)(RA + (pc / PPR) * RSA + (pc % PPR) * 16) = araw[pq]; } \
        _Pragma("unroll") for (int pq = 0; pq < 2; ++pq) { const int pc = tid + pq * NTHREADS; *(LAS u32x4*)(RV + (pc / 16) * MX_RSV + (pc % 16) * 16) = vraw[pq]; } \
        if (FIN) { LAS bf16* qd_ = (LAS bf16*)(lds + ((qb_) ? MX_QS2 : MX_QS)); \
            _Pragma("unroll") for (int pq = 0; pq < NQ; ++pq) { const int pc = tid + pq * NTHREADS; *(LAS u32x4*)(qd_ + (pc / PPR) * QSTR + (pc % PPR) * 8) = qraw[pq]; } } \
        if (!HG) { _Pragma("unroll") for (int i = 0; i < 8; ++i) lacur[i] = bf2f(laraw[i]); } } while (0)
    MX_RAW_TO_LDS(0);
    { const int c1 = (1 < G_CH) ? 1 : 0; MX_LOAD_A(c1); MX_LOAD_V(c1); if (FIN) MX_LOAD_Q(c1); }
    LDS_WAIT(); __syncthreads();

#pragma unroll 1
    for (int cc = 0; cc < G_CH; ++cc) {
        const int ccn = (cc + 1 < G_CH) ? cc + 1 : cc;
        const int cc2 = (cc + 2 < G_CH) ? cc + 2 : G_CH - 1;
        const int row0 = rowg + cc * 64;
        const LAS bf16* QSc = (const LAS bf16*)(lds + ((cc & 1) ? MX_QS2 : MX_QS));
        u32x2 art[NOCT][2], vrt[2][2];
        TR_READ(art[0][0], tra, 0); TR_READ(art[0][1], tra, 4 * RSA);
        if (HG) { TR_READ(art[NOCT - 1][0], tra, 32 * RSA); TR_READ(art[NOCT - 1][1], tra, 36 * RSA); }
        TR_READ(vrt[0][0], trv, 0); TR_READ(vrt[0][1], trv, 4 * MX_RSV); TR_READ(vrt[1][0], trv, 32 * MX_RSV); TR_READ(vrt[1][1], trv, 36 * MX_RSV);
        if (HG) asm volatile("s_waitcnt lgkmcnt(0)" : "+v"(art[0][0]), "+v"(art[0][1]), "+v"(art[NOCT - 1][0]), "+v"(art[NOCT - 1][1]), "+v"(vrt[0][0]), "+v"(vrt[0][1]), "+v"(vrt[1][0]), "+v"(vrt[1][1]) :: "memory");
        else asm volatile("s_waitcnt lgkmcnt(0)" : "+v"(art[0][0]), "+v"(art[0][1]), "+v"(vrt[0][0]), "+v"(vrt[0][1]), "+v"(vrt[1][0]), "+v"(vrt[1][1]) :: "memory");
        float fg[NOCT][8], kv[NOCT][8];
#pragma unroll
        for (int oi = 0; oi < NOCT; ++oi) { const int o = o_first + 4 * oi;
#pragma unroll
            for (int i = 0; i < 8; ++i) { const unsigned wv = (i & 2) ? art[oi][i >> 2].y : art[oi][i >> 2].x; const float x = (i & 1) ? bfhi(wv) : bflo(wv);
                if (HG) { const float zf = fminf(fmaxf(x, -80.f), 80.f);
                    const float e = __expf(-zf), s = __builtin_amdgcn_rcpf(1.0f + e);
                    fg[oi][i] = lbf + oml * s; kv[oi][i] = oml * e * s; }
                else { fg[oi][i] = __expf(lacur[i]); kv[oi][i] = x; } }
            float pr = 1.0f;
#pragma unroll
            for (int i = 0; i < 8; ++i) pr *= fg[oi][i];
            OCT[o * 128 + c] = pr; }
        LDS_WAIT(); __syncthreads();
#pragma unroll
        for (int oi = 0; oi < NOCT; ++oi) { const int o = o_first + 4 * oi;
            float suf = 1.0f;
#pragma unroll
            for (int o2 = 1; o2 < 8; ++o2) { const float t = OCT[o2 * 128 + c]; suf *= (o2 > o) ? t : 1.0f; }
            float kd[8];
#pragma unroll
            for (int i = 7; i >= 0; --i) { kd[i] = kv[oi][i] * suf; suf *= fg[oi][i]; }
            u32x4 pk; pk.x = pg8::cvt_pk_bf16(kd[0], kd[1]); pk.y = pg8::cvt_pk_bf16(kd[2], kd[3]); pk.z = pg8::cvt_pk_bf16(kd[4], kd[5]); pk.w = pg8::cvt_pk_bf16(kd[6], kd[7]);
            *(LAS u32x4*)(KD + (size_t)((((c >> 4) * 2 + (o >> 2)) * 64 + (o & 3) * 16 + (c & 15)) * 16)) = pk;
            if (o == 0) { ADEC[c] = suf; pprod *= suf; } }
        MX_RAW_TO_LDS((cc + 1) & 1);
        MX_LOAD_A(cc2); MX_LOAD_V(cc2);
        if (FIN) MX_LOAD_Q(cc2);
        LDS_WAIT(); __syncthreads();
        union { u32x4 u; bf16x8 v; } vf[2];
        vf[0].u = (u32x4){vrt[0][0].x, vrt[0][0].y, vrt[0][1].x, vrt[0][1].y}; vf[1].u = (u32x4){vrt[1][0].x, vrt[1][0].y, vrt[1][1].x, vrt[1][1].y};
#pragma unroll
        for (int kt = 0; kt < KT; ++kt) { const f32x4 a4 = *(const LAS f32x4*)(ADEC + kt * 16 + q * 4); S[kt] = S[kt] * a4;
#pragma unroll
            for (int ks = 0; ks < 2; ++ks) { const bf16x8 af = *(const LAS bf16x8*)(KD + (size_t)(((kt * 2 + ks) * 64 + lane) * 16));
                S[kt] = __builtin_amdgcn_mfma_f32_16x16x32_bf16(af, vf[ks].v, S[kt], 0, 0, 0); } }
        if (FIN) {
            f32x4 oacc[4];
#pragma unroll
            for (int lt = 0; lt < 4; ++lt) oacc[lt] = (f32x4){0.f, 0.f, 0.f, 0.f};
#pragma unroll
            for (int kk = 0; kk < KT / 2; ++kk) {
                union { u32x4 u; bf16x8 v; } bs;
                bs.u.x = pg8::cvt_pk_bf16(S[2 * kk][0], S[2 * kk][1]); bs.u.y = pg8::cvt_pk_bf16(S[2 * kk][2], S[2 * kk][3]); bs.u.z = pg8::cvt_pk_bf16(S[2 * kk + 1][0], S[2 * kk + 1][1]); bs.u.w = pg8::cvt_pk_bf16(S[2 * kk + 1][2], S[2 * kk + 1][3]);
#pragma unroll
                for (int lt = 0; lt < 4; ++lt) {
                    union { u32x4 u; bf16x8 v; } aq;
                    const u32x2 q0 = *(const LAS u32x2*)(QSc + (lt * 16 + n) * QSTR + (2 * kk) * 16 + q * 4), q1 = *(const LAS u32x2*)(QSc + (lt * 16 + n) * QSTR + (2 * kk + 1) * 16 + q * 4);
                    aq.u = (u32x4){q0.x, q0.y, q1.x, q1.y};
                    oacc[lt] = __builtin_amdgcn_mfma_f32_16x16x32_bf16(aq.v, bs.v, oacc[lt], 0, 0, 0); } }
#pragma unroll
            for (int lt = 0; lt < 4; ++lt)
#pragma unroll
                for (int j = 0; j < 4; ++j) OT[(lt * 16 + q * 4 + j) * 132 + w * 16 + n] = oacc[lt][j];
            LDS_WAIT(); __syncthreads();
            { const int fl = tid >> 3, seg = tid & 7;
                f32x4 ov[4]; float ssq = 0.f;
#pragma unroll
                for (int i = 0; i < 4; ++i) { ov[i] = *(const LAS f32x4*)(OT + fl * 132 + seg * 16 + i * 4); ssq += (ov[i].x * ov[i].x + ov[i].y * ov[i].y) + (ov[i].z * ov[i].z + ov[i].w * ov[i].w); }
                ssq += __shfl_xor(ssq, 1); ssq += __shfl_xor(ssq, 2); ssq += __shfl_xor(ssq, 4);
                const float rstd = __builtin_amdgcn_rsqf(ssq * (1.0f / 128.0f) + EPS);
                const u32x4 zg0 = zraw[0], zg1 = zraw[1];
                MX_LOAD_Z(ccn);
                u32x4 w0, w1;
                w0.x = pg8::cvt_pk_bf16(ov[0].x * rstd * nwv[0] * bflo(zg0.x), ov[0].y * rstd * nwv[1] * bfhi(zg0.x)); w0.y = pg8::cvt_pk_bf16(ov[0].z * rstd * nwv[2] * bflo(zg0.y), ov[0].w * rstd * nwv[3] * bfhi(zg0.y));
                w0.z = pg8::cvt_pk_bf16(ov[1].x * rstd * nwv[4] * bflo(zg0.z), ov[1].y * rstd * nwv[5] * bfhi(zg0.z)); w0.w = pg8::cvt_pk_bf16(ov[1].z * rstd * nwv[6] * bflo(zg0.w), ov[1].w * rstd * nwv[7] * bfhi(zg0.w));
                w1.x = pg8::cvt_pk_bf16(ov[2].x * rstd * nwv[8] * bflo(zg1.x), ov[2].y * rstd * nwv[9] * bfhi(zg1.x)); w1.y = pg8::cvt_pk_bf16(ov[2].z * rstd * nwv[10] * bflo(zg1.y), ov[2].w * rstd * nwv[11] * bfhi(zg1.y));
                w1.z = pg8::cvt_pk_bf16(ov[3].x * rstd * nwv[12] * bflo(zg1.z), ov[3].y * rstd * nwv[13] * bfhi(zg1.z)); w1.w = pg8::cvt_pk_bf16(ov[3].z * rstd * nwv[14] * bflo(zg1.w), ov[3].w * rstd * nwv[15] * bfhi(zg1.w));
                bf16* op = OB + (size_t)(row0 + fl) * D + (HG ? 512 : 0) + h * 128 + seg * 16;
                *(u32x4*)op = w0; *(u32x4*)(op + 8) = w1; }
        }
    }
#undef MX_RAW_TO_LDS
#undef MX_LOAD_A
#undef MX_LOAD_V
#undef MX_LOAD_Q
#undef MX_LOAD_Z
    if (!FIN) {
#pragma unroll
        for (int kt = 0; kt < KT; ++kt) *(u32x2*)(SB + (size_t)((w * KT + kt) * 64 + lane) * 4) = (u32x2){pg8::cvt_pk_bf16(S[kt][0], S[kt][1]), pg8::cvt_pk_bf16(S[kt][2], S[kt][3])};
        if (o_first == 0) PD[c] = pprod;
    }
    __syncthreads();
}

template <bool FIN>
__device__ __forceinline__ void phase_mixer(const Params& p, LAS unsigned char* lds, int l) {
    for (int u = blockIdx.x; u < 512; u += gridDim.x) {
        const int rem = u & 255, b = rem >> 7, h = (rem >> 5) & 3, jg = rem & 31;
        if (!FIN && jg == NG - 1) continue;
        if (u < 256) mixer_unit<true, FIN>(p, lds, l, b, h, jg); else mixer_unit<false, FIN>(p, lds, l, b, h, jg);
    }
}

__device__ __forceinline__ void phase_scan(const Params& p) {
    unsigned char* ws = p.ws;
    int tid_ = threadIdx.x; asm volatile("" : "+v"(tid_));
    const int gt = blockIdx.x * NTHREADS + tid_, NT = gridDim.x * NTHREADS;
    for (int tt = gt; tt < 8 * 4096 + 8 * 2048; tt += NT) {
        const bool hg = tt < 32768; const int t2 = hg ? tt : tt - 32768, per = hg ? 4096 : 2048, bh = t2 / per, e = t2 % per, KT = hg ? 8 : 4;
        const int kt = (e >> 6) % KT, lane = e & 63, c4 = kt * 16 + (lane >> 4) * 4;
        bf16* base = (bf16*)(ws + (hg ? WS_STATE_HG : WS_STATE)) + (size_t)bh * NG * (per * 4) + (size_t)e * 4;
        const float* pd = (const float*)(ws + WS_PDEC) + (size_t)(((hg ? 0 : 8) + bh) * NG) * 128 + c4;
        f32x4 S = (f32x4){0.f, 0.f, 0.f, 0.f};
        for (int j0 = 0; j0 < NG; j0 += 8) {
            f32x4 Lv[8], Pv[8];
#pragma unroll
            for (int j = 0; j < 8; ++j) { if (j0 + j < NG - 1) { { const u32x2 lv = *(const u32x2*)(base + (size_t)(j0 + j) * (per * 4)); Lv[j] = (f32x4){bflo(lv.x), bfhi(lv.x), bflo(lv.y), bfhi(lv.y)}; } Pv[j] = *(const f32x4*)(pd + (size_t)(j0 + j) * 128); } else { Lv[j] = (f32x4){0.f, 0.f, 0.f, 0.f}; Pv[j] = Lv[j]; } }
#pragma unroll
            for (int j = 0; j < 8; ++j) { *(u32x2*)(base + (size_t)(j0 + j) * (per * 4)) = (u32x2){pg8::cvt_pk_bf16(S[0], S[1]), pg8::cvt_pk_bf16(S[2], S[3])}; S = Pv[j] * S + Lv[j]; }
        }
    }
}

__device__ __forceinline__ void phase_final_norm(const Params& p) {
    int tid_ = threadIdx.x; asm volatile("" : "+v"(tid_));
    const int tid = tid_, lane = tid & 63, wave = tid >> 6;
    const u32x2* xb = (const u32x2*)(p.ws + WS_H);
    f32x4 nw[4];
#pragma unroll
    for (int j = 0; j < 4; ++j) nw[j] = *(const f32x4*)(p.in[15] + lane * 4 + 256 * j);
    const int gw = blockIdx.x * NWAVES + wave, NGW = gridDim.x * NWAVES;
    u32x2 vn[4];
    if (gw < T) {
#pragma unroll
        for (int j = 0; j < 4; ++j) vn[j] = (xb + (size_t)gw * (D / 4) + lane)[64 * j]; }
#pragma unroll 1
    for (int r = gw; r < T; r += NGW) {
        f32x4* xr = (f32x4*)(p.out + (size_t)r * D) + lane;
        f32x4 v[4]; float s = 0.f;
#pragma unroll
        for (int j = 0; j < 4; ++j) v[j] = (f32x4){bflo(vn[j].x), bfhi(vn[j].x), bflo(vn[j].y), bfhi(vn[j].y)};
        { const int rn = (r + NGW < T) ? r + NGW : r;
#pragma unroll
          for (int j = 0; j < 4; ++j) vn[j] = (xb + (size_t)rn * (D / 4) + lane)[64 * j]; }
#pragma unroll
        for (int j = 0; j < 4; ++j) s += (v[j].x * v[j].x + v[j].y * v[j].y) + (v[j].z * v[j].z + v[j].w * v[j].w);
        const float rstd = __builtin_amdgcn_rsqf(wave_sum(s) * (1.0f / D) + EPS);
#pragma unroll
        for (int j = 0; j < 4; ++j) xr[64 * j] = v[j] * rstd * nw[j];
    }
}

#define XB_TMO      128
#define XB_XCNT(j)  (256  + 64 * (j))
#define XB_XSUB(j)  (1280 + 64 * (j))
#define XB_XGEN(j)  (2304 + 64 * (j))
#define XB_TOP      3328
#define XB_TOPGEN   3392
#define XCD_BAR_WORDS 3456
#define XB_SPIN_CAP (1u << 18)

__device__ __forceinline__ unsigned xb_ld(unsigned* p)              { return __hip_atomic_load(p, __ATOMIC_RELAXED, __HIP_MEMORY_SCOPE_AGENT); }
__device__ __forceinline__ unsigned xb_add(unsigned* p, unsigned v) { return __hip_atomic_fetch_add(p, v, __ATOMIC_RELAXED, __HIP_MEMORY_SCOPE_AGENT); }
__device__ __forceinline__ unsigned xb_xcc_id() { return (unsigned)__builtin_amdgcn_s_getreg((3 << 11) | 20) & 0xFu; }
#define XB_SPIN(cond, bar) do { unsigned _sp = 0; while (cond) { __builtin_amdgcn_s_sleep(1); \
    if ((++_sp & 255u) == 0u) { if (xb_ld(&(bar)[XB_TMO])) break; if (_sp > XB_SPIN_CAP) { atomicAdd(&(bar)[XB_TMO], 1u); break; } } } } while (0)

struct XcdBarrier {
    unsigned* bar; unsigned x;
    volatile LAS unsigned* st;
};

__device__ __forceinline__ XcdBarrier xcd_barrier_post(unsigned* bar, volatile LAS unsigned* st) {
    XcdBarrier b; b.bar = bar; b.x = xb_xcc_id(); b.st = st;
    if (threadIdx.x == 0) (void)xb_add(&bar[XB_XCNT(b.x)], 1u);
    return b;
}
__device__ __forceinline__ void xcd_barrier_complete(unsigned* bar, unsigned x, unsigned& nloc, unsigned& nx) {
    const unsigned G = gridDim.x * gridDim.y * gridDim.z;
    unsigned sum, cnt, mine, sp = 0u;
    for (;;) {
        sum = 0u; cnt = 0u; mine = 0u;
#pragma unroll
        for (unsigned j = 0; j < 16; ++j) { const unsigned c = xb_ld(&bar[XB_XCNT(j)]); sum += c; cnt += (c > 0u) ? 1u : 0u; mine = (j == x) ? c : mine; }
        if (sum == G) break;
        __builtin_amdgcn_s_sleep(1);
        if ((++sp & 255u) == 0u) { if (xb_ld(&bar[XB_TMO])) break; if (sp > XB_SPIN_CAP) { atomicAdd(&bar[XB_TMO], 1u); break; } }
    }
    nloc = mine > 0u ? mine : 1u; nx = cnt > 0u ? cnt : 1u;
}

__device__ __forceinline__ void xcd_barrier(const XcdBarrier& b) {
    asm volatile("s_waitcnt vmcnt(0)" ::: "memory");
    __syncthreads();
    if (threadIdx.x == 0) {
        unsigned* bar = b.bar;
        __builtin_amdgcn_s_waitcnt(0);
        unsigned nloc = b.st[0], nx = b.st[1];
        if (nloc == 0u) { xcd_barrier_complete(bar, b.x, nloc, nx); b.st[0] = nloc; b.st[1] = nx; }
        const unsigned old = xb_add(&bar[XB_XSUB(b.x)], 1u);
        const unsigned gen = old / nloc;
        if (old + 1u == (gen + 1u) * nloc) {
            __builtin_amdgcn_fence(__ATOMIC_RELEASE, "agent");
            asm volatile("s_waitcnt vmcnt(0)" ::: "memory");
            const unsigned og = xb_add(&bar[XB_TOP], 1u);
            const unsigned tg = og / nx;
            if (og + 1u == (tg + 1u) * nx) xb_add(&bar[XB_TOPGEN], 1u);
            else XB_SPIN(xb_ld(&bar[XB_TOPGEN]) == tg, bar);
            __builtin_amdgcn_fence(__ATOMIC_ACQUIRE, "agent");
            xb_add(&bar[XB_XGEN(b.x)], 1u);
            asm volatile("s_waitcnt vmcnt(0)" ::: "memory");
        } else {
            XB_SPIN(xb_ld(&bar[XB_XGEN(b.x)]) == gen, bar);
            __builtin_amdgcn_fence(__ATOMIC_ACQUIRE, "agent");
            asm volatile("s_waitcnt vmcnt(0)" ::: "memory");
        }
    }
    __syncthreads();
}


__global__ void __launch_bounds__(NTHREADS, 2) mega_fwd(Params p) {
    extern __shared__ __attribute__((aligned(16))) unsigned char lds_raw[];
    LAS unsigned char* lds = (LAS unsigned char*)lds_raw;
    cg::grid_group grid = cg::this_grid();
    unsigned char* ws = p.ws;
    unsigned* barw = (unsigned*)(ws + WS_BAR);
    volatile LAS unsigned* bst = (volatile LAS unsigned*)(lds + LDS_BYTES - 64);
    if (threadIdx.x < 2) bst[threadIdx.x] = 0u;
    if (blockIdx.x == 0) for (int i = threadIdx.x; i < XCD_BAR_WORDS; i += NTHREADS) barw[i] = 0u;
    phase_prologue(p, lds);
    grid.sync();
    const XcdBarrier xb = xcd_barrier_post(barw, bst);
#pragma unroll 1
    for (int l_ = 0; l_ < DEPTH; ++l_) {
        int l = l_; asm volatile("" : "+s"(l));
        if (l == 0) phase_norm<false>(p, lds, l, p.in[0]); else phase_norm<true>(p, lds, l, p.out);
        xcd_barrier(xb);
        {
            pg8::Gemm g{(const pg8::bf16_t*)(ws + WS_H), (const pg8::bf16_t*)(ws + WS_WIN) + (size_t)l * NP * D, T, NP, D};
            pg8::StaticOrder S; S.init(T, NP, (int)gridDim.x, (int)blockIdx.x, 4);
            pg8::EpiIn E{(pg8::bf16_t*)(ws + WS_P1), (pg8::bf16_t*)(ws + WS_PG), p.in[11] + l * 2048};
            pg8::gemm_phase<pg8::EpiIn, pg8::StaticOrder, true, true>(lds, g, S, E);
        }
        xcd_barrier(xb);
        phase_mixer<false>(p, lds, l);
        xcd_barrier(xb);
        phase_scan(p);
        xcd_barrier(xb);
        phase_mixer<true>(p, lds, l);
        xcd_barrier(xb);
        {
            pg8::Gemm g{(const pg8::bf16_t*)(ws + WS_H), (const pg8::bf16_t*)(ws + WS_WUP) + (size_t)l * D * D, T, D, D};
            pg8::StaticOrder S; S.init(T, D, (int)gridDim.x, (int)blockIdx.x);
            pg8::EpiUp E{(const pg8::bf16_t*)(ws + WS_PG), (pg8::bf16_t*)(ws + WS_P1)};
            pg8::gemm_phase<pg8::EpiUp, pg8::StaticOrder, true, true>(lds, g, S, E);
        }
        xcd_barrier(xb);
        {
            pg8::Gemm g{(const pg8::bf16_t*)(ws + WS_P1), (const pg8::bf16_t*)(ws + WS_WOUT) + (size_t)l * D * D, T, D, D};
            pg8::StaticOrder S; S.init(T, D, (int)gridDim.x, (int)blockIdx.x);
            const float* gate2 = (const float*)(ws + WS_MOD) + (size_t)l * BATCH * 3072 + 2048;
            if (l == 0) { pg8::EpiOut<false> E{(const void*)p.in[0], (pg8::bf16_t*)p.out, gate2}; pg8::gemm_phase<pg8::EpiOut<false>, pg8::StaticOrder, true, true>(lds, g, S, E); }
            else { pg8::EpiOut<true> E{(const void*)p.out, (pg8::bf16_t*)(ws + WS_H), gate2}; pg8::gemm_phase<pg8::EpiOut<true>, pg8::StaticOrder, true, true>(lds, g, S, E); }
        }
        xcd_barrier(xb);
    }
    phase_final_norm(p);
}

extern "C" void kernel_launch(void* const* d_in, const int* in_sizes, int n_in, void* d_out, int out_size, void* d_ws, size_t ws_size, hipStream_t stream) {
    static int grid = 0;
    if (grid == 0) {
        if (n_in != 16 || in_sizes[0] != T * D || out_size != T * D || ws_size < WS_END) { fprintf(stderr, "kernel_launch: unexpected shapes (n_in %d, in0 %d, out %d, ws %zu)\n", n_in, n_in > 0 ? in_sizes[0] : -1, out_size, ws_size); grid = -1; return; }
        int dev = 0, cus = 0, per_cu = 0;
        if (hipGetDevice(&dev) != hipSuccess || hipDeviceGetAttribute(&cus, hipDeviceAttributeMultiprocessorCount, dev) != hipSuccess) { fprintf(stderr, "kernel_launch: device query failed\n"); grid = -1; return; }
        if (hipFuncSetAttribute((const void*)mega_fwd, hipFuncAttributeMaxDynamicSharedMemorySize, LDS_BYTES) != hipSuccess) { fprintf(stderr, "kernel_launch: hipFuncSetAttribute failed\n"); grid = -1; return; }
        if (hipOccupancyMaxActiveBlocksPerMultiprocessor(&per_cu, (const void*)mega_fwd, NTHREADS, LDS_BYTES) != hipSuccess || per_cu < 1) { fprintf(stderr, "kernel_launch: occupancy query failed (%d)\n", per_cu); (void)hipGetLastError(); per_cu = 1; }
        grid = cus * per_cu;
    }
    if (grid < 0) return;
    Params p{};
    for (int i = 0; i < 16; ++i) p.in[i] = (const float*)d_in[i];
    p.out = (float*)d_out; p.ws = (unsigned char*)d_ws;
    void* args[] = {&p};
    const hipError_t e = hipLaunchCooperativeKernel((const void*)mega_fwd, dim3(grid), dim3(NTHREADS), args, LDS_BYTES, stream);
    if (e != hipSuccess) fprintf(stderr, "kernel_launch: cooperative launch failed: %s (grid %d)\n", hipGetErrorString(e), grid);
}
```
